# Optimizing an MI355X kernel written in HIP

```python
import jax
import jax.numpy as jnp
from jax import lax
import numpy as np


D_MODEL = 1024
BATCH = 2
SEQ = 16384
DEPTH = 4

GRID_W = 64
CTX_LEN = 256
HEAD_DIM = 64
GQA_HEADS = 8
GQA_KV_HEADS = 2
NA_HEADS = 8
NA_ROWS = 8
NA_COLS = 16
RET_HEADS = 4
RET_DK = 128
RET_DV = 128
RET_CHUNK = 128
MLA_HEADS = 4
MLA_Q_LORA = 256
MLA_KV_LORA = 128
MLA_NOPE = 128
MLA_ROPE = 64
MLA_V = 128
N_EXPERTS = 32
TOP_K = 4
D_FF = 1024
SWIGLU_LIMIT = 7.0
SWIGLU_ALPHA = 1.702
MOE_BLOCK = 256
Q_BLOCK = 128
ROPE_THETA = 10000.0
EPS = 1e-6
GN_EPS = 1e-5
N_EVEN = (DEPTH + 1) // 2
N_ODD = DEPTH // 2
EVEN_WIDTHS = (GQA_HEADS * HEAD_DIM, GQA_KV_HEADS * HEAD_DIM, GQA_KV_HEADS * HEAD_DIM, NA_HEADS * HEAD_DIM, NA_HEADS * HEAD_DIM, NA_HEADS * HEAD_DIM)
ODD_WIDTHS = (RET_HEADS * RET_DK, RET_HEADS * RET_DK, RET_HEADS * RET_DV, RET_HEADS * RET_DV, MLA_Q_LORA, MLA_KV_LORA, MLA_ROPE)
EVEN_OUT = (GQA_HEADS + NA_HEADS) * HEAD_DIM
ODD_OUT = RET_HEADS * RET_DV + MLA_HEADS * MLA_V
RPB_SIZE = (2 * NA_ROWS - 1) * (2 * NA_COLS - 1)

kernel_name = 'hybrid_dit_gqa_na_retnet_mla_moe'


def rms_norm(x, g):
    xf = x.astype(jnp.float32)
    y = xf * lax.rsqrt(jnp.mean(xf * xf, axis=-1, keepdims=True) + EPS)
    return (y * g.astype(jnp.float32)).astype(x.dtype)


def modulate(x, g, shift, scale):
    return rms_norm(x, g) * (1.0 + scale) + shift


def split_cols(p, widths):
    return jnp.split(p, [int(v) for v in np.cumsum(widths)[:-1]], axis=-1)


def heads(t, n):
    b, l, w = t.shape
    return t.reshape(b, l, n, w // n).transpose(0, 2, 1, 3)


def unheads(t):
    b, h, l, d = t.shape
    return t.transpose(0, 2, 1, 3).reshape(b, l, h * d)


def axial_rope(rows, cols, d_rot):
    n_freq = d_rot // 4
    inv = ROPE_THETA ** (-jnp.arange(n_freq, dtype=jnp.float32) / n_freq)
    ang = jnp.concatenate([rows[:, None] * inv, cols[:, None] * inv], axis=-1)
    return jnp.cos(ang), jnp.sin(ang)


def apply_rope(x, cos, sin):
    xf = x.astype(jnp.float32).reshape(x.shape[:-1] + (-1, 2))
    x1, x2 = xf[..., 0], xf[..., 1]
    out = jnp.stack([x1 * cos - x2 * sin, x1 * sin + x2 * cos], axis=-1)
    return out.reshape(x.shape).astype(x.dtype)


def blocked_attention(q, k, v):
    b, kvh, g, lq, dq = q.shape
    scale = dq ** -0.5
    nb = lq // Q_BLOCK
    qb = jnp.moveaxis(q.reshape(b, kvh, g, nb, Q_BLOCK, dq), 3, 0)

    def block(qs):
        s = jnp.einsum('bkgqd,bksd->bkgqs', qs, k, preferred_element_type=jnp.float32) * scale
        p = jax.nn.softmax(s, axis=-1).astype(v.dtype)
        return jnp.einsum('bkgqs,bksd->bkgqd', p, v)

    o = lax.map(block, qb)
    return jnp.moveaxis(o, 0, 3).reshape(b, kvh, g, lq, v.shape[-1])


def neighbourhood_tables(seq_len):
    rows_n = seq_len // GRID_W
    wr = min(NA_ROWS, rows_n)
    t = jnp.arange(seq_len)
    r, col = t // GRID_W, t % GRID_W
    r0 = jnp.clip(r - wr // 2, 0, rows_n - wr)
    c0 = jnp.clip(col - NA_COLS // 2, 0, GRID_W - NA_COLS)
    kr = r0[:, None, None] + jnp.arange(wr)[None, :, None]
    kc = c0[:, None, None] + jnp.arange(NA_COLS)[None, None, :]
    idx = (kr * GRID_W + kc).reshape(seq_len, wr * NA_COLS)
    rel = ((kr - r[:, None, None] + NA_ROWS - 1) * (2 * NA_COLS - 1)
           + (kc - col[:, None, None] + NA_COLS - 1)).reshape(seq_len, wr * NA_COLS)
    return idx, rel


def neighbourhood_attention(q, k, v, k_ctx, v_ctx, rpb, idx, rel):
    b, h, s, d = q.shape
    scale = d ** -0.5
    nb = s // Q_BLOCK
    w = idx.shape[1]
    qb = jnp.moveaxis(q.reshape(b, h, nb, Q_BLOCK, d), 2, 0)
    ib = idx.reshape(nb, Q_BLOCK, w)
    rb = rel.reshape(nb, Q_BLOCK, w)

    def block(inp):
        qs, ii, rr = inp
        kw = k[:, :, ii]
        vw = v[:, :, ii]
        s_win = jnp.einsum('bhqd,bhqwd->bhqw', qs, kw, preferred_element_type=jnp.float32) * scale
        s_win = s_win + rpb[:, rr][None].astype(jnp.float32)
        s_ctx = jnp.einsum('bhqd,bhcd->bhqc', qs, k_ctx, preferred_element_type=jnp.float32) * scale
        p = jax.nn.softmax(jnp.concatenate([s_win, s_ctx], axis=-1), axis=-1).astype(v.dtype)
        return (jnp.einsum('bhqw,bhqwd->bhqd', p[..., :w], vw)
                + jnp.einsum('bhqc,bhcd->bhqd', p[..., w:], v_ctx))

    o = lax.map(block, (qb, ib, rb))
    return jnp.moveaxis(o, 0, 2).reshape(b, h, s, d)


def retention_chunkwise(q, k, v, log_gamma, state0, inclusive):
    b, h, L, dk = q.shape
    dv = v.shape[-1]
    n = L // RET_CHUNK
    pos = jnp.arange(RET_CHUNK, dtype=jnp.float32)
    diff = pos[:, None] - pos[None, :]
    mask = (diff >= 0) if inclusive else (diff > 0)
    decay_in = jnp.where(mask, jnp.exp(log_gamma[:, None, None] * jnp.where(mask, diff, 0.0)), 0.0)
    q_decay = jnp.exp(log_gamma[:, None] * (pos + 1.0))[..., None]
    k_decay = jnp.exp(log_gamma[:, None] * (RET_CHUNK - 1.0 - pos))[..., None]
    chunk_decay = jnp.exp(log_gamma * RET_CHUNK)[:, None, None]

    def chunks(t):
        return jnp.moveaxis(t.astype(jnp.float32).reshape(b, h, n, RET_CHUNK, t.shape[-1]), 2, 0)

    def step(state, inp):
        qc, kc, vc = inp
        inner = jnp.einsum('bhts,bhsv->bhtv', jnp.einsum('bhtd,bhsd->bhts', qc, kc) * decay_in, vc)
        cross = jnp.einsum('bhtd,bhdv->bhtv', qc * q_decay, state)
        new_state = state * chunk_decay + jnp.einsum('bhsd,bhsv->bhdv', kc * k_decay, vc)
        return new_state, inner + cross

    final, y = lax.scan(step, state0, (chunks(q), chunks(k), chunks(v)))
    return jnp.moveaxis(y, 0, 2).reshape(b, h, L, dv), final


def head_group_norm(y):
    mu = jnp.mean(y, axis=-1, keepdims=True)
    var = jnp.mean(jnp.square(y - mu), axis=-1, keepdims=True)
    return (y - mu) * lax.rsqrt(var + GN_EPS)


def mixer_even(h_lat, h_ctx, w_in, w_out, a_qn, a_kn, b_qn, b_kn, rpb, rope, nbr_idx, nbr_rel, need_ctx):
    def project(h):
        qa, ka, va, qb, kb, vb = split_cols(h @ w_in, EVEN_WIDTHS)
        return (rms_norm(heads(qa, GQA_HEADS), a_qn), rms_norm(heads(ka, GQA_KV_HEADS), a_kn), heads(va, GQA_KV_HEADS),
                rms_norm(heads(qb, NA_HEADS), b_qn), rms_norm(heads(kb, NA_HEADS), b_kn), heads(vb, NA_HEADS))

    qa, ka, va, qb, kb, vb = project(h_lat)
    qa_c, ka_c, va_c, qb_c, kb_c, vb_c = project(h_ctx)
    cos, sin = rope
    qa = apply_rope(qa, cos, sin)
    ka = apply_rope(ka, cos, sin)
    b, _, s, _ = qa.shape
    grp = GQA_HEADS // GQA_KV_HEADS
    oa = blocked_attention(qa.reshape(b, GQA_KV_HEADS, grp, s, HEAD_DIM),
                           jnp.concatenate([ka, ka_c], axis=2), jnp.concatenate([va, va_c], axis=2))
    ob = neighbourhood_attention(qb, kb, vb, kb_c, vb_c, rpb, nbr_idx, nbr_rel)
    o_lat = jnp.concatenate([unheads(oa.reshape(b, GQA_HEADS, s, HEAD_DIM)), unheads(ob)], axis=-1) @ w_out
    o_ctx = None
    if need_ctx:
        cl = qa_c.shape[2]
        oa_c = blocked_attention(qa_c.reshape(b, GQA_KV_HEADS, grp, cl, HEAD_DIM), ka_c, va_c)
        ob_c = blocked_attention(qb_c[:, :, None], kb_c, vb_c)
        o_ctx = jnp.concatenate([unheads(oa_c.reshape(b, GQA_HEADS, cl, HEAD_DIM)), unheads(ob_c[:, :, 0])], axis=-1) @ w_out
    return o_lat, o_ctx


def mixer_odd(h_lat, h_ctx, w_in, w_out, decay_logit, gn_g, cq_n, ckv_n, w_uq, w_ukv, q_n, k_n, rope_c, rope_d, need_ctx):
    def project(h):
        rq, rk, rv, rg, cq, ckv, kr = split_cols(h @ w_in, ODD_WIDTHS)
        b, L, _ = h.shape
        rq = heads(rq, RET_HEADS) * (RET_DK ** -0.5)
        rk = heads(rk, RET_HEADS)
        rv = heads(rv, RET_HEADS)
        q = heads(rms_norm(cq, cq_n) @ w_uq, MLA_HEADS)
        kv = heads(rms_norm(ckv, ckv_n) @ w_ukv, MLA_HEADS)
        k_rope = jnp.broadcast_to(kr[:, None], (b, MLA_HEADS, L, MLA_ROPE))
        k = jnp.concatenate([kv[..., :MLA_NOPE], k_rope], axis=-1)
        return rq, rk, rv, rg, rms_norm(q, q_n), rms_norm(k, k_n), kv[..., MLA_NOPE:]

    rq, rk, rv, rg, q, k, v = project(h_lat)
    rq_c, rk_c, rv_c, rg_c, q_c, k_c, v_c = project(h_ctx)
    cos_c, sin_c = rope_c
    cos_d, sin_d = rope_d
    rq = apply_rope(rq, cos_c, sin_c)
    rk = apply_rope(rk, cos_c, sin_c)
    q = jnp.concatenate([q[..., :MLA_NOPE], apply_rope(q[..., MLA_NOPE:], cos_d, sin_d)], axis=-1)
    k = jnp.concatenate([k[..., :MLA_NOPE], apply_rope(k[..., MLA_NOPE:], cos_d, sin_d)], axis=-1)

    log_g = jax.nn.log_sigmoid(decay_logit.astype(jnp.float32))
    b = h_lat.shape[0]
    s0 = jnp.zeros((b, RET_HEADS, RET_DK, RET_DV), jnp.float32)
    flip = lambda t: jnp.flip(t, axis=2)
    yf_c, st_f = retention_chunkwise(rq_c, rk_c, rv_c, log_g[0], s0, True)
    yb_c, st_b = retention_chunkwise(flip(rq_c), flip(rk_c), flip(rv_c), log_g[1], s0, False)
    yf, _ = retention_chunkwise(rq, rk, rv, log_g[0], st_f, True)
    yb, _ = retention_chunkwise(flip(rq), flip(rk), flip(rv), log_g[1], st_b, False)

    def retention_out(y, gate):
        return (unheads(head_group_norm(y)) * gn_g * jax.nn.silu(gate.astype(jnp.float32))).astype(gate.dtype)

    def mla(qq, kk, vv):
        return unheads(blocked_attention(qq[:, :, None], kk, vv)[:, :, 0])

    o_lat = jnp.concatenate([retention_out(yf + flip(yb), rg),
                             mla(q, jnp.concatenate([k, k_c], axis=2), jnp.concatenate([v, v_c], axis=2))], axis=-1) @ w_out
    o_ctx = None
    if need_ctx:
        o_ctx = jnp.concatenate([retention_out(yf_c + flip(yb_c), rg_c), mla(q_c, k_c, v_c)], axis=-1) @ w_out
    return o_lat, o_ctx


def moe(h, w_r, b_r, w1, b1, w2, b2):
    n, d = h.shape
    logits = (h @ w_r).astype(jnp.float32) + b_r.astype(jnp.float32)
    top_v, top_e = lax.top_k(logits, TOP_K)
    gates = jax.nn.softmax(top_v, axis=-1)
    nk = n * TOP_K
    flat_e = top_e.reshape(nk)
    flat_tok = jnp.repeat(jnp.arange(n, dtype=jnp.int32), TOP_K)
    flat_g = gates.reshape(nk)
    order = jnp.argsort(flat_e)
    se, stok, sg = flat_e[order], flat_tok[order], flat_g[order]
    counts = jnp.bincount(flat_e, length=N_EXPERTS)
    padded = ((counts + MOE_BLOCK - 1) // MOE_BLOCK) * MOE_BLOCK
    start = jnp.cumsum(counts) - counts
    pend = jnp.cumsum(padded)
    pstart = pend - padded
    dest = pstart[se] + (jnp.arange(nk) - start[se])
    cap = ((nk + N_EXPERTS * (MOE_BLOCK - 1)) // MOE_BLOCK + 1) * MOE_BLOCK
    n_blk = cap // MOE_BLOCK
    buf_tok = jnp.full((cap,), n, jnp.int32).at[dest].set(stok)
    buf_g = jnp.zeros((cap,), jnp.float32).at[dest].set(sg)
    blk_e = jnp.clip(jnp.searchsorted(pend, jnp.arange(n_blk) * MOE_BLOCK, side='right'), 0, N_EXPERTS - 1)
    h_pad = jnp.concatenate([h, jnp.zeros((1, d), h.dtype)], axis=0)

    def block(inp):
        tok, g, e = inp
        u = h_pad[tok] @ w1[e] + b1[e]
        gl, up = jnp.split(u.astype(jnp.float32), 2, axis=-1)
        gl = jnp.minimum(gl, SWIGLU_LIMIT)
        up = jnp.clip(up, -SWIGLU_LIMIT, SWIGLU_LIMIT)
        act = (gl * jax.nn.sigmoid(SWIGLU_ALPHA * gl) * (up + 1.0)).astype(h.dtype)
        return ((act @ w2[e] + b2[e]).astype(jnp.float32) * g[:, None]).astype(h.dtype)

    out = lax.map(block, (buf_tok.reshape(n_blk, MOE_BLOCK), buf_g.reshape(n_blk, MOE_BLOCK), blk_e))
    y = jnp.zeros((n + 1, d), h.dtype).at[buf_tok].add(out.reshape(cap, d))
    return y[:n]


def setup_inputs(seed: int = 0) -> dict:
    key = jax.random.key(seed)
    ks = jax.random.split(key, 32)
    f32 = jnp.float32
    D = D_MODEL

    def nrm(k, shape, scale):
        return jax.random.normal(k, shape, f32) * scale

    def gain(k, shape):
        return 1.0 + 0.02 * jax.random.normal(k, shape, f32)

    e_in = sum(EVEN_WIDTHS)
    o_in = sum(ODD_WIDTHS)
    kexp = 5.0 + jnp.arange(RET_HEADS, dtype=f32)
    base_logit = jnp.log(2.0 ** kexp - 1.0)
    return {
        'x': nrm(ks[0], (BATCH, SEQ, D), 1.0),
        'c': nrm(ks[1], (BATCH, D), 1.0),
        'ctx': nrm(ks[2], (BATCH, CTX_LEN, D), 1.0),
        'c_ctx': nrm(ks[3], (D,), 1.0),
        'norm1_g': gain(ks[4], (DEPTH, D)),
        'norm2_g': gain(ks[5], (DEPTH, D)),
        'w_mod': nrm(ks[6], (DEPTH, D, 6 * D), 0.5 * D ** -0.5),
        'b_mod': nrm(ks[7], (DEPTH, 6 * D), 0.01),
        'w_in_even': nrm(ks[8], (N_EVEN, D, e_in), D ** -0.5),
        'w_out_even': nrm(ks[9], (N_EVEN, EVEN_OUT, D), EVEN_OUT ** -0.5),
        'a_q_norm': gain(ks[10], (N_EVEN, HEAD_DIM)),
        'a_k_norm': gain(ks[11], (N_EVEN, HEAD_DIM)),
        'b_q_norm': gain(ks[12], (N_EVEN, HEAD_DIM)),
        'b_k_norm': gain(ks[13], (N_EVEN, HEAD_DIM)),
        'b_rpb': nrm(ks[14], (N_EVEN, NA_HEADS, RPB_SIZE), 0.1),
        'w_in_odd': nrm(ks[15], (N_ODD, D, o_in), D ** -0.5),
        'w_out_odd': nrm(ks[16], (N_ODD, ODD_OUT, D), ODD_OUT ** -0.5),
        'ret_decay': base_logit[None, None, :] + nrm(ks[17], (N_ODD, 2, RET_HEADS), 0.1),
        'ret_gn': gain(ks[18], (N_ODD, RET_HEADS * RET_DV)),
        'mla_cq_norm': gain(ks[19], (N_ODD, MLA_Q_LORA)),
        'mla_ckv_norm': gain(ks[20], (N_ODD, MLA_KV_LORA)),
        'w_uq': nrm(ks[21], (N_ODD, MLA_Q_LORA, MLA_HEADS * (MLA_NOPE + MLA_ROPE)), MLA_Q_LORA ** -0.5),
        'w_ukv': nrm(ks[22], (N_ODD, MLA_KV_LORA, MLA_HEADS * (MLA_NOPE + MLA_V)), MLA_KV_LORA ** -0.5),
        'mla_q_norm': gain(ks[23], (N_ODD, MLA_NOPE + MLA_ROPE)),
        'mla_k_norm': gain(ks[24], (N_ODD, MLA_NOPE + MLA_ROPE)),
        'w_router': nrm(ks[25], (DEPTH, D, N_EXPERTS), D ** -0.5),
        'b_router': nrm(ks[26], (DEPTH, N_EXPERTS), 0.01),
        'w_exp1': nrm(ks[27], (DEPTH, N_EXPERTS, D, 2 * D_FF), D ** -0.5),
        'b_exp1': nrm(ks[28], (DEPTH, N_EXPERTS, 2 * D_FF), 0.01),
        'w_exp2': nrm(ks[29], (DEPTH, N_EXPERTS, D_FF, D), D_FF ** -0.5),
        'b_exp2': nrm(ks[30], (DEPTH, N_EXPERTS, D), 0.01),
    }


def reference(x, c, ctx, c_ctx, norm1_g, norm2_g, w_mod, b_mod, w_in_even, w_out_even, a_q_norm, a_k_norm,
              b_q_norm, b_k_norm, b_rpb, w_in_odd, w_out_odd, ret_decay, ret_gn, mla_cq_norm, mla_ckv_norm,
              w_uq, w_ukv, mla_q_norm, mla_k_norm, w_router, b_router, w_exp1, b_exp1, w_exp2, b_exp2):
    bsz, s, d = x.shape
    cl = ctx.shape[1]
    t = jnp.arange(s)
    rows = (t // GRID_W).astype(jnp.float32)
    cols = (t % GRID_W).astype(jnp.float32)
    rope_a = axial_rope(rows, cols, HEAD_DIM)
    rope_c = axial_rope(rows, cols, RET_DK)
    rope_d = axial_rope(rows, cols, MLA_ROPE)
    nbr_idx, nbr_rel = neighbourhood_tables(s)
    silu_c = jax.nn.silu(c)
    silu_cc = jax.nn.silu(c_ctx)
    x_lat, x_ctx = x, ctx
    for l in range(DEPTH):
        need_ctx = l < DEPTH - 1
        sh1, sc1, g1, sh2, sc2, g2 = jnp.split((silu_c @ w_mod[l] + b_mod[l])[:, None, :], 6, axis=-1)
        csh1, csc1, cg1, csh2, csc2, cg2 = jnp.split(silu_cc @ w_mod[l] + b_mod[l], 6, axis=-1)
        a_lat = modulate(x_lat, norm1_g[l], sh1, sc1)
        a_ctx = modulate(x_ctx, norm1_g[l], csh1, csc1)
        i = l // 2
        if l % 2 == 0:
            o_lat, o_ctx = mixer_even(a_lat, a_ctx, w_in_even[i], w_out_even[i], a_q_norm[i], a_k_norm[i],
                                      b_q_norm[i], b_k_norm[i], b_rpb[i], rope_a, nbr_idx, nbr_rel, need_ctx)
        else:
            o_lat, o_ctx = mixer_odd(a_lat, a_ctx, w_in_odd[i], w_out_odd[i], ret_decay[i], ret_gn[i],
                                     mla_cq_norm[i], mla_ckv_norm[i], w_uq[i], w_ukv[i], mla_q_norm[i],
                                     mla_k_norm[i], rope_c, rope_d, need_ctx)
        x_lat = x_lat + g1 * o_lat
        m_lat = modulate(x_lat, norm2_g[l], sh2, sc2).reshape(bsz * s, d)
        if need_ctx:
            x_ctx = x_ctx + cg1 * o_ctx
            m_ctx = modulate(x_ctx, norm2_g[l], csh2, csc2).reshape(bsz * cl, d)
            y = moe(jnp.concatenate([m_lat, m_ctx], axis=0), w_router[l], b_router[l], w_exp1[l], b_exp1[l], w_exp2[l], b_exp2[l])
            x_lat = x_lat + g2 * y[:bsz * s].reshape(bsz, s, d)
            x_ctx = x_ctx + cg2 * y[bsz * s:].reshape(bsz, cl, d)
        else:
            y = moe(m_lat, w_router[l], b_router[l], w_exp1[l], b_exp1[l], w_exp2[l], b_exp2[l])
            x_lat = x_lat + g2 * y.reshape(bsz, s, d)
    return x_lat
```

```cpp
#include <hip/hip_runtime.h>
#include <cstdio>
#include <cstdint>

#ifndef MK_MULTI
#define MK_MULTI 0
#endif
#ifndef MK_STOP
#define MK_STOP 9999
#endif

#define LAS __attribute__((address_space(3)))
typedef unsigned short bf16;
typedef short bf16x8 __attribute__((ext_vector_type(8)));
typedef short s16x4 __attribute__((ext_vector_type(4)));
typedef float f32x4 __attribute__((ext_vector_type(4)));
typedef float f32x2 __attribute__((ext_vector_type(2)));
typedef float f32x16 __attribute__((ext_vector_type(16)));
typedef unsigned u32x4 __attribute__((ext_vector_type(4)));
typedef unsigned u32x2 __attribute__((ext_vector_type(2)));
typedef int i32x4 __attribute__((ext_vector_type(4)));
typedef int i32x8 __attribute__((ext_vector_type(8)));

constexpr int DM = 1024, NBATCH = 2, SEQ = 16384, CTXL = 256, SP = SEQ + CTXL, NL = NBATCH * SEQ, NCX = NBATCH * CTXL, NTOK = NL + NCX, DEPTH = 4;
constexpr int EIN = 2304, OIN = 2496, OINP = 2560, RAWLD = 2560;
constexpr int NEXP = 32, DFF = 1024, CAP = 141312;
constexpr float EPS = 1e-6f, GN_EPS = 1e-5f, L2T = 13.287712379549449f  , LOG2E = 1.4426950408889634f;
constexpr int NCHUNK = 130;

constexpr size_t al256(size_t x) { return (x + 255) & ~(size_t)255; }
constexpr size_t WS_CTL = 0, CTL_BYTES = 1u << 20;
constexpr size_t WS_MOD = WS_CTL + CTL_BYTES;
constexpr size_t WS_WINE = al256(WS_MOD + (size_t)4 * 3 * 6144 * 4);
constexpr size_t WS_WOUTE = WS_WINE + (size_t)2 * EIN * DM * 2;
constexpr size_t WS_WINO = WS_WOUTE + (size_t)2 * DM * DM * 2;
constexpr size_t WS_WOUTO = WS_WINO + (size_t)2 * OINP * DM * 2;
constexpr size_t WS_WUQ = WS_WOUTO + (size_t)2 * DM * DM * 2;
constexpr size_t WS_WUKV = WS_WUQ + (size_t)2 * 768 * 256 * 2;
constexpr size_t WS_W1 = WS_WUKV + (size_t)2 * 1024 * 256 * 2;
constexpr size_t WS_W2 = WS_W1 + (size_t)4 * 32 * 2048 * 1024 * 2;
constexpr size_t WS_X0 = WS_W2 + (size_t)4 * 32 * 1024 * 1024 * 2;
constexpr size_t WS_X1 = WS_X0 + (size_t)NTOK * DM * 4;
constexpr size_t WS_ACT = WS_X1 + (size_t)NTOK * DM * 4;
constexpr size_t WS_RAW = WS_ACT + (size_t)NTOK * DM * 2;
constexpr size_t WS_OCAT = WS_RAW + (size_t)NTOK * RAWLD * 2;
constexpr size_t SZ_H8 = (size_t)NBATCH * 8 * SP * 64 * 2, SZ_H2 = (size_t)NBATCH * 2 * SP * 64 * 2;
constexpr size_t WS_QA = WS_OCAT + (size_t)NTOK * DM * 2, WS_KA = WS_QA + SZ_H8, WS_VA = WS_KA + SZ_H2, WS_QB = WS_VA + SZ_H2, WS_KB = WS_QB + SZ_H8, WS_VB = WS_KB + SZ_H8;
constexpr size_t SZ_R = (size_t)NBATCH * 4 * SP * 128 * 2, SZ_M192 = (size_t)NBATCH * 4 * SP * 192 * 2;
constexpr size_t WS_RQ = WS_VB + SZ_H8, WS_RK = WS_RQ + SZ_R, WS_RV = WS_RK + SZ_R;
constexpr size_t WS_CQN = WS_RV + SZ_R;
constexpr size_t WS_CKVN = WS_CQN + (size_t)NTOK * 256 * 2;
constexpr size_t WS_QMR = WS_CKVN + (size_t)NTOK * 256 * 2;
constexpr size_t WS_KVR = WS_QMR + (size_t)NTOK * 768 * 2;
constexpr size_t WS_QM = WS_KVR + (size_t)NTOK * 1024 * 2, WS_KM = WS_QM + SZ_M192, WS_VM = WS_KM + SZ_M192;
constexpr size_t WS_KVP = WS_VM + SZ_R;
constexpr size_t WS_STP = WS_KVP + (size_t)2 * 8 * NCHUNK * 16384 * 4;
constexpr size_t WS_TOPE = WS_STP + (size_t)2 * 8 * NCHUNK * 16384 * 2;
constexpr size_t WS_TOPG = WS_TOPE + (size_t)NTOK * 4 * 4;
constexpr size_t WS_TOPR = WS_TOPG + (size_t)NTOK * 4 * 4;
constexpr size_t WS_POS = WS_TOPR + (size_t)NTOK * 4 * 4;
constexpr size_t WS_HIST = WS_POS + (size_t)NTOK * 4 * 4;
constexpr size_t WS_TILEE = WS_HIST + (size_t)1024 * 32 * 4;
constexpr size_t WS_GATES = WS_TILEE + 4096 * 4;
constexpr size_t WS_XS = al256(WS_GATES + (size_t)CAP * 4);
constexpr size_t WS_ACTS = WS_XS + (size_t)CAP * DM * 2;
constexpr size_t WS_CHK = WS_ACTS + (size_t)CAP * DM * 2;
constexpr size_t WS_VTA = WS_CHK + 65536;
constexpr size_t WS_VTM = WS_VTA + (size_t)NBATCH * 2 * 64 * SP;
constexpr size_t WS_RB2 = al256(WS_VTM + (size_t)NBATCH * 4 * 128 * SP);
constexpr size_t WS_LG = WS_RB2 + 4096;
constexpr size_t WS_RW = al256(WS_LG + (size_t)NTOK * 32 * 4);
constexpr size_t RW_IMG = 132096;
constexpr size_t WS_END = WS_RW + (size_t)12 * RW_IMG;

constexpr int CW_BAR = 4096;

constexpr int RING_BYTES = 131072, SCR_OFF = 131072, SCR_BYTES = 8192, MISC_OFF = SCR_OFF + SCR_BYTES, ARG_OFF = MISC_OFF + 4096, LDS_BYTES = 147456;

#define LDS_WAIT() asm volatile("s_waitcnt lgkmcnt(0)" ::: "memory")
#define VM_WAIT() asm volatile("s_waitcnt vmcnt(0)" ::: "memory")
#define SBAR() __builtin_amdgcn_sched_barrier(0)
__device__ __forceinline__ float bf2f(unsigned b) { return __uint_as_float(b << 16); }
__device__ __forceinline__ unsigned f2bf(float f) { unsigned u = __float_as_uint(f); return (u + 0x7fffu + ((u >> 16) & 1u)) >> 16; }
typedef __bf16 bf16v2_t __attribute__((ext_vector_type(2)));
__device__ __forceinline__ unsigned pk2(float lo, float hi) { const f32x2 v = {lo, hi}; const bf16v2_t r = __builtin_convertvector(v, bf16v2_t); return __builtin_bit_cast(unsigned, r); }
__device__ __forceinline__ void unpack8(const u32x4 w, float (&v)[8]) {
    v[0] = __uint_as_float(w.x << 16); v[1] = __uint_as_float(w.x & 0xffff0000u); v[2] = __uint_as_float(w.y << 16); v[3] = __uint_as_float(w.y & 0xffff0000u);
    v[4] = __uint_as_float(w.z << 16); v[5] = __uint_as_float(w.z & 0xffff0000u); v[6] = __uint_as_float(w.w << 16); v[7] = __uint_as_float(w.w & 0xffff0000u); }
__device__ __forceinline__ u32x4 pack8(const float (&v)[8]) { u32x4 w; w.x = pk2(v[0], v[1]); w.y = pk2(v[2], v[3]); w.z = pk2(v[4], v[5]); w.w = pk2(v[6], v[7]); return w; }
__device__ __forceinline__ float shx(float v, int o, int lane) { return __int_as_float(__builtin_amdgcn_ds_bpermute((lane ^ o) << 2, __float_as_int(v))); }
__device__ __forceinline__ int shxi(int v, int o, int lane) { return __builtin_amdgcn_ds_bpermute((lane ^ o) << 2, v); }
template <int CTRL> __device__ __forceinline__ float dppf(float x) { return __builtin_bit_cast(float, __builtin_amdgcn_mov_dpp(__builtin_bit_cast(int, x), CTRL, 0xf, 0xf, true)); }
__device__ __forceinline__ float sum8(float v) { v += dppf<0xB1>(v); v += dppf<0x4E>(v); v += dppf<0x141>(v); return v; }
__device__ __forceinline__ float sum16(float v) { v = sum8(v); v += dppf<0x140>(v); return v; }
__device__ __forceinline__ float sum32(float v) { v = sum16(v); auto r = __builtin_amdgcn_permlane16_swap(__float_as_uint(v), __float_as_uint(v), false, false); return __uint_as_float(r[0]) + __uint_as_float(r[1]); }
__device__ __forceinline__ float wave_sum(float v, int lane) { v = sum32(v); auto r = __builtin_amdgcn_permlane32_swap(__float_as_uint(v), __float_as_uint(v), false, false); return __uint_as_float(r[0]) + __uint_as_float(r[1]); }
__device__ __forceinline__ int crow(int r, int hi) { return (r & 3) + 8 * (r >> 2) + 4 * hi; }
__device__ __forceinline__ int lane_id_v() { int l; asm volatile("v_mbcnt_lo_u32_b32 %0, -1, 0\n\tv_mbcnt_hi_u32_b32 %0, -1, %0" : "=v"(l)); return l; }

#define XB_TMO      128
#define XB_XCNT(j)  (256  + 64 * (j))
#define XB_XSUB(j)  (1280 + 64 * (j))
#define XB_XGEN(j)  (2304 + 64 * (j))
#define XB_TOP      3328
#define XB_TOPGEN   3392
#define XCD_BAR_WORDS 3456
#define XB_SPIN_CAP (1u << 22)
__device__ __forceinline__ unsigned xb_ld(unsigned* p)              { return __hip_atomic_load(p, __ATOMIC_RELAXED, __HIP_MEMORY_SCOPE_AGENT); }
__device__ __forceinline__ unsigned xb_add(unsigned* p, unsigned v) { return __hip_atomic_fetch_add(p, v, __ATOMIC_RELAXED, __HIP_MEMORY_SCOPE_AGENT); }
__device__ __forceinline__ unsigned xb_xcc_id() { return (unsigned)__builtin_amdgcn_s_getreg((3 << 11) | 20) & 0xFu; }
#define XB_SPIN(cond, bar) do { unsigned _sp = 0; while (cond) { __builtin_amdgcn_s_sleep(1); \
    if ((++_sp & 255u) == 0u) { if (xb_ld(&(bar)[XB_TMO])) break; if (_sp > XB_SPIN_CAP) { atomicAdd(&(bar)[XB_TMO], 1u); break; } } } } while (0)
struct XcdBarrier { unsigned* bar; unsigned x; volatile LAS unsigned* st; int wave; };
__device__ __forceinline__ XcdBarrier xcd_barrier_post(unsigned* bar, volatile LAS unsigned* st, int wave) {
    XcdBarrier b; b.bar = bar; b.x = xb_xcc_id(); b.st = st; b.wave = wave;
    if (wave == 0 && lane_id_v() == 0) (void)xb_add(&bar[XB_XCNT(b.x)], 1u);
    return b;
}
__device__ __forceinline__ void xcd_barrier_complete(unsigned* bar, unsigned x, unsigned& nloc, unsigned& nx) {
    const unsigned G = gridDim.x * gridDim.y * gridDim.z;
    unsigned sum, cnt, mine, sp = 0u;
    for (;;) {
        sum = 0u; cnt = 0u; mine = 0u;
#pragma unroll
        for (unsigned j = 0; j < 16; ++j) { const unsigned c = xb_ld(&bar[XB_XCNT(j)]); sum += c; cnt += (c > 0u) ? 1u : 0u; mine = (j == x) ? c : mine; }
        if (sum == G) break;
        __builtin_amdgcn_s_sleep(1);
        if ((++sp & 255u) == 0u) { if (xb_ld(&bar[XB_TMO])) break; if (sp > XB_SPIN_CAP) { atomicAdd(&bar[XB_TMO], 1u); break; } }
    }
    nloc = mine > 0u ? mine : 1u; nx = cnt > 0u ? cnt : 1u;
}
__device__ __forceinline__ void xcd_barrier(const XcdBarrier& b) {
    asm volatile("s_waitcnt vmcnt(0)" ::: "memory");
    __syncthreads();
    if (b.wave == 0 && lane_id_v() == 0) {
        unsigned* bar = b.bar;
        __builtin_amdgcn_s_waitcnt(0);
        unsigned nloc = b.st[0], nx = b.st[1];
        if (nloc == 0u) { xcd_barrier_complete(bar, b.x, nloc, nx); b.st[0] = nloc; b.st[1] = nx; }
        const unsigned old = xb_add(&bar[XB_XSUB(b.x)], 1u);
        const unsigned gen = old / nloc;
        if (old + 1u == (gen + 1u) * nloc) {
            __builtin_amdgcn_fence(__ATOMIC_RELEASE, "agent");
            asm volatile("s_waitcnt vmcnt(0)" ::: "memory");
            const unsigned og = xb_add(&bar[XB_TOP], 1u);
            const unsigned tg = og / nx;
            if (og + 1u == (tg + 1u) * nx) xb_add(&bar[XB_TOPGEN], 1u);
            else XB_SPIN(xb_ld(&bar[XB_TOPGEN]) == tg, bar);
            __builtin_amdgcn_fence(__ATOMIC_ACQUIRE, "agent");
            xb_add(&bar[XB_XGEN(b.x)], 1u);
            asm volatile("s_waitcnt vmcnt(0)" ::: "memory");
        } else {
            XB_SPIN(xb_ld(&bar[XB_XGEN(b.x)]) == gen, bar);
            __builtin_amdgcn_fence(__ATOMIC_ACQUIRE, "agent");
            asm volatile("s_waitcnt vmcnt(0)" ::: "memory");
        }
    }
    __syncthreads();
}

namespace pg8 {
constexpr int BM = 256, BK = 64, HALF = 128, HTB = HALF * BK * 2, STAGE_BYTES = 8 * HTB, NXCD = 8, WGM = 8;
__device__ __forceinline__ void glds16(const void* base, unsigned voff, unsigned lds_dst) {
    unsigned keep;
    lds_dst = (unsigned)__builtin_amdgcn_readfirstlane((int)lds_dst);
    const unsigned long long b64 = (unsigned long long)base;
    const unsigned long long bu = ((unsigned long long)(unsigned)__builtin_amdgcn_readfirstlane((int)(b64 >> 32)) << 32) | (unsigned)__builtin_amdgcn_readfirstlane((int)b64);
    asm volatile("s_mov_b32 %0, m0\n\ts_mov_b32 m0, %3\n\ts_nop 0\n\tglobal_load_lds_dwordx4 %1, %2\n\ts_mov_b32 m0, %0" : "=&s"(keep) : "v"(voff), "s"(bu), "s"(lds_dst) : "memory");
}
__host__ __device__ __forceinline__ int lds_byte(int r, int c) { const int st = (r >> 4) * 2 + (c >> 5), rr = r & 15, cc = c & 31, ob = rr * 64 + cc * 2; return st * 1024 + (ob ^ (((ob >> 9) & 1) << 5)); }
__host__ __device__ __forceinline__ void stage_rc(int b, int& R, int& C) { const int st = b / 1024, sb = b % 1024, swz = sb ^ (((sb >> 9) & 1) << 5); R = (st >> 1) * 16 + swz / 64; C = (st & 1) * 32 + (swz % 64) / 2; }
__host__ __device__ __forceinline__ int perm32(int rho) { const int n = rho >> 4, i = rho & 15; return 8 * (i >> 2) + 4 * n + (i & 3); }

struct Unit { int pm, pn, e; };
struct Gemm { const bf16* A; const bf16* Bt; int K; size_t bexp; };

struct StaticOrder {
    int nM, nN, nwg, G, c;
    __device__ void init(int M, int N, int G_, int c_) { nM = M / BM; nN = N / BM; nwg = nM * nN; G = G_; c = c_; }
    __device__ bool next(int i, Unit& u) const {
        const long L = (long)i * G + c; if (L >= nwg) return false;
        int wgid = (int)L; { const int q = nwg / NXCD, r = nwg % NXCD, xcd = wgid % NXCD, off = wgid / NXCD; wgid = (xcd < r ? xcd * (q + 1) : r * (q + 1) + (xcd - r) * q) + off; }
        const int nig = WGM * nN, gid = wgid / nig, fm = gid * WGM, gsz = (nM - fm) < WGM ? (nM - fm) : WGM;
        u.pm = fm + ((wgid % nig) % gsz); u.pn = (wgid % nig) / gsz; u.e = 0; return true;
    }
};
struct MoeOrder {
    const LAS int* lte; int ntiles, nN, G, c;
    __device__ __forceinline__ void init(const int* te, int nN_, int G_, int c_, LAS int* lds_te, int tid) {
        ntiles = __builtin_amdgcn_readfirstlane(te[0]); nN = nN_; G = G_; c = c_; lte = lds_te;
        for (int i = tid; i <= ntiles; i += 512) lds_te[i] = te[i];
        __syncthreads();
    }
    __device__ __forceinline__ bool next(int i, Unit& u) const {
        int pm, pn;
        if (G == 256) { const int pmr = 256 / nN, x = c & 7, a = c >> 3; pm = i * pmr + x * (pmr >> 3) + a / nN; pn = a % nN; }
        else { const long L = (long)i * G + c; pm = (int)(L / nN); pn = (int)(L % nN); }
        if (pm >= ntiles) return false;
        u.pm = pm; u.pn = pn; u.e = __builtin_amdgcn_readfirstlane(lte[1 + pm]); return true;
    }
};

struct EpiKeep {
    static constexpr bool PERM = true; static constexpr int NST = 0;
    __device__ __forceinline__ void prefetch(const Unit& u, unsigned ldsa, int wid, int lane) const {}
    template <int AI> __device__ __forceinline__ void half(const f32x4 (&acc)[2][2][4][2], const Unit& u, int wr, int wc, int fr, int fq, const LAS unsigned char* bl) const {
#pragma unroll
        for (int bj = 0; bj < 2; ++bj)
#pragma unroll
            for (int m = 0; m < 4; ++m) asm volatile("" :: "v"(acc[AI][bj][m][0]), "v"(acc[AI][bj][m][1]));
    }
    __device__ __forceinline__ void operator()(const f32x4 (&acc)[2][2][4][2], const Unit& u, int wr, int wc, int fr, int fq) const {
#pragma unroll
        for (int ai = 0; ai < 2; ++ai)
#pragma unroll
            for (int bj = 0; bj < 2; ++bj)
#pragma unroll
                for (int m = 0; m < 4; ++m) asm volatile("" :: "v"(acc[ai][bj][m][0]), "v"(acc[ai][bj][m][1]));
    }
};
struct EpiBf16 {
    static constexpr bool PERM = true; static constexpr int NST = 8;
    bf16* O; int ldc; float sc;
    __device__ __forceinline__ void prefetch(const Unit& u, unsigned ldsa, int wid, int lane) const {}
    template <int AI> __device__ __forceinline__ void half(const f32x4 (&acc)[2][2][4][2], const Unit& u, int wr, int wc, int fr, int fq, const LAS unsigned char* bl) const {
        const int row0 = u.pm * BM + wr * 64 + fr, col0 = u.pn * BM + wc * 32 + 8 * fq;
        char* Ob = (char*)O; const unsigned ld2 = (unsigned)ldc * 2u; const unsigned off = (unsigned)row0 * ld2 + (unsigned)col0 * 2u;
#pragma unroll
        for (int m = 0; m < 4; ++m) { const unsigned ro = off + (unsigned)(AI * HALF + m * 16) * ld2;
#pragma unroll
            for (int bj = 0; bj < 2; ++bj) { const f32x4 v0 = acc[AI][bj][m][0] * sc, v1 = acc[AI][bj][m][1] * sc;
                u32x4 w; w.x = pk2(v0[0], v0[1]); w.y = pk2(v0[2], v0[3]); w.z = pk2(v1[0], v1[1]); w.w = pk2(v1[2], v1[3]);
                *(u32x4*)(Ob + ro + bj * HALF * 2) = w; } }
    }
    __device__ __forceinline__ void operator()(const f32x4 (&acc)[2][2][4][2], const Unit& u, int wr, int wc, int fr, int fq) const {
        const int row0 = u.pm * BM + wr * 64 + fr, col0 = u.pn * BM + wc * 32 + 8 * fq;
        char* Ob = (char*)O; const unsigned ld2 = (unsigned)ldc * 2u; unsigned off = (unsigned)row0 * ld2 + (unsigned)col0 * 2u;
#pragma unroll
        for (int ai = 0; ai < 2; ++ai)
#pragma unroll
            for (int m = 0; m < 4; ++m) { const unsigned ro = off + (unsigned)(ai * HALF + m * 16) * ld2;
#pragma unroll
                for (int bj = 0; bj < 2; ++bj) { const f32x4 v0 = acc[ai][bj][m][0] * sc, v1 = acc[ai][bj][m][1] * sc;
                    u32x4 w; w.x = pk2(v0[0], v0[1]); w.y = pk2(v0[2], v0[3]); w.z = pk2(v1[0], v1[1]); w.w = pk2(v1[2], v1[3]);
                    *(u32x4*)(Ob + ro + bj * HALF * 2) = w; } }
    }
};
struct EpiRes {
    static constexpr bool PERM = false;
    const bf16* base; bf16* out; const float* gate;
    __device__ __forceinline__ void operator()(const f32x4 (&acc)[2][2][4][2], const Unit& u, int wr, int wc, int fr, int fq) const {
        const int row0 = u.pm * BM + wr * 64 + fr, col0 = u.pn * BM + wc * 32 + 4 * fq;
        const int mrow = u.pm < 128 ? (u.pm >> 6) : 2;
        const float* gp = gate + (size_t)mrow * 6144 + col0;
        f32x4 gv[2][2];
#pragma unroll
        for (int bj = 0; bj < 2; ++bj)
#pragma unroll
            for (int n = 0; n < 2; ++n) gv[bj][n] = *(const f32x4*)(gp + bj * HALF + n * 16);
        const int odd = fq & 1;
#pragma unroll
        for (int ai = 0; ai < 2; ++ai)
#pragma unroll
            for (int mp = 0; mp < 2; ++mp) { const size_t off = (size_t)(row0 + ai * HALF + (2 * mp + odd) * 16) * DM + (col0 - 4 * odd);
#pragma unroll
                for (int bj = 0; bj < 2; ++bj)
#pragma unroll
                    for (int n = 0; n < 2; ++n) { const f32x4 pa = gv[bj][n] * acc[ai][bj][2 * mp][n], pb = gv[bj][n] * acc[ai][bj][2 * mp + 1][n];
                        f32x4 lo4, hi4;
#pragma unroll
                        for (int i = 0; i < 4; ++i) { const auto sw = __builtin_amdgcn_permlane16_swap(__float_as_uint(pa[i]), __float_as_uint(pb[i]), false, false); lo4[i] = __uint_as_float(sw[0]); hi4[i] = __uint_as_float(sw[1]); }
                        const u32x4 bw = *(const u32x4*)(base + off + bj * HALF + n * 16);
                        const f32x4 b0 = {__uint_as_float(bw.x << 16), __uint_as_float(bw.x & 0xffff0000u), __uint_as_float(bw.y << 16), __uint_as_float(bw.y & 0xffff0000u)};
                        const f32x4 b1 = {__uint_as_float(bw.z << 16), __uint_as_float(bw.z & 0xffff0000u), __uint_as_float(bw.w << 16), __uint_as_float(bw.w & 0xffff0000u)};
                        const f32x4 r0 = b0 + lo4, r1 = b1 + hi4;
                        u32x4 w; w.x = pk2(r0[0], r0[1]); w.y = pk2(r0[2], r0[3]); w.z = pk2(r1[0], r1[1]); w.w = pk2(r1[2], r1[3]); *(u32x4*)(out + off + bj * HALF + n * 16) = w; } }
    }
};
__device__ __forceinline__ float swiglu1(float g, float up) {
    g = fminf(g, 7.0f); up = fminf(fmaxf(up, -7.0f), 7.0f);
    const float sg = __builtin_amdgcn_rcpf(1.0f + __builtin_amdgcn_exp2f(-1.702f * LOG2E * g));
    return g * sg * (up + 1.0f);
}
struct EpiSwiGLU {
    static constexpr bool PERM = true;
    bf16* O; const float* b1;
    __device__ __forceinline__ void operator()(const f32x4 (&acc)[2][2][4][2], const Unit& u, int wr, int wc, int fr, int fq) const {
        const int row0 = u.pm * BM + wr * 64 + fr, colo = u.pn * HALF + wc * 32 + 8 * fq;
        const float* bg = b1 + (size_t)u.e * 2048 + colo;
        f32x4 bgv[2], buv[2];
#pragma unroll
        for (int n = 0; n < 2; ++n) { bgv[n] = *(const f32x4*)(bg + 4 * n); buv[n] = *(const f32x4*)(bg + 1024 + 4 * n); }
#pragma unroll
        for (int ai = 0; ai < 2; ++ai)
#pragma unroll
            for (int m = 0; m < 4; ++m) { bf16* rowp = O + (size_t)(row0 + ai * HALF + m * 16) * DM + colo;
                float o[8];
#pragma unroll
                for (int n = 0; n < 2; ++n) { const f32x4 g = acc[ai][0][m][n] + bgv[n], up = acc[ai][1][m][n] + buv[n];
#pragma unroll
                    for (int j = 0; j < 4; ++j) o[4 * n + j] = swiglu1(g[j], up[j]); }
                *(u32x4*)rowp = pack8(o); }
    }
};
struct EpiMoe2 {
    static constexpr bool PERM = true;
    bf16* O; const float* b2; const float* gate_s;
    __device__ __forceinline__ void operator()(const f32x4 (&acc)[2][2][4][2], const Unit& u, int wr, int wc, int fr, int fq) const {
        const int row0 = u.pm * BM + wr * 64 + fr, col0 = u.pn * BM + wc * 32 + 8 * fq;
        const float* bp = b2 + (size_t)u.e * 1024 + col0;
        f32x4 bv[2][2];
#pragma unroll
        for (int bj = 0; bj < 2; ++bj)
#pragma unroll
            for (int n = 0; n < 2; ++n) bv[bj][n] = *(const f32x4*)(bp + bj * HALF + 4 * n);
#pragma unroll
        for (int ai = 0; ai < 2; ++ai)
#pragma unroll
            for (int m = 0; m < 4; ++m) { const int row = row0 + ai * HALF + m * 16; const float gt = gate_s[row]; bf16* rowp = O + (size_t)row * DM + col0;
#pragma unroll
                for (int bj = 0; bj < 2; ++bj) { const f32x4 v0 = (acc[ai][bj][m][0] + bv[bj][0]) * gt, v1 = (acc[ai][bj][m][1] + bv[bj][1]) * gt;
                    u32x4 w; w.x = pk2(v0[0], v0[1]); w.y = pk2(v0[2], v0[3]); w.z = pk2(v1[0], v1[1]); w.w = pk2(v1[2], v1[3]);
                    *(u32x4*)(rowp + bj * HALF) = w; } }
    }
};


__device__ __forceinline__ unsigned pk4_fp8(float a, float b, float c, float d) { unsigned w = __float_as_uint(a);
    w = __builtin_amdgcn_cvt_pk_fp8_f32(a, b, w, false); w = __builtin_amdgcn_cvt_pk_fp8_f32(c, d, w, true); return w; }
__device__ __forceinline__ unsigned pk4_bf8(float a, float b, float c, float d) { unsigned w = __float_as_uint(a);
    w = __builtin_amdgcn_cvt_pk_bf8_f32(a, b, w, false); w = __builtin_amdgcn_cvt_pk_bf8_f32(c, d, w, true); return w; }
struct EpiSwiGLU8 {
    static constexpr bool PERM = true; static constexpr int NST = 2;
    unsigned char* O; const float* b1;
    __device__ __forceinline__ void prefetch(const Unit& u, unsigned ldsa, int wid, int lane) const {
        if (wid == 0) glds16((const void*)(b1 + (size_t)u.e * 2048 + u.pn * HALF), (unsigned)(lane < 32 ? lane * 16 : 4096 + (lane - 32) * 16), ldsa);
    }
    template <int AI> __device__ __forceinline__ void half(const f32x4 (&acc)[2][2][4][2], const Unit& u, int wr, int wc, int fr, int fq, const LAS unsigned char* bl) const {
        const int colo = u.pn * HALF + wc * 32 + 8 * fq, cl = wc * 32 + 8 * fq;
        f32x4 bgv[2], buv[2];
#pragma unroll
        for (int n = 0; n < 2; ++n) { bgv[n] = *(const LAS f32x4*)(bl + (cl + 4 * n) * 4); buv[n] = *(const LAS f32x4*)(bl + 512 + (cl + 4 * n) * 4) + 1.0f; }
        unsigned char* Ob = O + (size_t)(u.pm * BM) * DM; const unsigned off = (unsigned)(wr * 64 + fr + AI * HALF + (fq & 1) * 16) * DM + (unsigned)(colo - 8 * (fq & 1));
#pragma unroll
        for (int mp = 0; mp < 2; ++mp) { u32x2 w[2];
#pragma unroll
            for (int q = 0; q < 2; ++q) { const int m = 2 * mp + q; float o[8];
#pragma unroll
                for (int n = 0; n < 2; ++n) { const f32x4 g4 = acc[AI][0][m][n] * 0.03125f + bgv[n], u4 = acc[AI][1][m][n] * 0.03125f + buv[n];
#pragma unroll
                    for (int j = 0; j < 4; ++j) { const float g = fminf(g4[j], 7.0f), u1 = __builtin_amdgcn_fmed3f(u4[j], -6.0f, 8.0f);
                        const float r4 = __builtin_amdgcn_rcpf(0.25f + __builtin_amdgcn_exp2f(__builtin_fmaf(g, -1.702f * LOG2E, -2.0f)));
                        o[4 * n + j] = g * r4 * u1; } }
                w[q].x = pk4_fp8(o[0], o[1], o[2], o[3]); w[q].y = pk4_fp8(o[4], o[5], o[6], o[7]); }
            const auto sx = __builtin_amdgcn_permlane16_swap(w[0].x, w[1].x, false, false), sy = __builtin_amdgcn_permlane16_swap(w[0].y, w[1].y, false, false);
            u32x4 o4; o4.x = sx[0]; o4.y = sy[0]; o4.z = sx[1]; o4.w = sy[1];
            *(u32x4*)(Ob + off + (unsigned)(mp * 32) * DM) = o4; }
    }
    __device__ __forceinline__ void operator()(const f32x4 (&acc)[2][2][4][2], const Unit& u, int wr, int wc, int fr, int fq) const {
        const int row0 = u.pm * BM + wr * 64 + fr, colo = u.pn * HALF + wc * 32 + 8 * fq;
        const float* bg = b1 + (size_t)u.e * 2048 + colo;
        f32x4 bgv[2], buv[2];
#pragma unroll
        for (int n = 0; n < 2; ++n) { bgv[n] = *(const f32x4*)(bg + 4 * n); buv[n] = *(const f32x4*)(bg + 1024 + 4 * n); }
#pragma unroll
        for (int ai = 0; ai < 2; ++ai)
#pragma unroll
            for (int m = 0; m < 4; ++m) { unsigned char* rowp = O + (size_t)(row0 + ai * HALF + m * 16) * DM + colo;
                float o[8];
#pragma unroll
                for (int n = 0; n < 2; ++n) { const f32x4 g = acc[ai][0][m][n] * 0.03125f + bgv[n], up = acc[ai][1][m][n] * 0.03125f + buv[n];
#pragma unroll
                    for (int j = 0; j < 4; ++j) o[4 * n + j] = 4.0f * swiglu1(g[j], up[j]); }
                u32x2 w; w.x = pk4_fp8(o[0], o[1], o[2], o[3]); w.y = pk4_fp8(o[4], o[5], o[6], o[7]);
                *(u32x2*)rowp = w; }
    }
};
struct EpiMoe2F8 {
    static constexpr bool PERM = true; static constexpr int NST = 4;
    unsigned char* O; const float* b2; const float* gate_s;
    __device__ __forceinline__ void prefetch(const Unit& u, unsigned ldsa, int wid, int lane) const {
        if (wid == 0) glds16((const void*)(b2 + (size_t)u.e * 1024 + u.pn * BM), (unsigned)(lane * 16), ldsa);
        if (wid == 1) glds16((const void*)(gate_s + (size_t)u.pm * BM), (unsigned)(lane * 16), ldsa + 1024u);
    }
    template <int AI> __device__ __forceinline__ void half(const f32x4 (&acc)[2][2][4][2], const Unit& u, int wr, int wc, int fr, int fq, const LAS unsigned char* bl) const {
        const int col0 = u.pn * BM + wc * 32 + 8 * fq, cl = wc * 32 + 8 * fq;
        unsigned char* Ob = O + (size_t)(u.pm * BM) * DM; const unsigned off = (unsigned)(wr * 64 + fr + AI * HALF + (fq & 1) * 16) * DM + (unsigned)(col0 - 8 * (fq & 1));
#pragma unroll
        for (int bj = 0; bj < 2; ++bj) {
            const f32x4 b0 = *(const LAS f32x4*)(bl + (bj * HALF + cl) * 4) * 32.0f, b1 = *(const LAS f32x4*)(bl + (bj * HALF + cl + 4) * 4) * 32.0f;
#pragma unroll
            for (int mp = 0; mp < 2; ++mp) { u32x2 w[2];
#pragma unroll
                for (int q = 0; q < 2; ++q) { const int m = 2 * mp + q; const float gt = *(const LAS float*)(bl + 1024 + (AI * HALF + wr * 64 + m * 16 + fr) * 4);
                    const f32x4 v0 = (acc[AI][bj][m][0] * 0.25f + b0) * gt, v1 = (acc[AI][bj][m][1] * 0.25f + b1) * gt;
                    w[q].x = pk4_fp8(v0[0], v0[1], v0[2], v0[3]); w[q].y = pk4_fp8(v1[0], v1[1], v1[2], v1[3]); }
                const auto sx = __builtin_amdgcn_permlane16_swap(w[0].x, w[1].x, false, false), sy = __builtin_amdgcn_permlane16_swap(w[0].y, w[1].y, false, false);
                u32x4 o; o.x = sx[0]; o.y = sy[0]; o.z = sx[1]; o.w = sy[1];
                *(u32x4*)(Ob + off + (unsigned)(mp * 32) * DM + bj * HALF) = o; } }
    }
    __device__ __forceinline__ void operator()(const f32x4 (&acc)[2][2][4][2], const Unit& u, int wr, int wc, int fr, int fq) const {
        const int row0 = u.pm * BM + wr * 64 + fr, col0 = u.pn * BM + wc * 32 + 8 * fq;
        const float* bp = b2 + (size_t)u.e * 1024 + col0;
        f32x4 bv[2][2];
#pragma unroll
        for (int bj = 0; bj < 2; ++bj)
#pragma unroll
            for (int n = 0; n < 2; ++n) bv[bj][n] = *(const f32x4*)(bp + bj * HALF + 4 * n) * 32.0f;
#pragma unroll
        for (int ai = 0; ai < 2; ++ai)
#pragma unroll
            for (int m = 0; m < 4; ++m) { const int row = row0 + ai * HALF + m * 16; const float gt = gate_s[row]; unsigned char* rowp = O + (size_t)row * DM + col0;
#pragma unroll
                for (int bj = 0; bj < 2; ++bj) { const f32x4 v0 = (acc[ai][bj][m][0] * 0.25f + bv[bj][0]) * gt, v1 = (acc[ai][bj][m][1] * 0.25f + bv[bj][1]) * gt;
                    u32x2 w; w.x = pk4_fp8(v0[0], v0[1], v0[2], v0[3]); w.y = pk4_fp8(v1[0], v1[1], v1[2], v1[3]);
                    *(u32x2*)(rowp + bj * HALF) = w; } }
    }
};
template <class Epi, class Sched>
__device__ __forceinline__ void gemm_phase(LAS unsigned char* lds, const Gemm g, const Sched& S, const Epi& E, const int wid_in) {
    const int wid = __builtin_amdgcn_readfirstlane(wid_in);
    int lane = lane_id_v(); asm volatile("" : "+v"(lane));
    const int tid = wid * 64 + lane, wr = wid >> 2, wc = wid & 3, fr = lane & 15, fq = lane >> 4;
    const int K = g.K, nt = K / BK;
    unsigned voffA[2], voffB[2];
#pragma unroll
    for (int i = 0; i < 2; ++i) { int R, C; stage_rc(tid * 16 + i * 8192, R, C); const int Rb = Epi::PERM ? ((R & ~31) + perm32(R & 31)) : R;
        voffA[i] = (unsigned)(R * K + C) * 2u; voffB[i] = (unsigned)(Rb * K + C) * 2u; }
    const size_t kstep = (size_t)(BK * 2);
    const size_t hstep = (size_t)HALF * K * 2;
    const size_t tstep = 2 * hstep;
    const unsigned ldsb = (unsigned)(size_t)lds + (unsigned)wid * 1024u;
    const int aoff = lds_byte(wr * 64 + fr, fq * 8), boff = lds_byte(wc * 32 + fr, fq * 8);
#define PG8_SA(b, h) (((b) * 2 + (h)) * HTB)
#define PG8_SB(b, h) ((4 + (b) * 2 + (h)) * HTB)
#define PG8_STAGE(bufoff, gbase, voff) do { _Pragma("unroll") for (int _i = 0; _i < 2; ++_i) \
        glds16((const void*)(gbase), (voff)[_i], ldsb + (unsigned)(bufoff) + (unsigned)(_i * 8192)); } while (0)
#define PG8_LDA(dst, b, h) do { _Pragma("unroll") for (int m = 0; m < 4; ++m) _Pragma("unroll") for (int k = 0; k < 2; ++k) dst[m][k] = *(const LAS bf16x8*)(lds + PG8_SA(b, h) + aoff + m * 2048 + k * 1024); } while (0)
#define PG8_LDB(dst, b, h) do { _Pragma("unroll") for (int n = 0; n < 2; ++n) _Pragma("unroll") for (int k = 0; k < 2; ++k) dst[n][k] = *(const LAS bf16x8*)(lds + PG8_SB(b, h) + boff + n * 2048 + k * 1024); } while (0)
#define PG8_MMA(ai, bj, At, Bt) do { __builtin_amdgcn_s_setprio(1); _Pragma("unroll") for (int m = 0; m < 4; ++m) _Pragma("unroll") for (int n = 0; n < 2; ++n) _Pragma("unroll") for (int k = 0; k < 2; ++k) \
        acc[ai][bj][m][n] = __builtin_amdgcn_mfma_f32_16x16x32_bf16(Bt[n][k], At[m][k], acc[ai][bj][m][n], 0, 0, 0); __builtin_amdgcn_s_setprio(0); } while (0)
#define PG8_WAIT_V(n) asm volatile("s_waitcnt vmcnt(" #n ")" ::: "memory")
#define PG8_WAIT_L(n) asm volatile("s_waitcnt lgkmcnt(" #n ")" ::: "memory")
#define PG8_BAR __builtin_amdgcn_s_barrier()
#define PG8_SCHED __builtin_amdgcn_sched_barrier(0)
    Unit cur, nxt; int ui = 0;
    if (!S.next(0, cur)) return;
    cur.pm = __builtin_amdgcn_readfirstlane(cur.pm); cur.pn = __builtin_amdgcn_readfirstlane(cur.pn); cur.e = __builtin_amdgcn_readfirstlane(cur.e);
    f32x4 acc[2][2][4][2];
#pragma unroll
    for (int a = 0; a < 2; ++a)
#pragma unroll
        for (int b = 0; b < 2; ++b)
#pragma unroll
            for (int m = 0; m < 4; ++m)
#pragma unroll
                for (int n = 0; n < 2; ++n) acc[a][b][m][n] = (f32x4){0.f, 0.f, 0.f, 0.f};
    bf16x8 At[4][2], B0[2][2], B1[2][2];
    const char* cA = (const char*)g.A + (size_t)cur.pm * tstep; const char* cB = (const char*)g.Bt + (size_t)cur.e * g.bexp + (size_t)cur.pn * tstep;
    PG8_STAGE(PG8_SB(0, 0), cB, voffB); PG8_STAGE(PG8_SB(0, 1), cB + hstep, voffB); PG8_STAGE(PG8_SA(0, 0), cA, voffA); PG8_STAGE(PG8_SA(0, 1), cA + hstep, voffA);
    if (wr == 1) PG8_BAR;
    PG8_WAIT_V(2); PG8_BAR;
    PG8_STAGE(PG8_SB(1, 0), cB + kstep, voffB); PG8_STAGE(PG8_SA(1, 0), cA + kstep, voffA); PG8_STAGE(PG8_SB(1, 1), cB + hstep + kstep, voffB);
    PG8_WAIT_V(6); PG8_BAR;
    for (;;) {
        const bool has_next = S.next(ui + 1, nxt);
        nxt.pm = __builtin_amdgcn_readfirstlane(nxt.pm); nxt.pn = __builtin_amdgcn_readfirstlane(nxt.pn); nxt.e = __builtin_amdgcn_readfirstlane(nxt.e);
        const char* nA = has_next ? (const char*)g.A + (size_t)nxt.pm * tstep : cA; const char* nB = has_next ? (const char*)g.Bt + (size_t)nxt.e * g.bexp + (size_t)nxt.pn * tstep : cB;
#pragma nounroll
        for (int t = 0; t < nt; t += 2) {
            const bool last = (t == nt - 2);
            const char* a1 = cA + (size_t)(t + 1) * kstep;
            const char* a2 = last ? nA : cA + (size_t)(t + 2) * kstep; const char* b2 = last ? nB : cB + (size_t)(t + 2) * kstep;
            const char* a3 = a2 + kstep; const char* b3 = b2 + kstep;
            PG8_LDB(B0, 0, 0); PG8_LDB(B1, 0, 1); PG8_SCHED; PG8_LDA(At, 0, 0); PG8_STAGE(PG8_SA(1, 1), a1 + hstep, voffA);
            PG8_WAIT_V(8); PG8_WAIT_L(0); PG8_BAR; PG8_MMA(0, 0, At, B0); PG8_MMA(0, 1, At, B1); PG8_BAR; PG8_SCHED;
            PG8_LDA(At, 0, 1); PG8_STAGE(PG8_SB(0, 0), b2, voffB); PG8_STAGE(PG8_SB(0, 1), b2 + hstep, voffB); PG8_STAGE(PG8_SA(0, 0), a2, voffA);
            PG8_WAIT_V(8); PG8_WAIT_L(0); PG8_BAR; PG8_MMA(1, 0, At, B0); PG8_MMA(1, 1, At, B1); PG8_BAR; PG8_SCHED;
            PG8_LDB(B0, 1, 0); PG8_LDB(B1, 1, 1); PG8_SCHED; PG8_LDA(At, 1, 0); PG8_STAGE(PG8_SA(0, 1), a2 + hstep, voffA);
            PG8_WAIT_V(8); PG8_WAIT_L(0); PG8_BAR; PG8_MMA(0, 0, At, B0); PG8_MMA(0, 1, At, B1); PG8_BAR; PG8_SCHED;
            PG8_LDA(At, 1, 1); PG8_STAGE(PG8_SB(1, 0), b3, voffB); PG8_STAGE(PG8_SB(1, 1), b3 + hstep, voffB); PG8_STAGE(PG8_SA(1, 0), a3, voffA);
            PG8_WAIT_V(8); PG8_WAIT_L(0); PG8_BAR; PG8_MMA(1, 0, At, B0); PG8_MMA(1, 1, At, B1); PG8_BAR; PG8_SCHED;
        }
        if (wr == 0) PG8_BAR;
        { int ln2 = lane_id_v(); asm volatile("" : "+v"(ln2));
          E(acc, cur, wr, wc, ln2 & 15, ln2 >> 4); }
        if (!has_next) break;
#pragma unroll
        for (int a = 0; a < 2; ++a)
#pragma unroll
            for (int b = 0; b < 2; ++b)
#pragma unroll
                for (int m = 0; m < 4; ++m)
#pragma unroll
                    for (int n = 0; n < 2; ++n) acc[a][b][m][n] = (f32x4){0.f, 0.f, 0.f, 0.f};
        cur = nxt; cA = nA; cB = nB; ++ui;
        if (wr == 1) PG8_BAR;
    }
    PG8_WAIT_V(0);
    PG8_BAR;
#undef PG8_SA
#undef PG8_SB
#undef PG8_STAGE
#undef PG8_LDA
#undef PG8_LDB
#undef PG8_MMA
#undef PG8_MMAZ
#undef PG8_WAIT_V
#undef PG8_WAIT_L
#undef PG8_BAR
#undef PG8_SCHED
}
__device__ __forceinline__ f32x4 zero4() { f32x4 z; asm volatile("v_mov_b32 %0, 0\n\tv_mov_b32 %1, 0\n\tv_mov_b32 %2, 0\n\tv_mov_b32 %3, 0" : "=v"(z.x), "=v"(z.y), "=v"(z.z), "=v"(z.w)); return z; }
__device__ __forceinline__ void zero4_inplace(f32x4& v) {
    asm volatile("v_and_b32 %0, 0, %0\n\tv_and_b32 %1, 0, %1\n\tv_and_b32 %2, 0, %2\n\tv_and_b32 %3, 0, %3" : "+v"(v.x), "+v"(v.y), "+v"(v.z), "+v"(v.w));
}
template <class Epi, class Sched>
__device__ __forceinline__ void gemm_phase_f8(LAS unsigned char* lds, const Gemm g, const Sched& S, const Epi& E, const int wid_in) {
    const int wid = __builtin_amdgcn_readfirstlane(wid_in);
    int lane = lane_id_v(); asm volatile("" : "+v"(lane));
    const int tid = wid * 64 + lane, wr = wid >> 2, wc = wid & 3, fr = lane & 15, fq = lane >> 4;
    const int K = g.K, nt = K / BK;
    unsigned voffA, voffB;
    { int R, C; stage_rc(tid * 16, R, C); const int Rb = Epi::PERM ? ((R & ~31) + perm32(R & 31)) : R; voffA = (unsigned)(R * K + C) * 2u; voffB = (unsigned)(Rb * K + C) * 2u; }
    const size_t r64 = (size_t)64 * K * 2;
    const size_t kstep = (size_t)(BK * 2);
    const size_t hstep = (size_t)HALF * K * 2;
    const size_t tstep = 2 * hstep;
    const unsigned ldsb = (unsigned)(size_t)lds + (unsigned)wid * 1024u;
    const int aoff0 = lds_byte(wr * 64 + fr, fq * 16), boff0 = lds_byte(wc * 32 + fr, fq * 16);
#define PG8_SA(b, h) (((b) * 2 + (h)) * HTB)
#define PG8_SB(b, h) ((4 + (b) * 2 + (h)) * HTB)
#define PG8_STAGE(bufoff, gbase, voff) do { \
        glds16((const void*)(gbase), (voff), ldsb + (unsigned)(bufoff)); \
        glds16((const void*)((const char*)(gbase) + r64), (voff), ldsb + (unsigned)(bufoff) + 8192u); } while (0)
#define PG8_LDA(dst, b, h) do { _Pragma("unroll") for (int m = 0; m < 4; ++m) { const i32x4 lo_ = *(const LAS i32x4*)(lds + PG8_SA(b, h) + aoff0 + m * 2048), hi_ = *(const LAS i32x4*)(lds + PG8_SA(b, h) + aoff0 + 16 + m * 2048); dst[m] = __builtin_shufflevector(lo_, hi_, 0, 1, 2, 3, 4, 5, 6, 7); } } while (0)
#define PG8_LDB(dst, b, h) do { _Pragma("unroll") for (int n = 0; n < 2; ++n) { const i32x4 lo_ = *(const LAS i32x4*)(lds + PG8_SB(b, h) + boff0 + n * 2048), hi_ = *(const LAS i32x4*)(lds + PG8_SB(b, h) + boff0 + 16 + n * 2048); dst[n] = __builtin_shufflevector(lo_, hi_, 0, 1, 2, 3, 4, 5, 6, 7); } } while (0)
#define PG8_MMA(ai, bj, At, Bt) do { __builtin_amdgcn_s_setprio(1); _Pragma("unroll") for (int m = 0; m < 4; ++m) _Pragma("unroll") for (int n = 0; n < 2; ++n) \
        acc[ai][bj][m][n] = __builtin_amdgcn_mfma_scale_f32_16x16x128_f8f6f4(Bt[n], At[m], acc[ai][bj][m][n], 0, 0, 0, 0x7F7F7F7F, 0, 0x7F7F7F7F); __builtin_amdgcn_s_setprio(0); } while (0)
#define PG8_MMAZ(ai, bj, At, Bt) do { __builtin_amdgcn_s_setprio(1); _Pragma("unroll") for (int m = 0; m < 4; ++m) _Pragma("unroll") for (int n = 0; n < 2; ++n) \
        acc[ai][bj][m][n] = __builtin_amdgcn_mfma_scale_f32_16x16x128_f8f6f4(Bt[n], At[m], (f32x4){0.f, 0.f, 0.f, 0.f}, 0, 0, 0, 0x7F7F7F7F, 0, 0x7F7F7F7F); __builtin_amdgcn_s_setprio(0); } while (0)
#define PG8_WAIT_V(n) asm volatile("s_waitcnt vmcnt(" #n ")" ::: "memory")
#define PG8_WAIT_L(n) asm volatile("s_waitcnt lgkmcnt(" #n ")" ::: "memory")
#define PG8_BAR __builtin_amdgcn_s_barrier()
#define PG8_SCHED __builtin_amdgcn_sched_barrier(0)
#ifndef GEMM_FW
#define GEMM_FW 0
#endif
#ifndef GEMM_OVL
#define GEMM_OVL 2
#endif
#define PG8_WAITN(n) do { if constexpr ((n) == 8) PG8_WAIT_V(8); else if constexpr ((n) == 12) PG8_WAIT_V(12); else if constexpr ((n) == 16) PG8_WAIT_V(16); else if constexpr ((n) == 24) PG8_WAIT_V(24); else static_assert((n) == 8 || (n) == 12 || (n) == 16 || (n) == 24, "vmcnt"); } while (0)
#if GEMM_OVL == 1
    Unit cur, nxt; int ui = 0;
    if (!S.next(0, cur)) return;
    cur.pm = __builtin_amdgcn_readfirstlane(cur.pm); cur.pn = __builtin_amdgcn_readfirstlane(cur.pn); cur.e = __builtin_amdgcn_readfirstlane(cur.e);
    constexpr int NST = Epi::NST;
    LAS unsigned char* const blds = lds + STAGE_BYTES;
    const unsigned bldsa = (unsigned)(size_t)lds + (unsigned)STAGE_BYTES;
    f32x4 acc[2][2][4][2];
#pragma unroll
    for (int a = 0; a < 2; ++a)
#pragma unroll
        for (int b = 0; b < 2; ++b)
#pragma unroll
            for (int m = 0; m < 4; ++m)
#pragma unroll
                for (int n = 0; n < 2; ++n) acc[a][b][m][n] = zero4();
    i32x8 At[4], B0[2], B1[2];
    const char* cA = (const char*)g.A + (size_t)cur.pm * tstep; const char* cB = (const char*)g.Bt + (size_t)cur.e * g.bexp + (size_t)cur.pn * tstep;
    PG8_STAGE(PG8_SB(0, 0), cB, voffB); PG8_STAGE(PG8_SB(0, 1), cB + hstep, voffB); PG8_STAGE(PG8_SA(0, 0), cA, voffA); PG8_STAGE(PG8_SA(0, 1), cA + hstep, voffA);
    if (wr == 1) PG8_BAR;
    PG8_WAIT_V(2); PG8_BAR;
    PG8_STAGE(PG8_SB(1, 0), cB + kstep, voffB); PG8_STAGE(PG8_SA(1, 0), cA + kstep, voffA); PG8_STAGE(PG8_SB(1, 1), cB + hstep + kstep, voffB);
    PG8_WAIT_V(6); PG8_BAR;
    for (;;) {
        const bool has_next = S.next(ui + 1, nxt);
        nxt.pm = __builtin_amdgcn_readfirstlane(nxt.pm); nxt.pn = __builtin_amdgcn_readfirstlane(nxt.pn); nxt.e = __builtin_amdgcn_readfirstlane(nxt.e);
        const char* nA = has_next ? (const char*)g.A + (size_t)nxt.pm * tstep : cA; const char* nB = has_next ? (const char*)g.Bt + (size_t)nxt.e * g.bexp + (size_t)nxt.pn * tstep : cB;
#define PG8_ITER(FIRST, LAST, T, FW) do { \
            const char* a1 = cA + (size_t)((T) + 1) * kstep; \
            const char* a2 = (LAST) ? nA : cA + (size_t)((T) + 2) * kstep; const char* b2 = (LAST) ? nB : cB + (size_t)((T) + 2) * kstep; \
            const char* a3 = a2 + kstep; const char* b3 = b2 + kstep; \
            if (LAST) { int ln2 = lane_id_v(); asm volatile("" : "+v"(ln2)); E.prefetch(cur, bldsa + (unsigned)(ui & 1) * 2048u, wid, ln2); } \
            PG8_LDB(B0, 0, 0); PG8_LDB(B1, 0, 1); PG8_SCHED; PG8_LDA(At, 0, 0); PG8_STAGE(PG8_SA(1, 1), a1 + hstep, voffA); \
            if (FW) PG8_WAITN(8 + 2 * NST); else PG8_WAIT_V(8); \
            PG8_WAIT_L(0); PG8_BAR; PG8_MMA(0, 0, At, B0); PG8_MMA(0, 1, At, B1); PG8_BAR; PG8_SCHED; \
            PG8_LDA(At, 0, 1); PG8_STAGE(PG8_SB(0, 0), b2, voffB); PG8_STAGE(PG8_SB(0, 1), b2 + hstep, voffB); PG8_STAGE(PG8_SA(0, 0), a2, voffA); \
            if (FW) PG8_WAITN(8 + 2 * NST); else PG8_WAIT_V(8); \
            PG8_WAIT_L(0); PG8_BAR; PG8_MMA(1, 0, At, B0); PG8_MMA(1, 1, At, B1); PG8_BAR; PG8_SCHED; \
            PG8_LDB(B0, 1, 0); PG8_LDB(B1, 1, 1); PG8_SCHED; PG8_LDA(At, 1, 0); PG8_STAGE(PG8_SA(0, 1), a2 + hstep, voffA); \
            PG8_WAIT_V(8); PG8_WAIT_L(0); PG8_BAR; PG8_MMA(0, 0, At, B0); PG8_MMA(0, 1, At, B1); PG8_BAR; PG8_SCHED; \
            PG8_LDA(At, 1, 1); PG8_STAGE(PG8_SB(1, 0), b3, voffB); PG8_STAGE(PG8_SB(1, 1), b3 + hstep, voffB); PG8_STAGE(PG8_SA(1, 0), a3, voffA); PG8_WAIT_V(8); \
            PG8_WAIT_L(0); PG8_BAR; PG8_MMA(1, 0, At, B0); PG8_MMA(1, 1, At, B1); PG8_BAR; PG8_SCHED; \
            if (LAST) { \
                { int ln2 = lane_id_v(); asm volatile("" : "+v"(ln2)); E.template half<0>(acc, cur, wr, wc, ln2 & 15, ln2 >> 4, blds + (ui & 1) * 2048); } \
                PG8_SCHED; \
                { int ln2 = lane_id_v(); asm volatile("" : "+v"(ln2)); E.template half<1>(acc, cur, wr, wc, ln2 & 15, ln2 >> 4, blds + (ui & 1) * 2048); } \
                PG8_SCHED; \
                _Pragma("unroll") for (int a = 0; a < 2; ++a) _Pragma("unroll") for (int b = 0; b < 2; ++b) _Pragma("unroll") for (int m = 0; m < 4; ++m) _Pragma("unroll") for (int n = 0; n < 2; ++n) zero4_inplace(acc[a][b][m][n]); \
                PG8_SCHED; } } while (0)
#pragma nounroll
        for (int t = 0; t < nt - 2; t += 2) { const bool fw = (t == 0) && (ui > 0); PG8_ITER(false, false, t, fw); }
        PG8_ITER(false, true, nt - 2, false);
#undef PG8_ITER
        if (!has_next) break;
        cur = nxt; cA = nA; cB = nB; ++ui;
    }
    if (wr == 0) PG8_BAR;
    PG8_WAIT_V(0);
    PG8_BAR;
#else
#ifndef GEMM_STAG
#define GEMM_STAG 0
#endif
    if (GEMM_STAG > 0 && (S.c & 4)) { for (int q = 0; q < GEMM_STAG; ++q) __builtin_amdgcn_s_sleep(100); }
    Unit cur, nxt; int ui = 0;
    if (!S.next(0, cur)) return;
    cur.pm = __builtin_amdgcn_readfirstlane(cur.pm); cur.pn = __builtin_amdgcn_readfirstlane(cur.pn); cur.e = __builtin_amdgcn_readfirstlane(cur.e);
    f32x4 acc[2][2][4][2];
#pragma unroll
    for (int a = 0; a < 2; ++a)
#pragma unroll
        for (int b = 0; b < 2; ++b)
#pragma unroll
            for (int m = 0; m < 4; ++m)
#pragma unroll
                for (int n = 0; n < 2; ++n) acc[a][b][m][n] = zero4();
    i32x8 At[4], B0[2], B1[2];
    const char* cA = (const char*)g.A + (size_t)cur.pm * tstep; const char* cB = (const char*)g.Bt + (size_t)cur.e * g.bexp + (size_t)cur.pn * tstep;
    PG8_STAGE(PG8_SB(0, 0), cB, voffB); PG8_STAGE(PG8_SB(0, 1), cB + hstep, voffB); PG8_STAGE(PG8_SA(0, 0), cA, voffA); PG8_STAGE(PG8_SA(0, 1), cA + hstep, voffA);
    if (wr == 1) PG8_BAR;
    PG8_WAIT_V(2); PG8_BAR;
    PG8_STAGE(PG8_SB(1, 0), cB + kstep, voffB); PG8_STAGE(PG8_SA(1, 0), cA + kstep, voffA); PG8_STAGE(PG8_SB(1, 1), cB + hstep + kstep, voffB);
    PG8_WAIT_V(6); PG8_BAR;
    for (;;) {
        const bool has_next = S.next(ui + 1, nxt);
        nxt.pm = __builtin_amdgcn_readfirstlane(nxt.pm); nxt.pn = __builtin_amdgcn_readfirstlane(nxt.pn); nxt.e = __builtin_amdgcn_readfirstlane(nxt.e);
        const char* nA = has_next ? (const char*)g.A + (size_t)nxt.pm * tstep : cA; const char* nB = has_next ? (const char*)g.Bt + (size_t)nxt.e * g.bexp + (size_t)nxt.pn * tstep : cB;
#pragma nounroll
        for (int t = 0; t < nt; t += 2) {
            const bool last = (t == nt - 2);
#if GEMM_OVL == 2
            if (last) { int ln2 = lane_id_v(); asm volatile("" : "+v"(ln2)); E.prefetch(cur, (unsigned)(size_t)lds + (unsigned)STAGE_BYTES + (unsigned)(ui & 1) * 2048u, wid, ln2); }
#endif
            const char* a1 = cA + (size_t)(t + 1) * kstep;
            const char* a2 = last ? nA : cA + (size_t)(t + 2) * kstep; const char* b2 = last ? nB : cB + (size_t)(t + 2) * kstep;
            const char* a3 = a2 + kstep; const char* b3 = b2 + kstep;
            const bool fw = (GEMM_FW != 0) && (t == 0) && (ui > 0);
            PG8_LDB(B0, 0, 0); PG8_LDB(B1, 0, 1); PG8_SCHED; PG8_LDA(At, 0, 0); PG8_STAGE(PG8_SA(1, 1), a1 + hstep, voffA);
            if (fw) PG8_WAITN(8 + 2 * Epi::NST); else PG8_WAIT_V(8);
            PG8_WAIT_L(0); PG8_BAR; PG8_MMA(0, 0, At, B0); PG8_MMA(0, 1, At, B1); PG8_BAR; PG8_SCHED;
            PG8_LDA(At, 0, 1); PG8_STAGE(PG8_SB(0, 0), b2, voffB); PG8_STAGE(PG8_SB(0, 1), b2 + hstep, voffB); PG8_STAGE(PG8_SA(0, 0), a2, voffA);
            if (fw) PG8_WAITN(8 + 2 * Epi::NST); else PG8_WAIT_V(8);
            PG8_WAIT_L(0); PG8_BAR; PG8_MMA(1, 0, At, B0); PG8_MMA(1, 1, At, B1); PG8_BAR; PG8_SCHED;
            PG8_LDB(B0, 1, 0); PG8_LDB(B1, 1, 1); PG8_SCHED; PG8_LDA(At, 1, 0); PG8_STAGE(PG8_SA(0, 1), a2 + hstep, voffA);
            PG8_WAIT_V(8); PG8_WAIT_L(0); PG8_BAR; PG8_MMA(0, 0, At, B0); PG8_MMA(0, 1, At, B1); PG8_BAR; PG8_SCHED;
            PG8_LDA(At, 1, 1); PG8_STAGE(PG8_SB(1, 0), b3, voffB); PG8_STAGE(PG8_SB(1, 1), b3 + hstep, voffB); PG8_STAGE(PG8_SA(1, 0), a3, voffA);
            PG8_WAIT_V(8); PG8_WAIT_L(0); PG8_BAR; PG8_MMA(1, 0, At, B0); PG8_MMA(1, 1, At, B1); PG8_BAR; PG8_SCHED;
        }
        if (wr == 0) PG8_BAR;
        { int ln2 = lane_id_v(); asm volatile("" : "+v"(ln2));
#if GEMM_OVL == 2
          E.template half<0>(acc, cur, wr, wc, ln2 & 15, ln2 >> 4, lds + STAGE_BYTES + (ui & 1) * 2048); E.template half<1>(acc, cur, wr, wc, ln2 & 15, ln2 >> 4, lds + STAGE_BYTES + (ui & 1) * 2048); }
#else
          E(acc, cur, wr, wc, ln2 & 15, ln2 >> 4); }
#endif
        if (!has_next) break;
#pragma unroll
        for (int a = 0; a < 2; ++a)
#pragma unroll
            for (int b = 0; b < 2; ++b)
#pragma unroll
                for (int m = 0; m < 4; ++m)
#pragma unroll
                    for (int n = 0; n < 2; ++n) acc[a][b][m][n] = zero4();
        cur = nxt; cA = nA; cB = nB; ++ui;
        if (wr == 1) PG8_BAR;
    }
    PG8_WAIT_V(0);
    PG8_BAR;
#endif
#undef PG8_WAITN
#undef PG8_SA
#undef PG8_SB
#undef PG8_STAGE
#undef PG8_LDA
#undef PG8_LDB
#undef PG8_MMA
#undef PG8_MMAZ
#undef PG8_WAIT_V
#undef PG8_WAIT_L
#undef PG8_BAR
#undef PG8_SCHED
}
}
#ifndef ATT_PRIO
#define ATT_PRIO 0
#endif
template <int NCB> __device__ __forceinline__ int v_st(int k, int c) { const int kk = (k & ~0xC) | ((k & 4) << 1) | ((k & 8) >> 1); return ((kk >> 3) * NCB + (c >> 5)) * 512 + ((kk & 7) * 32 + (c & 31)) * 2; }
__device__ __forceinline__ int v_rd_base(int lane) { return ((lane & 3) << 3) | (((lane >> 2) & 3) << 6) | (((lane >> 4) & 1) << 5) | (((lane >> 5) & 1) << 8); }
template <int OFF> __device__ __forceinline__ s16x4 tr_read(int vb) {
    s16x4 r; asm volatile("ds_read_b64_tr_b16 %0, %1 offset:%2" : "=&v"(r) : "v"(vb), "i"(OFF) : "memory"); return r;
}
#define VRO(ks, half) (((2 * (ks) + (half)) * NCB + D0) * 512)
#define PKV(L, H) (bf16x8){L[0], L[1], L[2], L[3], H[0], H[1], H[2], H[3]}
template <int NCB, int D0, int KS0, int NKS> __device__ __forceinline__ void pv_grp(f32x16& od, int vb, const bf16x8 (&pa)[NKS]) {
    static_assert(NKS == 2 || NKS == 4, "NKS");
    const s16x4 l0 = tr_read<VRO(KS0, 0)>(vb), h0 = tr_read<VRO(KS0, 1)>(vb), l1 = tr_read<VRO(KS0 + 1, 0)>(vb), h1 = tr_read<VRO(KS0 + 1, 1)>(vb);
    if constexpr (NKS == 4) {
        const s16x4 l2 = tr_read<VRO(KS0 + 2, 0)>(vb), h2 = tr_read<VRO(KS0 + 2, 1)>(vb), l3 = tr_read<VRO(KS0 + 3, 0)>(vb), h3 = tr_read<VRO(KS0 + 3, 1)>(vb);
        asm volatile("s_waitcnt lgkmcnt(0)" ::: "memory"); SBAR();
        od = __builtin_amdgcn_mfma_f32_32x32x16_bf16(pa[0], PKV(l0, h0), od, 0, 0, 0);
        od = __builtin_amdgcn_mfma_f32_32x32x16_bf16(pa[1], PKV(l1, h1), od, 0, 0, 0);
        od = __builtin_amdgcn_mfma_f32_32x32x16_bf16(pa[2], PKV(l2, h2), od, 0, 0, 0);
        od = __builtin_amdgcn_mfma_f32_32x32x16_bf16(pa[3], PKV(l3, h3), od, 0, 0, 0);
    } else {
        asm volatile("s_waitcnt lgkmcnt(0)" ::: "memory"); SBAR();
        od = __builtin_amdgcn_mfma_f32_32x32x16_bf16(pa[0], PKV(l0, h0), od, 0, 0, 0);
        od = __builtin_amdgcn_mfma_f32_32x32x16_bf16(pa[1], PKV(l1, h1), od, 0, 0, 0);
    }
}
#undef VRO
#undef PKV
struct AttnNA { int krow0, rq, r0, cq, c0; const float* rpb; };

template <int DQK, int DV, bool NA, int NB32, int HF>
__device__ __forceinline__ void attn_step(const char* Ks, int vb, const bf16x8 (&qr)[DQK / 16], f32x16 (&o)[DV / 32], float& m_reg, float& l_reg, float* al_l,
                                          float C, float thr, bool win_tile, int rowpart, int c0, const float* rpb, int r32, int hi) {
    constexpr int NCB = DV / 32, NQ = DQK / 16, KRS = DQK * 2;
    f32x16 p[NB32];
#pragma unroll
    for (int j = 0; j < NB32; ++j) p[j] = (f32x16){0};
#pragma unroll
    for (int d0 = 0; d0 < NQ; ++d0) { const int cb = (d0 * 16 + hi * 8) * 2;
#pragma unroll
        for (int j = 0; j < NB32; ++j) { const bf16x8 kf = *(const bf16x8*)(Ks + (32 * (NB32 * HF + j) + r32) * KRS + (cb ^ ((r32 & 7) << 4)));
            p[j] = __builtin_amdgcn_mfma_f32_32x32x16_bf16(kf, qr[d0], p[j], 0, 0, 0); }
        if constexpr (NQ > 8) { if ((d0 & 3) == 3) SBAR(); } }
    if constexpr (NA) {
        if (win_tile) {
#pragma unroll
            for (int j = 0; j < NB32; ++j)
#pragma unroll
                for (int r = 0; r < 16; ++r) { const int kc = 32 * (NB32 * HF + j) + crow(r, hi); const bool v0 = (unsigned)(kc - c0) < 16u;
                    const float b0 = rpb[v0 ? rowpart + kc : 0]; p[j][r] = v0 ? p[j][r] + b0 : -1e30f; }
        }
    }
    float pmax = p[0][0];
#pragma unroll
    for (int j = 0; j < NB32; ++j)
#pragma unroll
        for (int r = 0; r < 16; ++r) pmax = fmaxf(pmax, p[j][r]);
    { auto rr = __builtin_amdgcn_permlane32_swap(__float_as_uint(pmax), __float_as_uint(pmax), false, false); pmax = fmaxf(__uint_as_float(rr[0]), __uint_as_float(rr[1])); }
    float mn, alpha;
    if (__all(pmax - m_reg <= thr)) { mn = m_reg; alpha = 1.f; }
    else { mn = fmaxf(m_reg, pmax); alpha = __builtin_amdgcn_exp2f((m_reg - mn) * C); m_reg = mn; }
    const float mnC = -mn * C;
    float ps = 0.f;
#pragma unroll
    for (int j = 0; j < NB32; ++j)
#pragma unroll
        for (int r = 0; r < 16; ++r) { p[j][r] = __builtin_amdgcn_exp2f(fmaf(p[j][r], C, mnC)); ps += p[j][r]; }
    { auto rr = __builtin_amdgcn_permlane32_swap(__float_as_uint(ps), __float_as_uint(ps), false, false); ps = __uint_as_float(rr[0]) + __uint_as_float(rr[1]); }
    l_reg = l_reg * alpha + ps;
    if (__any(alpha < 1.f)) { if (hi == 0) al_l[r32] = alpha; asm volatile("s_waitcnt lgkmcnt(0)" ::: "memory");
#pragma unroll
        for (int r = 0; r < 16; ++r) { const float a_ = al_l[crow(r, hi)];
#pragma unroll
            for (int d = 0; d < NCB; ++d) o[d][r] *= a_; } }
    bf16x8 pa[2 * NB32];
#define PK4(P, BASE, OUT) do { unsigned a0 = pk2(P[BASE + 0], P[BASE + 1]), a1 = pk2(P[BASE + 2], P[BASE + 3]);   \
    unsigned b0_ = pk2(P[BASE + 4], P[BASE + 5]), b1_ = pk2(P[BASE + 6], P[BASE + 7]);                              \
    auto r0_ = __builtin_amdgcn_permlane32_swap(a0, b0_, false, false); auto r1_ = __builtin_amdgcn_permlane32_swap(a1, b1_, false, false); \
    u32x4 w_ = {r0_[0], r1_[0], r0_[1], r1_[1]}; OUT = *reinterpret_cast<bf16x8*>(&w_); } while (0)
#pragma unroll
    for (int j = 0; j < NB32; ++j) { PK4(p[j], 0, pa[2 * j]); PK4(p[j], 8, pa[2 * j + 1]); }
#undef PK4
    pv_grp<NCB, 0, 2 * NB32 * HF, 2 * NB32>(o[0], vb, pa);
    pv_grp<NCB, 1, 2 * NB32 * HF, 2 * NB32>(o[1], vb, pa);
    if constexpr (NCB == 4) { pv_grp<NCB, 2, 2 * NB32 * HF, 2 * NB32>(o[2], vb, pa); pv_grp<NCB, 3, 2 * NB32 * HF, 2 * NB32>(o[3], vb, pa); }
}

template <int DQK, int DV, bool NA, int NB32>
__device__ __forceinline__ void attn_unit(const bf16* __restrict__ Qb, const bf16* __restrict__ Kh, const bf16* __restrict__ Vh, int n1, int base1, int base2, int ntiles,
                                          bf16* __restrict__ Ob, char* lds, float C, float thr, const AttnNA na, const int wid_in) {
    const int wid = __builtin_amdgcn_readfirstlane(wid_in);
    constexpr int NCB = DV / 32, NQ = DQK / 16, KCH = DQK / 64, VCH = DV / 64, KTB = 64 * DQK * 2, VTB = 64 * DV * 2, KRS = DQK * 2;
    int lane = lane_id_v(); asm volatile("" : "+v"(lane));
    const int tid = wid * 64 + lane, r32 = lane & 31, hi = lane >> 5;
    char* K_lds = lds; char* V_lds = lds + 2 * KTB;
    float* wsf = (float*)(lds + 2 * KTB + 2 * VTB) + wid * 64; float* li_l = wsf; float* al_l = wsf + 32;
    float m_reg = -1e30f, l_reg = 0.f; f32x16 o[NCB];
#pragma unroll
    for (int d = 0; d < NCB; ++d) o[d] = (f32x16){0};
    bf16x8 qr[NQ];
    { const char* Qc = (const char*)Qb; const unsigned qoff = (unsigned)((wid * 32 + r32) * DQK + hi * 8) * 2u;
#pragma unroll
      for (int d0 = 0; d0 < NQ; ++d0) qr[d0] = *(const bf16x8*)(Qc + qoff + d0 * 32); }
    const int vb0 = (int)(uintptr_t)V_lds + v_rd_base(lane);
    bf16x8 kstA[KCH], vstA[VCH], kstB[KCH], vstB[VCH];
    unsigned koff[KCH], voff[VCH];
#pragma unroll
    for (int i = 0; i < KCH; ++i) { const int id = tid + i * 512; koff[i] = (unsigned)((id / (DQK / 8)) * DQK + (id % (DQK / 8)) * 8) * 2u; }
#pragma unroll
    for (int i = 0; i < VCH; ++i) { const int id = tid + i * 512; voff[i] = (unsigned)((id / (DV / 8)) * DV + (id % (DV / 8)) * 8) * 2u; }
#define ATT_LOAD(KS, VS, t) do { const int _t = (t); const int key0 = __builtin_amdgcn_readfirstlane(_t < n1 ? base1 + _t * 64 : base2 + (_t - n1) * 64); \
    const char* kt_ = (const char*)Kh + (size_t)key0 * (DQK * 2); const char* vt_ = (const char*)Vh + (size_t)key0 * (DV * 2); \
    _Pragma("unroll") for (int i = 0; i < KCH; ++i) KS[i] = *(const bf16x8*)(kt_ + koff[i]); \
    _Pragma("unroll") for (int i = 0; i < VCH; ++i) VS[i] = *(const bf16x8*)(vt_ + voff[i]); } while (0)
#define ATT_WRITE(KS, VS, b) do { \
    _Pragma("unroll") for (int i = 0; i < KCH; ++i) { const int id = tid + i * 512, kr_ = id / (DQK / 8), kc_ = (id % (DQK / 8)) * 16; *(bf16x8*)(K_lds + (b) * KTB + kr_ * KRS + (kc_ ^ ((kr_ & 7) << 4))) = KS[i]; } \
    _Pragma("unroll") for (int i = 0; i < VCH; ++i) { const int id = tid + i * 512; *(bf16x8*)(V_lds + (b) * VTB + v_st<NCB>(id / (DV / 8), (id % (DV / 8)) * 8)) = VS[i]; } } while (0)
#define ATT_BODY(t_, bsel_) do { const int tq_ = (t_); \
        bool act = true; bool win_tile = false; int rowpart = 0; \
        if constexpr (NA) { win_tile = tq_ < n1; act = !win_tile || ((unsigned)(na.krow0 + tq_ - na.r0) < 8u); rowpart = (na.krow0 + tq_ - na.rq + 7) * 31 + 15 - na.cq; } \
        if (act) { \
            const char* Ks = K_lds + (bsel_) * KTB; const int vb = vb0 + (bsel_) * VTB; \
            attn_step<DQK, DV, NA, NB32, 0>(Ks, vb, qr, o, m_reg, l_reg, al_l, C, thr, win_tile, rowpart, na.c0, na.rpb, r32, hi); \
            if constexpr (NB32 == 1) attn_step<DQK, DV, NA, NB32, 1>(Ks, vb, qr, o, m_reg, l_reg, al_l, C, thr, win_tile, rowpart, na.c0, na.rpb, r32, hi); \
        } } while (0)
    ATT_LOAD(kstA, vstA, 0);
    if (ntiles > 1) ATT_LOAD(kstB, vstB, 1);
    for (int t = 0; t < ntiles; t += 2) {
        ATT_WRITE(kstA, vstA, 0);
        __syncthreads();
        if (t + 2 < ntiles) ATT_LOAD(kstA, vstA, t + 2);
        ATT_BODY(t, 0);
        if (t + 1 < ntiles) {
            ATT_WRITE(kstB, vstB, 1);
            __syncthreads();
            if (t + 3 < ntiles) ATT_LOAD(kstB, vstB, t + 3);
            ATT_BODY(t + 1, 1);
        }
    }
#undef ATT_BODY
#undef ATT_LOAD
#undef ATT_WRITE
    if (hi == 0) li_l[r32] = l_reg;
    asm volatile("s_waitcnt lgkmcnt(0)" ::: "memory");
    bf16* Ow = Ob + (size_t)(wid * 32) * DM;
#pragma unroll
    for (int r = 0; r < 16; ++r) { const int orow = crow(r, hi); const float rl = __builtin_amdgcn_rcpf(li_l[orow]);
#pragma unroll
        for (int d0 = 0; d0 < NCB; ++d0) Ow[(size_t)orow * DM + d0 * 32 + r32] = (bf16)f2bf(o[d0][r] * rl); }
    __syncthreads();
}

constexpr int TSTR = 272, TBYTES = 128 * TSTR;
__device__ __forceinline__ int toff(int r, int cb) { return r * TSTR + cb; }
__device__ __forceinline__ void mm128(const char* At, const char* Bt, f32x16& c0, f32x16& c1, int mb, int nb0, int r32, int hi) {
#pragma unroll
    for (int kk = 0; kk < 8; ++kk) { const int cb = (kk * 16 + hi * 8) * 2;
        const bf16x8 a = *(const bf16x8*)(At + toff(mb * 32 + r32, cb));
        const bf16x8 b0 = *(const bf16x8*)(Bt + toff(nb0 * 32 + r32, cb));
        const bf16x8 b1 = *(const bf16x8*)(Bt + toff(nb0 * 32 + 32 + r32, cb));
        c0 = __builtin_amdgcn_mfma_f32_32x32x16_bf16(a, b0, c0, 0, 0, 0);
        c1 = __builtin_amdgcn_mfma_f32_32x32x16_bf16(a, b1, c1, 0, 0, 0); }
}
__device__ __forceinline__ void stage_nat(const bf16* src, char* T, int tid) {
#pragma unroll
    for (int i = 0; i < 4; ++i) { const int id = tid + i * 512, row = id >> 4, c8 = id & 15; *(u32x4*)(T + toff(row, c8 * 16)) = *(const u32x4*)(src + (size_t)row * 128 + c8 * 8); }
}
__device__ __forceinline__ int ret_chunk_pos(int c) { return c < 128 ? c * 128 : SEQ + (c - 128) * 128; }

#ifndef ATT_DBG_2XK
#define ATT_DBG_2XK 0
#endif
#ifndef ATT_DBG_SYNC
#define ATT_DBG_SYNC 0
#endif
#ifndef ATT_DBG_REGSTAGE
#define ATT_DBG_REGSTAGE 0
#endif
#define VRO(ks, half) (((2 * (ks) + (half)) * NCB + D0) * 512)
#define PKV(L, H) (bf16x8){L[0], L[1], L[2], L[3], H[0], H[1], H[2], H[3]}
template <int NCB, int D0, int KS0, int NKS> __device__ __forceinline__ void pvT_grp(f32x16& od, int vb, const bf16x8 (&pb)[NKS]) {
    static_assert(NKS == 2 || NKS == 4, "NKS");
    const s16x4 l0 = tr_read<VRO(KS0, 0)>(vb), h0 = tr_read<VRO(KS0, 1)>(vb), l1 = tr_read<VRO(KS0 + 1, 0)>(vb), h1 = tr_read<VRO(KS0 + 1, 1)>(vb);
    if constexpr (NKS == 4) {
        const s16x4 l2 = tr_read<VRO(KS0 + 2, 0)>(vb), h2 = tr_read<VRO(KS0 + 2, 1)>(vb), l3 = tr_read<VRO(KS0 + 3, 0)>(vb), h3 = tr_read<VRO(KS0 + 3, 1)>(vb);
        asm volatile("s_waitcnt lgkmcnt(0)" ::: "memory"); SBAR();
        od = __builtin_amdgcn_mfma_f32_32x32x16_bf16(PKV(l0, h0), pb[0], od, 0, 0, 0);
        od = __builtin_amdgcn_mfma_f32_32x32x16_bf16(PKV(l1, h1), pb[1], od, 0, 0, 0);
        od = __builtin_amdgcn_mfma_f32_32x32x16_bf16(PKV(l2, h2), pb[2], od, 0, 0, 0);
        od = __builtin_amdgcn_mfma_f32_32x32x16_bf16(PKV(l3, h3), pb[3], od, 0, 0, 0);
    } else {
        asm volatile("s_waitcnt lgkmcnt(0)" ::: "memory"); SBAR();
        od = __builtin_amdgcn_mfma_f32_32x32x16_bf16(PKV(l0, h0), pb[0], od, 0, 0, 0);
        od = __builtin_amdgcn_mfma_f32_32x32x16_bf16(PKV(l1, h1), pb[1], od, 0, 0, 0);
    }
}
#undef VRO
#undef PKV
template <int NCB, int D0, int KS0, int NKS> __device__ __forceinline__ void pvT_rd(s16x4 (&f)[2 * NKS], int vb) {
#define VRO(ks, half) (((2 * (ks) + (half)) * NCB + D0) * 512)
    f[0] = tr_read<VRO(KS0, 0)>(vb); f[1] = tr_read<VRO(KS0, 1)>(vb); f[2] = tr_read<VRO(KS0 + 1, 0)>(vb); f[3] = tr_read<VRO(KS0 + 1, 1)>(vb);
    if constexpr (NKS == 4) { f[4] = tr_read<VRO(KS0 + 2, 0)>(vb); f[5] = tr_read<VRO(KS0 + 2, 1)>(vb); f[6] = tr_read<VRO(KS0 + 3, 0)>(vb); f[7] = tr_read<VRO(KS0 + 3, 1)>(vb); }
#undef VRO
}
template <int NKS> __device__ __forceinline__ void pvT_mm(f32x16& od, const s16x4 (&f)[2 * NKS], const bf16x8 (&pb)[NKS]) {
#define PKV(L, H) (bf16x8){L[0], L[1], L[2], L[3], H[0], H[1], H[2], H[3]}
    od = __builtin_amdgcn_mfma_f32_32x32x16_bf16(PKV(f[0], f[1]), pb[0], od, 0, 0, 0);
    od = __builtin_amdgcn_mfma_f32_32x32x16_bf16(PKV(f[2], f[3]), pb[1], od, 0, 0, 0);
    if constexpr (NKS == 4) { od = __builtin_amdgcn_mfma_f32_32x32x16_bf16(PKV(f[4], f[5]), pb[2], od, 0, 0, 0); od = __builtin_amdgcn_mfma_f32_32x32x16_bf16(PKV(f[6], f[7]), pb[3], od, 0, 0, 0); }
#undef PKV
}
template <int NCB, int KS0, int NKS> __device__ __forceinline__ void pvT_all(f32x16 (&o)[NCB], int vb, const bf16x8 (&pb)[NKS]) {
    static_assert((NCB == 2 || NCB == 4) && (NKS == 2 || NKS == 4), "pvT_all");
    s16x4 fa[2 * NKS], fb[2 * NKS];
    pvT_rd<NCB, 0, KS0, NKS>(fa, vb);
    pvT_rd<NCB, 1, KS0, NKS>(fb, vb);
    if constexpr (NKS == 4) asm volatile("s_waitcnt lgkmcnt(8)" ::: "memory"); else asm volatile("s_waitcnt lgkmcnt(4)" ::: "memory");
    SBAR(); pvT_mm<NKS>(o[0], fa, pb); SBAR();
    if constexpr (NCB == 4) {
        pvT_rd<NCB, 2, KS0, NKS>(fa, vb);
        if constexpr (NKS == 4) asm volatile("s_waitcnt lgkmcnt(8)" ::: "memory"); else asm volatile("s_waitcnt lgkmcnt(4)" ::: "memory");
        SBAR(); pvT_mm<NKS>(o[1], fb, pb); SBAR();
        pvT_rd<NCB, 3, KS0, NKS>(fb, vb);
        if constexpr (NKS == 4) asm volatile("s_waitcnt lgkmcnt(8)" ::: "memory"); else asm volatile("s_waitcnt lgkmcnt(4)" ::: "memory");
        SBAR(); pvT_mm<NKS>(o[2], fa, pb); SBAR();
        asm volatile("s_waitcnt lgkmcnt(0)" ::: "memory");
        SBAR(); pvT_mm<NKS>(o[3], fb, pb);
    } else {
        asm volatile("s_waitcnt lgkmcnt(0)" ::: "memory");
        SBAR(); pvT_mm<NKS>(o[1], fb, pb);
    }
}
#ifndef PV_PIPE
#define PV_PIPE 0
#endif
#if PV_PIPE
#define PVT_CALL(KS0_, NKS_) pvT_all<NCB, KS0_, NKS_>(o, vb, pa)
#else
#define PVT_CALL(KS0_, NKS_) do { pvT_grp<NCB, 0, KS0_, NKS_>(o[0], vb, pa); pvT_grp<NCB, 1, KS0_, NKS_>(o[1], vb, pa); \
    if constexpr (NCB == 4) { pvT_grp<NCB, 2, KS0_, NKS_>(o[2], vb, pa); pvT_grp<NCB, 3, KS0_, NKS_>(o[3], vb, pa); } } while (0)
#endif
template <int DQK, int DV, int NB32, bool LONES, int RING = 3, bool PING = false, bool PRESC = false>
__device__ __forceinline__ void attn_dense2(const bf16* __restrict__ Qb, const bf16* __restrict__ Kh, const bf16* __restrict__ Vh, int key_base, int ntiles,
                                            bf16* __restrict__ Ob, char* lds, float C, float MC, const int wid_in) {
    constexpr int NCB = DV / 32, NQ = DQK / 16, KCH = DQK / 64, VCH = DV / 64, KTB = 64 * DQK * 2, VTB = 64 * DV * 2, KRS = DQK * 2, SLOT = KTB + VTB;
    static_assert(RING * SLOT + 2048 <= RING_BYTES && (!PING || (RING == 4 && NB32 == 2)), "attention ring");
    const int wid = __builtin_amdgcn_readfirstlane(wid_in);
    int lane = lane_id_v(); asm volatile("" : "+v"(lane));
    const int r32 = lane & 31, hi = lane >> 5;
    float* wsf = (float*)(lds + RING * SLOT) + wid * 64; float* li_l = wsf;
    f32x16 o[NCB];
#pragma unroll
    for (int d = 0; d < NCB; ++d) o[d] = (f32x16){0};
    f32x16 ol = (f32x16){0}; float l_part = 0.f;
    bf16x8 qr[NQ];
    { const char* Qc = (const char*)Qb; const unsigned qoff = (unsigned)((wid * 32 + r32) * DQK + hi * 8) * 2u;
#pragma unroll
      for (int d0 = 0; d0 < NQ; ++d0) qr[d0] = *(const bf16x8*)(Qc + qoff + d0 * 32); }
    unsigned ksrc[KCH], vsrc[VCH];
#pragma unroll
    for (int i = 0; i < KCH; ++i) { const int j = (i * 8 + wid) * 64 + lane, row = j / (DQK / 8), cp = j % (DQK / 8), c = cp ^ (row & 7); ksrc[i] = (unsigned)(row * KRS + c * 16); }
#pragma unroll
    for (int i = 0; i < VCH; ++i) { const int j = (i * 8 + wid) * 64 + lane, st = j >> 5, q = j & 31, kk = (st / NCB) * 8 + (q >> 2), cc = (st % NCB) * 32 + (q & 3) * 8;
        vsrc[i] = (unsigned)(kk * DV * 2 + cc * 2); }
    const unsigned ldsb = (unsigned)(uintptr_t)lds;
#if ATT_DBG_REGSTAGE
#define AD_DMA(t) do { const int t_ = (t); char* sp_ = lds + (t_ % RING) * SLOT; const size_t k0_ = (size_t)(key_base + t_ * 64); \
    _Pragma("unroll") for (int i = 0; i < KCH; ++i) *(u32x4*)(sp_ + (i * 8 + wid) * 1024 + lane * 16) = *(const u32x4*)((const char*)Kh + k0_ * KRS + ksrc[i]); \
    _Pragma("unroll") for (int i = 0; i < VCH; ++i) *(u32x4*)(sp_ + KTB + (i * 8 + wid) * 1024 + lane * 16) = *(const u32x4*)((const char*)Vh + k0_ * (DV * 2) + vsrc[i]); } while (0)
#else
#define AD_DMA(t) do { const int t_ = (t); const unsigned sb_ = ldsb + (unsigned)(t_ % RING) * SLOT; const size_t k0_ = (size_t)(key_base + t_ * 64); \
    _Pragma("unroll") for (int i = 0; i < KCH; ++i) pg8::glds16((const char*)Kh + k0_ * KRS, ksrc[i], sb_ + (unsigned)((i * 8 + wid) * 1024)); \
    _Pragma("unroll") for (int i = 0; i < VCH; ++i) pg8::glds16((const char*)Vh + k0_ * (DV * 2), vsrc[i], sb_ + KTB + (unsigned)((i * 8 + wid) * 1024)); } while (0)
#endif
    const int vbl = (int)ldsb + KTB + v_rd_base(lane);
    bf16x8 ones8;
    { u32x4 ow_; asm volatile("v_mov_b32 %0, 0x3f803f80\n\tv_mov_b32 %1, 0x3f803f80\n\tv_mov_b32 %2, 0x3f803f80\n\tv_mov_b32 %3, 0x3f803f80" : "=v"(ow_.x), "=v"(ow_.y), "=v"(ow_.z), "=v"(ow_.w)); ones8 = *reinterpret_cast<bf16x8*>(&ow_); }
#define AD_QK(P, Ks, KB) do { _Pragma("unroll") for (int d0 = 0; d0 < NQ; ++d0) { const int cb = (d0 * 16 + hi * 8) * 2; \
        const bf16x8 kf = *(const bf16x8*)((Ks) + (32 * (KB) + r32) * KRS + (cb ^ ((r32 & 7) << 4))); \
        if (ATT_DBG_2XK && DQK == 64) { const bf16x8 kf2 = *(const volatile bf16x8*)((Ks) + (32 * (KB) + r32) * KRS + ((cb ^ 16) ^ ((r32 & 7) << 4))); asm volatile("" :: "v"(kf2)); } \
        P = __builtin_amdgcn_mfma_f32_32x32x16_bf16(kf, qr[d0], P, 0, 0, 0); if constexpr (NQ > 8) { if ((d0 & 3) == 3) SBAR(); } } } while (0)
#define AD_PK4(P, BASE, OUT) do { u32x4 w_ = {pk2(P[BASE + 0], P[BASE + 1]), pk2(P[BASE + 2], P[BASE + 3]), pk2(P[BASE + 4], P[BASE + 5]), pk2(P[BASE + 6], P[BASE + 7])}; \
    OUT = *reinterpret_cast<bf16x8*>(&w_); } while (0)
#define AD_SM(P, PA0, PA1) do { _Pragma("unroll") for (int r = 0; r < 16; ++r) { P[r] = PRESC ? __builtin_amdgcn_exp2f(P[r]) : __builtin_amdgcn_exp2f(fmaf(P[r], C, -MC)); if constexpr (!LONES) l_part += P[r]; } \
        AD_PK4(P, 0, PA0); AD_PK4(P, 8, PA1); } while (0)
    AD_DMA(0); if (ntiles > 1) AD_DMA(1);
    asm volatile("s_waitcnt vmcnt(0)" ::: "memory"); __syncthreads();
    if (ntiles > 2) AD_DMA(2);
    f32x16 negm;
#pragma unroll
    for (int r = 0; r < 16; ++r) negm[r] = PRESC ? -MC : 0.f;
    f32x16 sA = negm, sB = negm;
    { const char* Ks0 = lds; AD_QK(sA, Ks0, 0); if constexpr (NB32 == 2) AD_QK(sB, Ks0, 1); }
    if (PING && wid >= 4) {
        bf16x8 pa[4];
        for (int t = 0; t < ntiles; ++t) {
            const int pslot = (t + RING - 1) % RING, nslot = (t + 1) % RING; const bool more = t + 1 < ntiles;
            if (t > 0) { asm volatile("s_waitcnt vmcnt(0)" ::: "memory"); __syncthreads(); if (t + 2 < ntiles) AD_DMA(t + 2); }
            if (t > 0) { const int vb = vbl + pslot * SLOT;
                PVT_CALL(0, 4);
                if constexpr (LONES) {
#pragma unroll
                    for (int ks = 0; ks < 4; ++ks) ol = __builtin_amdgcn_mfma_f32_32x32x16_bf16(ones8, pa[ks], ol, 0, 0, 0); } }
            const char* Kn = lds + nslot * SLOT;
            f32x16 nA = negm, nB = negm;
            if (more) { AD_QK(nA, Kn, 0); AD_QK(nB, Kn, 1); }
            AD_SM(sA, pa[0], pa[1]); AD_SM(sB, pa[2], pa[3]);
            sA = nA; sB = nB;
        }
        { const int vb = vbl + ((ntiles - 1) % RING) * SLOT;
          PVT_CALL(0, 4);
          if constexpr (LONES) {
#pragma unroll
              for (int ks = 0; ks < 4; ++ks) ol = __builtin_amdgcn_mfma_f32_32x32x16_bf16(ones8, pa[ks], ol, 0, 0, 0); } }
    } else
    for (int t = 0; t < ntiles; ++t) {
        const int slot = t % RING, nslot = (t + 1) % RING; const bool more = t + 1 < ntiles;
        if (t > 0) { asm volatile("s_waitcnt vmcnt(0)" ::: "memory"); __syncthreads(); if (t + 2 < ntiles) AD_DMA(t + 2); }
        const char* Ks = lds + slot * SLOT; const char* Kn = lds + nslot * SLOT; const int vb = vbl + slot * SLOT;
        if constexpr (NB32 == 2) {
            f32x16 nA = negm, nB = negm;
            if (more) { AD_QK(nA, Kn, 0); AD_QK(nB, Kn, 1); }
            bf16x8 pa[4];
            AD_SM(sA, pa[0], pa[1]); AD_SM(sB, pa[2], pa[3]);
            PVT_CALL(0, 4);
            if constexpr (LONES) {
#pragma unroll
                for (int ks = 0; ks < 4; ++ks) ol = __builtin_amdgcn_mfma_f32_32x32x16_bf16(ones8, pa[ks], ol, 0, 0, 0); }
            sA = nA; sB = nB;
#if ATT_DBG_SYNC
            asm volatile("s_waitcnt vmcnt(0) lgkmcnt(0)" ::: "memory"); __syncthreads();
#endif
        } else {
            { f32x16 n1 = negm; AD_QK(n1, Ks, 1);
              bf16x8 pa[2]; AD_SM(sA, pa[0], pa[1]);
              PVT_CALL(0, 2);
              if constexpr (LONES) { ol = __builtin_amdgcn_mfma_f32_32x32x16_bf16(ones8, pa[0], ol, 0, 0, 0); ol = __builtin_amdgcn_mfma_f32_32x32x16_bf16(ones8, pa[1], ol, 0, 0, 0); }
              sB = n1; }
            { f32x16 n0 = negm; if (more) AD_QK(n0, Kn, 0);
              bf16x8 pa[2]; AD_SM(sB, pa[0], pa[1]);
              PVT_CALL(2, 2);
              if constexpr (LONES) { ol = __builtin_amdgcn_mfma_f32_32x32x16_bf16(ones8, pa[0], ol, 0, 0, 0); ol = __builtin_amdgcn_mfma_f32_32x32x16_bf16(ones8, pa[1], ol, 0, 0, 0); }
              sA = n0; }
        }
    }
#undef AD_DMA
#undef AD_QK
#undef AD_PK4
#undef AD_SM
    float rl;
    if constexpr (LONES) rl = __builtin_amdgcn_rcpf(ol[0]);
    else { auto rr = __builtin_amdgcn_permlane32_swap(__float_as_uint(l_part), __float_as_uint(l_part), false, false); rl = __builtin_amdgcn_rcpf(__uint_as_float(rr[0]) + __uint_as_float(rr[1])); }
    bf16* Ow = Ob + (size_t)(wid * 32 + r32) * DM + 8 * hi;
#pragma unroll
    for (int d0 = 0; d0 < NCB; ++d0)
#pragma unroll
        for (int q = 0; q < 2; ++q) { u32x2 wa, wb;
            wa.x = pk2(o[d0][8 * q] * rl, o[d0][8 * q + 1] * rl); wa.y = pk2(o[d0][8 * q + 2] * rl, o[d0][8 * q + 3] * rl);
            wb.x = pk2(o[d0][8 * q + 4] * rl, o[d0][8 * q + 5] * rl); wb.y = pk2(o[d0][8 * q + 6] * rl, o[d0][8 * q + 7] * rl);
            const auto sx = __builtin_amdgcn_permlane32_swap(wa.x, wb.x, false, false), sy = __builtin_amdgcn_permlane32_swap(wa.y, wb.y, false, false);
            u32x4 w4; w4.x = sx[0]; w4.y = sy[0]; w4.z = sx[1]; w4.w = sy[1];
            *(u32x4*)(Ow + d0 * 32 + 16 * q) = w4; }
    __syncthreads();
}

__device__ __forceinline__ void attn_gqa128(const unsigned char* __restrict__ Qb, const unsigned char* __restrict__ Kh, const unsigned char* __restrict__ VTh, int key_base, int ntiles64,
                                            bf16* __restrict__ Ob, char* lds, float MC, const int wid_in) {
    constexpr int NCB = 2, KTB = 4096, VTB = 4096, KRS = 64, SLOTB = 2 * KTB + 2 * VTB, RING = 4;
    static_assert(RING * SLOTB <= RING_BYTES, "gqa ring");
    const int wid = __builtin_amdgcn_readfirstlane(wid_in);
    int lane = lane_id_v(); asm volatile("" : "+v"(lane));
    const int r32 = lane & 31, hi = lane >> 5;
    f32x16 o[NCB]; o[0] = (f32x16){0}; o[1] = (f32x16){0};
    f32x16 ol = (f32x16){0};
    i32x8 q8;
    { const char* Qc = (const char*)Qb; const unsigned qoff = (unsigned)((wid * 32 + r32) * 64 + hi * 32);
      const i32x4 lo_ = *(const i32x4*)(Qc + qoff), hi_ = *(const i32x4*)(Qc + qoff + 16); q8 = __builtin_shufflevector(lo_, hi_, 0, 1, 2, 3, 4, 5, 6, 7); }
    unsigned ksrc, vsrc;
    { const int j = wid * 64 + lane, sub = j >> 8, jj = j & 255, row = jj >> 2, cp = jj & 3, c = cp ^ ((row >> 2) & 3);
      ksrc = (unsigned)((sub * 64 + row) * KRS + c * 16); vsrc = (unsigned)(row * SP + sub * 64 + c * 16); }
    const unsigned ldsb = (unsigned)(uintptr_t)lds;
#define G_DMA(T) do { const int T_ = (T); const unsigned sb_ = ldsb + (unsigned)(T_ % RING) * SLOTB + (unsigned)wid * 1024u; const size_t k0_ = (size_t)(key_base + T_ * 128); \
    pg8::glds16((const char*)Kh + k0_ * KRS, ksrc, sb_); pg8::glds16((const char*)VTh + k0_, vsrc, sb_ + 2 * KTB); } while (0)
    i32x8 ones8;
    { i32x4 ow_; asm volatile("v_mov_b32 %0, 0x38383838\n\tv_mov_b32 %1, 0x38383838\n\tv_mov_b32 %2, 0x38383838\n\tv_mov_b32 %3, 0x38383838" : "=v"(ow_.x), "=v"(ow_.y), "=v"(ow_.z), "=v"(ow_.w)); ones8 = __builtin_shufflevector(ow_, ow_, 0, 1, 2, 3, 4, 5, 6, 7); }
    f32x16 negm;
#pragma unroll
    for (int r = 0; r < 16; ++r) negm[r] = 8.0f - MC;
#define G_FRAG(OUT, Ts, BLK) do { const int row_ = 32 * (BLK) + r32, sw_ = (row_ >> 2) & 3; const char* rp_ = (Ts) + row_ * 64; \
        const i32x4 lo_ = *(const i32x4*)(rp_ + (((2 * hi) ^ sw_) << 4)), hi_ = *(const i32x4*)(rp_ + (((2 * hi + 1) ^ sw_) << 4)); \
        OUT = __builtin_shufflevector(lo_, hi_, 0, 1, 2, 3, 4, 5, 6, 7); } while (0)
#define G_QK(P, Ks, KB) do { i32x8 kf_; G_FRAG(kf_, Ks, KB); P = __builtin_amdgcn_mfma_scale_f32_32x32x64_f8f6f4(kf_, q8, negm, 0, 0, 0, 0x7F7F7F7F, 0, 0x7C7C7C7C); } while (0)
#define G_SM(PA, PB, P8) do { _Pragma("unroll") for (int r = 0; r < 16; ++r) { PA[r] = __builtin_amdgcn_exp2f(PA[r]); PB[r] = __builtin_amdgcn_exp2f(PB[r]); } \
        P8 = (i32x8){(int)pg8::pk4_bf8(PA[0], PA[1], PA[2], PA[3]), (int)pg8::pk4_bf8(PA[4], PA[5], PA[6], PA[7]), (int)pg8::pk4_bf8(PA[8], PA[9], PA[10], PA[11]), (int)pg8::pk4_bf8(PA[12], PA[13], PA[14], PA[15]), \
                      (int)pg8::pk4_bf8(PB[0], PB[1], PB[2], PB[3]), (int)pg8::pk4_bf8(PB[4], PB[5], PB[6], PB[7]), (int)pg8::pk4_bf8(PB[8], PB[9], PB[10], PB[11]), (int)pg8::pk4_bf8(PB[12], PB[13], PB[14], PB[15])}; } while (0)
#define G_PV(Vs) do { i32x8 v0_, v1_; G_FRAG(v0_, Vs, 0); G_FRAG(v1_, Vs, 1); if (ATT_PRIO == 2) __builtin_amdgcn_s_setprio(1); \
        o[0] = __builtin_amdgcn_mfma_scale_f32_32x32x64_f8f6f4(v0_, p8, o[0], 0, 1, 0, 0x7F7F7F7F, 0, 0x7F7F7F7F); \
        o[1] = __builtin_amdgcn_mfma_scale_f32_32x32x64_f8f6f4(v1_, p8, o[1], 0, 1, 0, 0x7F7F7F7F, 0, 0x7F7F7F7F); \
        ol = __builtin_amdgcn_mfma_scale_f32_32x32x64_f8f6f4(ones8, p8, ol, 0, 1, 0, 0x7F7F7F7F, 0, 0x7F7F7F7F); if (ATT_PRIO == 2) __builtin_amdgcn_s_setprio(0); } while (0)
#define G_KA(s) (lds + (((s) >> 1) % RING) * SLOTB + ((s) & 1) * KTB)
#define G_VA(s) (lds + (((s) >> 1) % RING) * SLOTB + 2 * KTB + ((s) & 1) * VTB)
    const int NT = ntiles64 >> 1;
    G_DMA(0); if (NT > 1) G_DMA(1);
    asm volatile("s_waitcnt vmcnt(0)" ::: "memory"); __syncthreads();
    if (NT > 2) G_DMA(2);
    f32x16 sA, sB;
    { const char* K0 = lds; G_QK(sA, K0, 0); G_QK(sB, K0, 1); }
    if (wid >= 4) {
        if (ATT_PRIO == 1) __builtin_amdgcn_s_setprio(1);
        i32x8 p8 = ones8;
        for (int T = 0; T < NT; ++T) {
            if (T > 0) { asm volatile("s_waitcnt vmcnt(0)" ::: "memory"); __syncthreads(); if (T + 2 < NT) G_DMA(T + 2); }
#pragma unroll
            for (int sub = 0; sub < 2; ++sub) { const int s = 2 * T + sub;
                if (s > 0) { const char* Vp = G_VA(s - 1); G_PV(Vp); }
                f32x16 nA = negm, nB = negm;
                if (s + 1 < ntiles64) { const char* Kn = G_KA(s + 1); G_QK(nA, Kn, 0); G_QK(nB, Kn, 1); }
                G_SM(sA, sB, p8);
                sA = nA; sB = nB; }
        }
        { const char* Vp = G_VA(ntiles64 - 1); G_PV(Vp); }
        if (ATT_PRIO == 1) __builtin_amdgcn_s_setprio(0);
    } else {
        for (int T = 0; T < NT; ++T) {
            if (T > 0) { asm volatile("s_waitcnt vmcnt(0)" ::: "memory"); __syncthreads(); if (T + 2 < NT) G_DMA(T + 2); }
#pragma unroll
            for (int sub = 0; sub < 2; ++sub) { const int s = 2 * T + sub;
                f32x16 nA = negm, nB = negm;
                if (s + 1 < ntiles64) { const char* Kn = G_KA(s + 1); G_QK(nA, Kn, 0); G_QK(nB, Kn, 1); }
                i32x8 p8; G_SM(sA, sB, p8);
                { const char* Vc = G_VA(s); G_PV(Vc); }
                sA = nA; sB = nB; }
        }
    }
#undef G_DMA
#undef G_FRAG
#undef G_QK
#undef G_SM
#undef G_PV
#undef G_KA
#undef G_VA
    const float rl = __builtin_amdgcn_rcpf(ol[0]);
    bf16* Ow = Ob + (size_t)(wid * 32 + r32) * DM + 8 * hi;
#pragma unroll
    for (int d0 = 0; d0 < NCB; ++d0)
#pragma unroll
        for (int q = 0; q < 2; ++q) { u32x2 wa, wb;
            wa.x = pk2(o[d0][8 * q] * rl, o[d0][8 * q + 1] * rl); wa.y = pk2(o[d0][8 * q + 2] * rl, o[d0][8 * q + 3] * rl);
            wb.x = pk2(o[d0][8 * q + 4] * rl, o[d0][8 * q + 5] * rl); wb.y = pk2(o[d0][8 * q + 6] * rl, o[d0][8 * q + 7] * rl);
            const auto sx = __builtin_amdgcn_permlane32_swap(wa.x, wb.x, false, false), sy = __builtin_amdgcn_permlane32_swap(wa.y, wb.y, false, false);
            u32x4 w4; w4.x = sx[0]; w4.y = sy[0]; w4.z = sx[1]; w4.w = sy[1];
            *(u32x4*)(Ow + d0 * 32 + 16 * q) = w4; }
    __syncthreads();
}

__device__ __forceinline__ void attn_mla8(const unsigned char* __restrict__ Qb, const unsigned char* __restrict__ Kh, const unsigned char* __restrict__ VTh, int key_base, int ntiles,
                                          bf16* __restrict__ Ob, char* lds, float MC, const int wid_in) {
    constexpr int NCB = 4, KTB = 64 * 192, VTB = 128 * 64, KRS = 192, SLOT = KTB + VTB, RING = 4;
    static_assert(RING * SLOT <= RING_BYTES, "mla8 ring");
    const int wid = __builtin_amdgcn_readfirstlane(wid_in);
    int lane = lane_id_v(); asm volatile("" : "+v"(lane));
    const int r32 = lane & 31, hi = lane >> 5;
    f32x16 o[NCB];
#pragma unroll
    for (int d = 0; d < NCB; ++d) o[d] = (f32x16){0};
    f32x16 ol = (f32x16){0};
    i32x8 ones8;
    { i32x4 ow_; asm volatile("v_mov_b32 %0, 0x38383838\n\tv_mov_b32 %1, 0x38383838\n\tv_mov_b32 %2, 0x38383838\n\tv_mov_b32 %3, 0x38383838" : "=v"(ow_.x), "=v"(ow_.y), "=v"(ow_.z), "=v"(ow_.w)); ones8 = __builtin_shufflevector(ow_, ow_, 0, 1, 2, 3, 4, 5, 6, 7); }
    i32x8 q8[3];
    { const char* Qc = (const char*)Qb; const unsigned qoff = (unsigned)((wid * 32 + r32) * 192 + hi * 32);
#pragma unroll
      for (int st = 0; st < 3; ++st) { const i32x4 lo_ = *(const i32x4*)(Qc + qoff + st * 64), hi_ = *(const i32x4*)(Qc + qoff + st * 64 + 16); q8[st] = __builtin_shufflevector(lo_, hi_, 0, 1, 2, 3, 4, 5, 6, 7); } }
    unsigned ksrc[2], vsrc;
#pragma unroll
    for (int i = 0; i < 2; ++i) { const int j = (i * 8 + wid) * 64 + lane, row = j / 12, cp = j % 12, c = cp ^ ((row >> 2) & 3); ksrc[i] = (unsigned)(row * KRS + c * 16); }
    { const int j = wid * 64 + lane, v = j >> 2, cp = j & 3, c = cp ^ ((v >> 2) & 3); vsrc = (unsigned)(v * SP + c * 16); }
    const unsigned ldsb = (unsigned)(uintptr_t)lds;
#define M_DMA(t) do { const int t_ = (t); const unsigned sb_ = ldsb + (unsigned)(t_ % RING) * SLOT; const size_t k0_ = (size_t)(key_base + t_ * 64); \
    pg8::glds16((const char*)Kh + k0_ * KRS, ksrc[0], sb_ + (unsigned)(wid * 1024)); \
    if (wid < 4) pg8::glds16((const char*)Kh + k0_ * KRS, ksrc[1], sb_ + (unsigned)((8 + wid) * 1024)); \
    pg8::glds16((const char*)VTh + k0_, vsrc, sb_ + KTB + (unsigned)(wid * 1024)); } while (0)
    const int sw0 = (r32 >> 2) & 3; const unsigned xa = (unsigned)(((2 * hi) ^ sw0) << 4), xb = (unsigned)(((2 * hi + 1) ^ sw0) << 4);
    const unsigned kofA = (unsigned)(r32 * KRS) + xa, kofB = (unsigned)(r32 * KRS) + xb, vofA = (unsigned)(r32 * 64) + xa, vofB = (unsigned)(r32 * 64) + xb;
    f32x16 negm;
#pragma unroll
    for (int r = 0; r < 16; ++r) negm[r] = 8.0f - MC;
#define M_QK(P, Ks, KB) do { const char* rp_ = (Ks) + (KB) * (32 * KRS); \
        _Pragma("unroll") for (int st = 0; st < 3; ++st) { \
            const i32x4 lo_ = *(const i32x4*)(rp_ + st * 64 + kofA), hi_ = *(const i32x4*)(rp_ + st * 64 + kofB); \
            const i32x8 kf_ = __builtin_shufflevector(lo_, hi_, 0, 1, 2, 3, 4, 5, 6, 7); \
            P = __builtin_amdgcn_mfma_scale_f32_32x32x64_f8f6f4(kf_, q8[st], P, 0, 0, 0, 0x7F7F7F7F, 0, 0x7B7B7B7B); } } while (0)
#define M_SM(P, W0, W1, W2, W3) do { _Pragma("unroll") for (int r = 0; r < 16; ++r) { P[r] = __builtin_amdgcn_exp2f(P[r]); } \
        W0 = (int)pg8::pk4_bf8(P[0], P[1], P[2], P[3]); W1 = (int)pg8::pk4_bf8(P[4], P[5], P[6], P[7]); W2 = (int)pg8::pk4_bf8(P[8], P[9], P[10], P[11]); W3 = (int)pg8::pk4_bf8(P[12], P[13], P[14], P[15]); } while (0)
    M_DMA(0); if (ntiles > 1) M_DMA(1);
    asm volatile("s_waitcnt vmcnt(0)" ::: "memory"); __syncthreads();
    if (ntiles > 2) M_DMA(2);
    f32x16 sA = negm;
    { const char* Ks0 = lds; M_QK(sA, Ks0, 0); }
#define M_PV(Vs_) do { if (ATT_PRIO == 2) __builtin_amdgcn_s_setprio(1); _Pragma("unroll") for (int d0 = 0; d0 < NCB; ++d0) { const char* rp_ = (Vs_) + d0 * 2048; \
            const i32x4 lo_ = *(const i32x4*)(rp_ + vofA), hi_ = *(const i32x4*)(rp_ + vofB); \
            const i32x8 vf_ = __builtin_shufflevector(lo_, hi_, 0, 1, 2, 3, 4, 5, 6, 7); \
            o[d0] = __builtin_amdgcn_mfma_scale_f32_32x32x64_f8f6f4(vf_, p8, o[d0], 0, 1, 0, 0x7F7F7F7F, 0, 0x7F7F7F7F); } \
        ol = __builtin_amdgcn_mfma_scale_f32_32x32x64_f8f6f4(ones8, p8, ol, 0, 1, 0, 0x7F7F7F7F, 0, 0x7F7F7F7F); if (ATT_PRIO == 2) __builtin_amdgcn_s_setprio(0); } while (0)
    if (ATT_PRIO == 1 && wid >= 4) __builtin_amdgcn_s_setprio(1);
    if (wid >= 4) {
        i32x8 p8 = q8[0];
        for (int t = 0; t < ntiles; ++t) {
            const int slot = t % RING, nslot = (t + 1) % RING; const bool more = t + 1 < ntiles;
            if (t > 0) { asm volatile("s_waitcnt vmcnt(0)" ::: "memory"); __syncthreads(); if (t + 2 < ntiles) M_DMA(t + 2); }
            const char* Ks = lds + slot * SLOT; const char* Kn = lds + nslot * SLOT;
            if (t > 0) { const char* Vp = lds + ((t - 1) % RING) * SLOT + KTB; M_PV(Vp); }
            f32x16 n1 = negm; M_QK(n1, Ks, 1);
            M_SM(sA, p8[0], p8[1], p8[2], p8[3]);
            f32x16 n0 = negm; if (more) M_QK(n0, Kn, 0);
            M_SM(n1, p8[4], p8[5], p8[6], p8[7]);
            sA = n0;
        }
        { const char* Vp = lds + ((ntiles - 1) % RING) * SLOT + KTB; M_PV(Vp); }
    } else {
        for (int t = 0; t < ntiles; ++t) {
            const int slot = t % RING, nslot = (t + 1) % RING; const bool more = t + 1 < ntiles;
            if (t > 0) { asm volatile("s_waitcnt vmcnt(0)" ::: "memory"); __syncthreads(); if (t + 2 < ntiles) M_DMA(t + 2); }
            const char* Ks = lds + slot * SLOT; const char* Kn = lds + nslot * SLOT; const char* Vs = Ks + KTB;
            i32x8 p8;
            f32x16 n1 = negm; M_QK(n1, Ks, 1);
            M_SM(sA, p8[0], p8[1], p8[2], p8[3]);
            f32x16 n0 = negm; if (more) M_QK(n0, Kn, 0);
            M_SM(n1, p8[4], p8[5], p8[6], p8[7]);
            M_PV(Vs);
            sA = n0;
        }
    }
#undef M_PV
    if (ATT_PRIO == 1 && wid >= 4) __builtin_amdgcn_s_setprio(0);
#undef M_DMA
#undef M_QK
#undef M_SM
    const float rl = __builtin_amdgcn_rcpf(ol[0]);
    bf16* Ow = Ob + (size_t)(wid * 32 + r32) * DM + 8 * hi;
#pragma unroll
    for (int d0 = 0; d0 < NCB; ++d0)
#pragma unroll
        for (int q = 0; q < 2; ++q) { u32x2 wa, wb;
            wa.x = pk2(o[d0][8 * q] * rl, o[d0][8 * q + 1] * rl); wa.y = pk2(o[d0][8 * q + 2] * rl, o[d0][8 * q + 3] * rl);
            wb.x = pk2(o[d0][8 * q + 4] * rl, o[d0][8 * q + 5] * rl); wb.y = pk2(o[d0][8 * q + 6] * rl, o[d0][8 * q + 7] * rl);
            const auto sx = __builtin_amdgcn_permlane32_swap(wa.x, wb.x, false, false), sy = __builtin_amdgcn_permlane32_swap(wa.y, wb.y, false, false);
            u32x4 w4; w4.x = sx[0]; w4.y = sy[0]; w4.z = sx[1]; w4.w = sy[1];
            *(u32x4*)(Ow + d0 * 32 + 16 * q) = w4; }
    __syncthreads();
}

__device__ __forceinline__ void attn_mla8x(const unsigned char* __restrict__ Qb, const unsigned char* __restrict__ Kh, const unsigned char* __restrict__ VTh, int key_base, int ntiles64,
                                           bf16* __restrict__ Ob, char* lds, float MC, const int wid_in) {
    constexpr int NCB = 4, KTB = 64 * 192, VTB = 128 * 64, KRS = 192, SLOT = 2 * KTB + 2 * VTB, RING = 3;
    static_assert(RING * SLOT <= RING_BYTES, "mla8x ring");
    const int wid = __builtin_amdgcn_readfirstlane(wid_in);
    int lane = lane_id_v(); asm volatile("" : "+v"(lane));
    const int r32 = lane & 31, hi = lane >> 5;
    f32x16 o[NCB];
#pragma unroll
    for (int d = 0; d < NCB; ++d) o[d] = (f32x16){0};
    f32x16 ol = (f32x16){0};
    i32x8 ones8;
    { i32x4 ow_; asm volatile("v_mov_b32 %0, 0x38383838\n\tv_mov_b32 %1, 0x38383838\n\tv_mov_b32 %2, 0x38383838\n\tv_mov_b32 %3, 0x38383838" : "=v"(ow_.x), "=v"(ow_.y), "=v"(ow_.z), "=v"(ow_.w)); ones8 = __builtin_shufflevector(ow_, ow_, 0, 1, 2, 3, 4, 5, 6, 7); }
    i32x8 q8[3];
    { const char* Qc = (const char*)Qb; const unsigned qoff = (unsigned)((wid * 32 + r32) * 192 + hi * 32);
#pragma unroll
      for (int st = 0; st < 3; ++st) { const i32x4 lo_ = *(const i32x4*)(Qc + qoff + st * 64), hi_ = *(const i32x4*)(Qc + qoff + st * 64 + 16); q8[st] = __builtin_shufflevector(lo_, hi_, 0, 1, 2, 3, 4, 5, 6, 7); } }
    unsigned ksrc[3], vsrc;
#pragma unroll
    for (int i = 0; i < 3; ++i) { const int j = (i * 8 + wid) * 64 + lane, row = j / 12, cp = j % 12, c = cp ^ ((row >> 2) & 3); ksrc[i] = (unsigned)(row * KRS + c * 16); }
    { const int j = wid * 64 + lane, v = j >> 2, cp = j & 3, c = cp ^ ((v >> 2) & 3); vsrc = (unsigned)(v * SP + c * 16); }
    const unsigned ldsb = (unsigned)(uintptr_t)lds;
#define X_DMA(T) do { const int T_ = (T); const unsigned sb_ = ldsb + (unsigned)(T_ % RING) * SLOT; const size_t k0_ = (size_t)(key_base + T_ * 128); \
    pg8::glds16((const char*)Kh + k0_ * KRS, ksrc[0], sb_ + (unsigned)(wid * 1024)); \
    pg8::glds16((const char*)Kh + k0_ * KRS, ksrc[1], sb_ + (unsigned)((8 + wid) * 1024)); \
    pg8::glds16((const char*)Kh + k0_ * KRS, ksrc[2], sb_ + (unsigned)((16 + wid) * 1024)); \
    pg8::glds16((const char*)VTh + k0_, vsrc, sb_ + 2 * KTB + (unsigned)(wid * 1024)); \
    pg8::glds16((const char*)VTh + k0_ + 64, vsrc, sb_ + 2 * KTB + VTB + (unsigned)(wid * 1024)); } while (0)
    f32x16 negm;
#pragma unroll
    for (int r = 0; r < 16; ++r) negm[r] = 8.0f - MC;
#define X_QK(P, Ks, KB) do { const int row_ = 32 * (KB) + r32, sw_ = (row_ >> 2) & 3; const char* rp_ = (Ks) + row_ * KRS; \
        _Pragma("unroll") for (int st = 0; st < 3; ++st) { const int c0_ = 4 * st + 2 * hi; \
            const i32x4 lo_ = *(const i32x4*)(rp_ + ((c0_ ^ sw_) << 4)), hi_ = *(const i32x4*)(rp_ + (((c0_ + 1) ^ sw_) << 4)); \
            const i32x8 kf_ = __builtin_shufflevector(lo_, hi_, 0, 1, 2, 3, 4, 5, 6, 7); \
            P = __builtin_amdgcn_mfma_scale_f32_32x32x64_f8f6f4(kf_, q8[st], P, 0, 0, 0, 0x7F7F7F7F, 0, 0x7B7B7B7B); } } while (0)
#define X_SM(P, W, B) do { _Pragma("unroll") for (int r = 0; r < 16; ++r) { P[r] = __builtin_amdgcn_exp2f(P[r]); } \
        W[B] = (int)pg8::pk4_bf8(P[0], P[1], P[2], P[3]); W[B + 1] = (int)pg8::pk4_bf8(P[4], P[5], P[6], P[7]); W[B + 2] = (int)pg8::pk4_bf8(P[8], P[9], P[10], P[11]); W[B + 3] = (int)pg8::pk4_bf8(P[12], P[13], P[14], P[15]); } while (0)
#define X_PV(Vs_, PW) do { _Pragma("unroll") for (int d0 = 0; d0 < NCB; ++d0) { const int row_ = 32 * d0 + r32, sw_ = (row_ >> 2) & 3; const char* rp_ = (Vs_) + row_ * 64; \
            const i32x4 lo_ = *(const i32x4*)(rp_ + (((2 * hi) ^ sw_) << 4)), hi_ = *(const i32x4*)(rp_ + (((2 * hi + 1) ^ sw_) << 4)); \
            const i32x8 vf_ = __builtin_shufflevector(lo_, hi_, 0, 1, 2, 3, 4, 5, 6, 7); \
            o[d0] = __builtin_amdgcn_mfma_scale_f32_32x32x64_f8f6f4(vf_, PW, o[d0], 0, 1, 0, 0x7F7F7F7F, 0, 0x7F7F7F7F); } \
        ol = __builtin_amdgcn_mfma_scale_f32_32x32x64_f8f6f4(ones8, PW, ol, 0, 1, 0, 0x7F7F7F7F, 0, 0x7F7F7F7F); } while (0)
#define X_KA(s) (lds + (((s) >> 1) % RING) * SLOT + ((s) & 1) * KTB)
#define X_VA(s) (lds + (((s) >> 1) % RING) * SLOT + 2 * KTB + ((s) & 1) * VTB)
    const int NT = ntiles64 >> 1;
    X_DMA(0); if (NT > 1) X_DMA(1);
    asm volatile("s_waitcnt vmcnt(0)" ::: "memory"); __syncthreads();
    if (NT > 2) X_DMA(2);
    f32x16 sA = negm;
    { const char* K0 = lds; X_QK(sA, K0, 0); }
    if (wid >= 4) {
        for (int T = 0; T < NT; ++T) {
            if (T > 0) { asm volatile("s_waitcnt vmcnt(0)" ::: "memory"); __syncthreads(); if (T + 2 < NT) X_DMA(T + 2); }
            i32x8 pa, pb;
            { const int s = 2 * T; const char* Ks = X_KA(s); const char* Kn = X_KA(s + 1);
              f32x16 n1 = negm; X_QK(n1, Ks, 1);
              X_SM(sA, pa, 0);
              f32x16 n0 = negm; X_QK(n0, Kn, 0);
              X_SM(n1, pa, 4);
              sA = n0; }
            { const int s = 2 * T + 1; const char* Ks = X_KA(s); const char* Vp = X_VA(s - 1); const char* Vs = X_VA(s);
              X_PV(Vp, pa);
              f32x16 n1 = negm; X_QK(n1, Ks, 1);
              X_SM(sA, pb, 0);
              f32x16 n0 = negm; if (s + 1 < ntiles64) { const char* Kn = X_KA(s + 1); X_QK(n0, Kn, 0); }
              X_SM(n1, pb, 4);
              X_PV(Vs, pb);
              sA = n0; }
        }
    } else {
        for (int T = 0; T < NT; ++T) {
            if (T > 0) { asm volatile("s_waitcnt vmcnt(0)" ::: "memory"); __syncthreads(); if (T + 2 < NT) X_DMA(T + 2); }
#pragma unroll
            for (int sub = 0; sub < 2; ++sub) { const int s = 2 * T + sub; const char* Ks = X_KA(s); const char* Vs = X_VA(s);
                i32x8 p8;
                f32x16 n1 = negm; X_QK(n1, Ks, 1);
                X_SM(sA, p8, 0);
                f32x16 n0 = negm; if (s + 1 < ntiles64) { const char* Kn = X_KA(s + 1); X_QK(n0, Kn, 0); }
                X_SM(n1, p8, 4);
                X_PV(Vs, p8);
                sA = n0; }
        }
    }
#undef X_DMA
#undef X_QK
#undef X_SM
#undef X_PV
#undef X_KA
#undef X_VA
    const float rl = __builtin_amdgcn_rcpf(ol[0]);
    bf16* Ow = Ob + (size_t)(wid * 32 + r32) * DM + 8 * hi;
#pragma unroll
    for (int d0 = 0; d0 < NCB; ++d0)
#pragma unroll
        for (int q = 0; q < 2; ++q) { u32x2 wa, wb;
            wa.x = pk2(o[d0][8 * q] * rl, o[d0][8 * q + 1] * rl); wa.y = pk2(o[d0][8 * q + 2] * rl, o[d0][8 * q + 3] * rl);
            wb.x = pk2(o[d0][8 * q + 4] * rl, o[d0][8 * q + 5] * rl); wb.y = pk2(o[d0][8 * q + 6] * rl, o[d0][8 * q + 7] * rl);
            const auto sx = __builtin_amdgcn_permlane32_swap(wa.x, wb.x, false, false), sy = __builtin_amdgcn_permlane32_swap(wa.y, wb.y, false, false);
            u32x4 w4; w4.x = sx[0]; w4.y = sy[0]; w4.z = sx[1]; w4.w = sy[1];
            *(u32x4*)(Ow + d0 * 32 + 16 * q) = w4; }
    __syncthreads();
}
struct Args { const float* in[31]; float* out; unsigned char* ws; int ph_lo, ph_hi; };
enum { I_X = 0, I_C, I_CTX, I_CCTX, I_N1G, I_N2G, I_WMOD, I_BMOD, I_WINE, I_WOUTE, I_AQN, I_AKN, I_BQN, I_BKN, I_RPB, I_WINO, I_WOUTO, I_RDEC, I_RGN, I_CQNG, I_CKVNG, I_WUQ, I_WUKV, I_MQN, I_MKN,
       I_WR, I_BR, I_W1, I_B1, I_W2, I_B2 };

struct Ctx { int tid, lane, wave, gw, NGW, G, bid; char* lds; char* atb; };
__device__ __forceinline__ unsigned long long rfl64(unsigned long long v) { return ((unsigned long long)(unsigned)__builtin_amdgcn_readfirstlane((int)(v >> 32)) << 32) | (unsigned)__builtin_amdgcn_readfirstlane((int)v); }
#define GAS __attribute__((address_space(1)))
#define AIN(c, i) ((const float*)(const GAS float*)rfl64(*(const unsigned long long*)((c).atb + 8 * (i))))
#define AOUT(c) ((float*)(GAS float*)rfl64(*(const unsigned long long*)((c).atb + 8 * 31)))
#define AWS(c) ((unsigned char*)(GAS unsigned char*)rfl64(*(const unsigned long long*)((c).atb + 8 * 32)))
__device__ __forceinline__ u32x4 zero4u() { u32x4 z; asm volatile("v_mov_b32 %0, 0\n\tv_mov_b32 %1, 0\n\tv_mov_b32 %2, 0\n\tv_mov_b32 %3, 0" : "=v"(z.x), "=v"(z.y), "=v"(z.z), "=v"(z.w)); return z; }

__device__ __forceinline__ void tr_tile(const float* src, int ldn, bf16* dst, int ldk, float* scr, int lane) {
#pragma unroll 1
    for (int h2 = 0; h2 < 2; ++h2) { float tv[16];
#pragma unroll
      for (int i = 0; i < 16; ++i) tv[i] = src[(size_t)(2 * (16 * h2 + i) + (lane >> 5)) * ldn + (lane & 31)];
#pragma unroll
      for (int i = 0; i < 16; ++i) scr[(2 * (16 * h2 + i) + (lane >> 5)) * 33 + (lane & 31)] = tv[i]; }
    LDS_WAIT(); asm volatile("" ::: "memory");
    const int c = lane & 7;
#pragma unroll
    for (int j = 0; j < 4; ++j) { const int n = (lane >> 3) + 8 * j; const float* s = scr + (8 * c) * 33 + n;
        u32x4 o; o.x = pk2(s[0 * 33], s[1 * 33]); o.y = pk2(s[2 * 33], s[3 * 33]); o.z = pk2(s[4 * 33], s[5 * 33]); o.w = pk2(s[6 * 33], s[7 * 33]);
        *(u32x4*)(dst + (size_t)n * ldk + 8 * c) = o; }
    LDS_WAIT(); asm volatile("" ::: "memory");
}
__device__ __forceinline__ void tr_tile_f8(const float* src, int ldn, unsigned char* dst, int ldk, float sc, float* scr, int lane) {
#pragma unroll 1
    for (int h2 = 0; h2 < 2; ++h2) { float tv[16];
#pragma unroll
      for (int i = 0; i < 16; ++i) tv[i] = src[(size_t)(2 * (16 * h2 + i) + (lane >> 5)) * ldn + (lane & 31)];
#pragma unroll
      for (int i = 0; i < 16; ++i) scr[(2 * (16 * h2 + i) + (lane >> 5)) * 33 + (lane & 31)] = tv[i]; }
    LDS_WAIT(); asm volatile("" ::: "memory");
    const int c = lane & 7;
#pragma unroll
    for (int j = 0; j < 4; ++j) { const int n = (lane >> 3) + 8 * j; const float* s = scr + (8 * c) * 33 + n;
        u32x2 o; o.x = pg8::pk4_fp8(s[0 * 33] * sc, s[1 * 33] * sc, s[2 * 33] * sc, s[3 * 33] * sc); o.y = pg8::pk4_fp8(s[4 * 33] * sc, s[5 * 33] * sc, s[6 * 33] * sc, s[7 * 33] * sc);
        *(u32x2*)(dst + (size_t)n * ldk + 8 * c) = o; }
    LDS_WAIT(); asm volatile("" ::: "memory");
}
__device__ __forceinline__ void tr_tile64_f8(const float* src, int ldn, unsigned char* dst, int ldk, float sc, float* scr, int lane) {
#pragma unroll 1
    for (int h2 = 0; h2 < 2; ++h2) { f32x4 t[8];
#pragma unroll
        for (int i = 0; i < 8; ++i) t[i] = *(const f32x4*)(src + (size_t)(4 * (8 * h2 + i) + (lane >> 4)) * ldn + (lane & 15) * 4);
#pragma unroll
        for (int i = 0; i < 8; ++i) { float* sp = scr + (4 * (8 * h2 + i) + (lane >> 4)) * 65 + (lane & 15) * 4; sp[0] = t[i].x; sp[1] = t[i].y; sp[2] = t[i].z; sp[3] = t[i].w; } }
    LDS_WAIT(); asm volatile("" ::: "memory");
    const int c = lane & 7;
#pragma unroll
    for (int j = 0; j < 8; ++j) { const int n = (lane >> 3) + 8 * j; const float* s = scr + (8 * c) * 65 + n;
        u32x2 o; o.x = pg8::pk4_fp8(s[0 * 65] * sc, s[1 * 65] * sc, s[2 * 65] * sc, s[3 * 65] * sc); o.y = pg8::pk4_fp8(s[4 * 65] * sc, s[5 * 65] * sc, s[6 * 65] * sc, s[7 * 65] * sc);
        *(u32x2*)(dst + (size_t)n * ldk + 8 * c) = o; }
    LDS_WAIT(); asm volatile("" ::: "memory");
}
__device__ __forceinline__ void tr64_load(const float* src, int ldn, f32x4 (&t)[16], int lane) {
#pragma unroll
    for (int i = 0; i < 16; ++i) t[i] = *(const f32x4*)(src + (size_t)(4 * i + (lane >> 4)) * ldn + (lane & 15) * 4);
}
__device__ __forceinline__ void tr64_store_f8(const f32x4 (&t)[16], unsigned char* dst, int ldk, float sc, float* scr, int lane) {
#pragma unroll
    for (int i = 0; i < 16; ++i) { float* sp = scr + (4 * i + (lane >> 4)) * 65 + (lane & 15) * 4; sp[0] = t[i].x; sp[1] = t[i].y; sp[2] = t[i].z; sp[3] = t[i].w; }
    LDS_WAIT(); asm volatile("" ::: "memory");
    const int c = lane & 7;
#pragma unroll
    for (int j = 0; j < 8; ++j) { const int n = (lane >> 3) + 8 * j; const float* s = scr + (8 * c) * 65 + n;
        u32x2 o; o.x = pg8::pk4_fp8(s[0 * 65] * sc, s[1 * 65] * sc, s[2 * 65] * sc, s[3 * 65] * sc); o.y = pg8::pk4_fp8(s[4 * 65] * sc, s[5 * 65] * sc, s[6 * 65] * sc, s[7 * 65] * sc);
        *(u32x2*)(dst + (size_t)n * ldk + 8 * c) = o; }
    LDS_WAIT(); asm volatile("" ::: "memory");
}
__device__ __forceinline__ float silu_f(float x) { return x / (1.0f + __expf(-x)); }

__device__ __forceinline__ void phase_prologue(const Ctx& cx) {
    unsigned char* ws = AWS(cx);
    {
        float* sil = (float*)cx.lds;
        float* red = sil + 3 * 1024;
        float* MOD = (float*)(ws + WS_MOD);
        const float* cv = AIN(cx, I_C); const float* cc = AIN(cx, I_CCTX);
        for (int i = cx.tid; i < 3 * 1024; i += 512) sil[i] = silu_f(i < 2048 ? cv[i] : cc[i - 2048]);
        __syncthreads();
        for (int it = cx.bid; it < 4 * 96; it += cx.G) {
            const int l = it / 96, cg = it % 96, col = cg * 64 + cx.lane;
            const float* w = AIN(cx, I_WMOD) + ((size_t)l * 1024 + cx.wave * 128) * 6144 + col;
            const float* sw = sil + cx.wave * 128;
            float s0 = 0.f, s1 = 0.f, s2 = 0.f;
#pragma unroll 1
            for (int k0 = 0; k0 < 128; k0 += 32) { float wv[32];
#pragma unroll
                for (int k = 0; k < 32; ++k) wv[k] = w[(size_t)(k0 + k) * 6144];
#pragma unroll
                for (int k = 0; k < 32; ++k) { s0 += sw[k0 + k] * wv[k]; s1 += sw[1024 + k0 + k] * wv[k]; s2 += sw[2048 + k0 + k] * wv[k]; } }
            red[(cx.wave * 3 + 0) * 64 + cx.lane] = s0; red[(cx.wave * 3 + 1) * 64 + cx.lane] = s1; red[(cx.wave * 3 + 2) * 64 + cx.lane] = s2;
            __syncthreads();
            if (cx.tid < 192) { const int r = cx.tid >> 6, ln = cx.tid & 63; float s = 0.f;
#pragma unroll
                for (int w8 = 0; w8 < 8; ++w8) s += red[(w8 * 3 + r) * 64 + ln];
                MOD[((size_t)l * 3 + r) * 6144 + cg * 64 + ln] = s + AIN(cx, I_BMOD)[(size_t)l * 6144 + cg * 64 + ln]; }
            __syncthreads();
        }
    }
    float* scr = (float*)(cx.lds + cx.wave * 16640);
    constexpr int IT_W1 = 128 * 512, IT_W2 = 128 * 256;
    constexpr int S_WINE = 16 * 72, S_WOUT = 512, S_WINO = 16 * 78, S_UQ = 4 * 24, S_UKV = 2 * 32;
    constexpr int IT_SMALL = 2 * (S_WINE + S_WOUT + S_WINO + S_WOUT + S_UQ + S_UKV);
    {
        auto item = [&](int it, const float*& src, int& ldn, unsigned char*& dst) {
            if (it < IT_W1) { const int mat = it >> 9, r = it & 511, kb = r >> 5, nb = r & 31, n0 = nb * 64;
                const int orow = n0 < 1024 ? (n0 >> 7) * 256 + (n0 & 127) : ((n0 - 1024) >> 7) * 256 + 128 + (n0 & 127);
                src = AIN(cx, I_W1) + (size_t)mat * 1024 * 2048 + (size_t)kb * 64 * 2048 + n0; ldn = 2048; dst = (unsigned char*)(ws + WS_W1) + (size_t)mat * 2048 * 1024 + (size_t)orow * 1024 + kb * 64; }
            else { const int r = it - IT_W1, mat = r >> 8, q = r & 255, kb = q >> 4, nb = q & 15;
                src = AIN(cx, I_W2) + (size_t)mat * 1024 * 1024 + (size_t)kb * 64 * 1024 + nb * 64; ldn = 1024; dst = (unsigned char*)(ws + WS_W2) + (size_t)mat * 1024 * 1024 + (size_t)nb * 64 * 1024 + kb * 64; } };
        auto tile_of = [&](int sq) -> int { const int pr = cx.gw + (sq >> 1) * cx.NGW, half = sq & 1;
            if (pr >= (IT_W1 + IT_W2) / 2) return -1;
            if (pr < IT_W1 / 2) { const int mat = pr >> 8, q = pr & 255, kbp = q >> 5, nb = q & 31; return mat * 512 + (2 * kbp + half) * 32 + nb; }
            const int p2 = pr - IT_W1 / 2, mat = p2 >> 7, q = p2 & 127, kbp = q >> 4, nb = q & 15; return IT_W1 + mat * 256 + (2 * kbp + half) * 16 + nb; };
        int sq = 0, it = tile_of(0);
        if (it >= 0) {
            const float* src; int ldn; unsigned char* dst; f32x4 t[16], tn[16];
            item(it, src, ldn, dst); tr64_load(src, ldn, t, cx.lane);
            for (;;) {
                const int nit = tile_of(sq + 1); const float* nsrc = src; int nldn = ldn; unsigned char* ndst = dst;
                if (nit >= 0) { item(nit, nsrc, nldn, ndst); tr64_load(nsrc, nldn, tn, cx.lane); }
                tr64_store_f8(t, dst, 1024, 32.0f, scr, cx.lane);
                if (nit < 0) break;
#pragma unroll
                for (int i = 0; i < 16; ++i) t[i] = tn[i];
                src = nsrc; ldn = nldn; dst = ndst; ++sq;
            }
        }
    }
    for (int it = cx.gw; it < IT_SMALL; it += cx.NGW) {
        int r = it;
        const int i = r >= IT_SMALL / 2 ? 1 : 0; if (i) r -= IT_SMALL / 2;
        if (r < S_WINE) { const int kb = r / 72, nb = r % 72;
            tr_tile_f8(AIN(cx, I_WINE) + (size_t)i * 1024 * EIN + (size_t)kb * 64 * EIN + nb * 32, EIN, (unsigned char*)(ws + WS_WINE) + (size_t)i * EIN * 1024 + (size_t)nb * 32 * 1024 + kb * 64, 1024, 32.0f, scr, cx.lane); continue; }
        r -= S_WINE;
        if (r < S_WOUT) { const int kb = r >> 5, nb = r & 31;
            tr_tile(AIN(cx, I_WOUTE) + (size_t)i * 1024 * 1024 + (size_t)kb * 64 * 1024 + nb * 32, 1024, (bf16*)(ws + WS_WOUTE) + (size_t)i * 1024 * 1024 + (size_t)nb * 32 * 1024 + kb * 64, 1024, scr, cx.lane); continue; }
        r -= S_WOUT;
        if (r < S_WINO) { const int kb = r / 78, nb = r % 78;
            tr_tile_f8(AIN(cx, I_WINO) + (size_t)i * 1024 * OIN + (size_t)kb * 64 * OIN + nb * 32, OIN, (unsigned char*)(ws + WS_WINO) + (size_t)i * OINP * 1024 + (size_t)nb * 32 * 1024 + kb * 64, 1024, 32.0f, scr, cx.lane); continue; }
        r -= S_WINO;
        if (r < S_WOUT) { const int kb = r >> 5, nb = r & 31;
            tr_tile(AIN(cx, I_WOUTO) + (size_t)i * 1024 * 1024 + (size_t)kb * 64 * 1024 + nb * 32, 1024, (bf16*)(ws + WS_WOUTO) + (size_t)i * 1024 * 1024 + (size_t)nb * 32 * 1024 + kb * 64, 1024, scr, cx.lane); continue; }
        r -= S_WOUT;
        if (r < S_UQ) { const int kb = r / 24, nb = r % 24;
            tr_tile(AIN(cx, I_WUQ) + (size_t)i * 256 * 768 + (size_t)kb * 64 * 768 + nb * 32, 768, (bf16*)(ws + WS_WUQ) + (size_t)i * 768 * 256 + (size_t)nb * 32 * 256 + kb * 64, 256, scr, cx.lane); continue; }
        r -= S_UQ;
        { const int kb = r >> 5, nb = r & 31;
            tr_tile(AIN(cx, I_WUKV) + (size_t)i * 128 * 1024 + (size_t)kb * 64 * 1024 + nb * 32, 1024, (bf16*)(ws + WS_WUKV) + (size_t)i * 1024 * 256 + (size_t)nb * 32 * 256 + kb * 64, 256, scr, cx.lane); }
    }
    const int gt = cx.bid * 512 + cx.tid, NT_ = cx.G * 512;
    for (int idx = gt; idx < 2 * 64 * 64; idx += NT_) { const int i = idx / (64 * 64), q = idx % (64 * 64);
        *(u32x4*)((unsigned char*)(ws + WS_WINO) + (size_t)i * OINP * 1024 + (size_t)OIN * 1024 + (size_t)q * 16) = (u32x4){0u, 0u, 0u, 0u}; }
    for (int idx = gt; idx < 2 * 1024 * 16; idx += NT_) { const int i = idx / (1024 * 16), q = idx % (1024 * 16), row = q >> 4, c8 = q & 15;
        *(u32x4*)((bf16*)(ws + WS_WUKV) + (size_t)i * 1024 * 256 + (size_t)row * 256 + 128 + c8 * 8) = (u32x4){0u, 0u, 0u, 0u}; }
}

__device__ __forceinline__ void modulate_row(const f32x4 (&x)[4], const float* g, const float* shift, const float* scale, int lane, f32x4 (&y)[4]) {
    float ss = 0.f;
#pragma unroll
    for (int j = 0; j < 4; ++j) ss += (x[j].x * x[j].x + x[j].y * x[j].y) + (x[j].z * x[j].z + x[j].w * x[j].w);
    const float rs = rsqrtf(wave_sum(ss, lane) * (1.0f / DM) + EPS);
#pragma unroll
    for (int j = 0; j < 4; ++j) { const int o = 4 * lane + 256 * j; const f32x4 gv = *(const f32x4*)(g + o), sh = *(const f32x4*)(shift + o), sc = *(const f32x4*)(scale + o);
        y[j] = (x[j] * rs) * gv * (sc + 1.0f) + sh; }
}
__device__ __forceinline__ void modulate_row_c(const f32x4 (&x)[4], const f32x4 (&gv)[4], const f32x4 (&sh)[4], const f32x4 (&sc)[4], int lane, f32x4 (&y)[4]) {
    float ss = 0.f;
#pragma unroll
    for (int j = 0; j < 4; ++j) ss += (x[j].x * x[j].x + x[j].y * x[j].y) + (x[j].z * x[j].z + x[j].w * x[j].w);
    const float rs = rsqrtf(wave_sum(ss, lane) * (1.0f / DM) + EPS);
#pragma unroll
    for (int j = 0; j < 4; ++j) y[j] = (x[j] * rs) * gv[j] * (sc[j] + 1.0f) + sh[j];
}
__device__ __forceinline__ void store_row_bf16(bf16* dst, const f32x4 (&y)[4], int lane) {
#pragma unroll
    for (int j = 0; j < 4; ++j) { u32x2 w; w.x = pk2(y[j].x, y[j].y); w.y = pk2(y[j].z, y[j].w); *(u32x2*)(dst + 4 * lane + 256 * j) = w; }
}
__device__ __forceinline__ void store_row_fp8(unsigned char* dst, const f32x4 (&y)[4], int lane) {
#pragma unroll
    for (int j = 0; j < 4; ++j) *(unsigned*)(dst + 4 * lane + 256 * j) = pg8::pk4_fp8(y[j].x, y[j].y, y[j].z, y[j].w);
}
__device__ __forceinline__ int mrow_of(int tok) { return tok < NL ? (tok >> 14) : 2; }
__device__ __forceinline__ void load_row_bf16(const bf16* src, f32x4 (&x)[4], int lane) {
#pragma unroll
    for (int j = 0; j < 4; ++j) { const u32x2 w = *(const u32x2*)(src + 4 * lane + 256 * j);
        x[j] = (f32x4){__uint_as_float(w.x << 16), __uint_as_float(w.x & 0xffff0000u), __uint_as_float(w.y << 16), __uint_as_float(w.y & 0xffff0000u)}; }
}

__device__ __forceinline__ void phase_init(const Ctx& cx) {
    bf16* X0 = (bf16*)(AWS(cx) + WS_X0); bf16* ACT = (bf16*)(AWS(cx) + WS_ACT); const float* MOD = (const float*)(AWS(cx) + WS_MOD);
    f32x4 xn[4];
#define IN_LOAD(X, T) do { const float* src_ = (T) < NL ? AIN(cx, I_X) + (size_t)(T) * DM : AIN(cx, I_CTX) + (size_t)((T) - NL) * DM; \
        _Pragma("unroll") for (int j = 0; j < 4; ++j) X[j] = *(const f32x4*)(src_ + 4 * cx.lane + 256 * j); } while (0)
    if (cx.gw < DEPTH * 3 * 32) {
        const int l_ = cx.gw / 96, mrw_ = (cx.gw / 32) % 3, e_ = cx.gw & 31; float sm_ = 0.f;
        const float* sh_ = MOD + ((size_t)l_ * 3 + mrw_) * 6144 + 3 * 1024; const float* wr_ = AIN(cx, I_WR) + (size_t)l_ * 1024 * 32 + e_;
        for (int k = cx.lane; k < 1024; k += 64) sm_ += sh_[k] * wr_[(size_t)k * 32];
        sm_ = wave_sum(sm_, cx.lane);
        if (cx.lane == 0) ((float*)(AWS(cx) + WS_RB2))[cx.gw] = sm_; }
    for (int idx = cx.gw * 64 + cx.lane; idx < 12 * 32 * 1024; idx += cx.NGW * 64) {
        const int k = idx & 1023, e = (idx >> 10) & 31, lm = idx >> 15, l_ = lm / 3, mrw_ = lm % 3;
        const float w = AIN(cx, I_WR)[((size_t)l_ * 1024 + k) * 32 + e] * AIN(cx, I_N2G)[l_ * 1024 + k] * (1.0f + MOD[((size_t)l_ * 3 + mrw_) * 6144 + 4 * 1024 + k]);
        const unsigned short hh = f2bf(w), ll = f2bf(w - bf2f(hh));
        unsigned char* img = AWS(cx) + WS_RW + (size_t)lm * RW_IMG + e * 2064 + k * 2;
        *(unsigned short*)img = hh; *(unsigned short*)(img + 66048) = ll; }
    f32x4 ig[4], ish[4], isc[4]; int cur_mr = -1;
#pragma unroll
    for (int j = 0; j < 4; ++j) ig[j] = *(const f32x4*)(AIN(cx, I_N1G) + 4 * cx.lane + 256 * j);
    if (cx.gw < NTOK) IN_LOAD(xn, cx.gw);
    for (int tok = cx.gw; tok < NTOK; tok += cx.NGW) {
        f32x4 x[4], y[4];
#pragma unroll
        for (int j = 0; j < 4; ++j) x[j] = xn[j];
        if (tok + cx.NGW < NTOK) IN_LOAD(xn, tok + cx.NGW);
        store_row_bf16(X0 + (size_t)tok * DM, x, cx.lane);
        const int mrw = mrow_of(tok);
        if (mrw != cur_mr) { cur_mr = mrw; const float* mr = MOD + (size_t)mrw * 6144;
#pragma unroll
            for (int j = 0; j < 4; ++j) { ish[j] = *(const f32x4*)(mr + 4 * cx.lane + 256 * j); isc[j] = *(const f32x4*)(mr + 1024 + 4 * cx.lane + 256 * j); } }
        modulate_row_c(x, ig, ish, isc, cx.lane, y);
        store_row_fp8((unsigned char*)ACT + (size_t)tok * DM, y, cx.lane);
    }
}

__device__ __forceinline__ void tok_decode(int tok, int& b, int& pos, bool& lat) {
    if (tok < NL) { b = tok >> 14; pos = tok & (SEQ - 1); lat = true; } else { const int t2 = tok - NL; b = t2 >> 8; pos = SEQ + (t2 & 255); lat = false; }
}
__device__ __forceinline__ void rope8(float (&v)[8], int pi0, int nf, float grow, float gcol) {
#pragma unroll
    for (int p = 0; p < 4; ++p) { const int pi = pi0 + p; const int f = pi < nf ? pi : pi - nf; const float pv = pi < nf ? grow : gcol;
        const float inv = __builtin_amdgcn_exp2f(-(float)f * (L2T / (float)nf)); const float rev = pv * inv * 0.15915494309189535f;
        const float sn = __builtin_amdgcn_sinf(rev), cs = __builtin_amdgcn_cosf(rev);
        const float x1 = v[2 * p], x2 = v[2 * p + 1]; v[2 * p] = x1 * cs - x2 * sn; v[2 * p + 1] = x1 * sn + x2 * cs; }
}

__device__ __forceinline__ void phase_postproj_even(const Ctx& cx, int li) {
    unsigned char* ws = AWS(cx); const bf16* RAW = (const bf16*)(ws + WS_RAW);
    const float* aq = AIN(cx, I_AQN) + li * 64; const float* ak = AIN(cx, I_AKN) + li * 64; const float* bq = AIN(cx, I_BQN) + li * 64; const float* bk = AIN(cx, I_BKN) + li * 64;
    u32x4 cw[5], nw[5];
#define PE_LOAD(W, T) do { const bf16* row_ = RAW + (size_t)(T) * RAWLD; _Pragma("unroll") for (int it = 0; it < 5; ++it) { const int ch_ = it * 64 + cx.lane; \
        W[it] = (u32x4){0u, 0u, 0u, 0u}; if (ch_ < 288) W[it] = *(const u32x4*)(row_ + ch_ * 8); } } while (0)
    float gv[4][8]; bool hasg[4];
#pragma unroll
    for (int it = 0; it < 4; ++it) { const int ch = it * 64 + cx.lane, hh = ch >> 3, d0 = (ch & 7) * 8;
        const float* gp = hh < 8 ? aq : hh < 10 ? ak : hh < 12 ? nullptr : hh < 20 ? bq : hh < 28 ? bk : nullptr; hasg[it] = gp != nullptr;
#pragma unroll
        for (int e = 0; e < 8; ++e) gv[it][e] = gp ? gp[d0 + e] : 1.0f; }
    if (cx.gw < NTOK) PE_LOAD(cw, cx.gw);
    for (int tok = cx.gw; tok < NTOK; tok += cx.NGW) {
        int b, pos; bool lat; tok_decode(tok, b, pos, lat);
        const float grow = (float)(pos >> 6), gcol = (float)(pos & 63);
        const bool hn = tok + cx.NGW < NTOK;
        if (hn) PE_LOAD(nw, tok + cx.NGW);
#pragma unroll
        for (int it = 0; it < 5; ++it) {
            const int ch = it * 64 + cx.lane; const bool on = ch < 288;
            const u32x4 w = cw[it];
            float v[8]; unpack8(w, v);
            float ss = 0.f;
#pragma unroll
            for (int e = 0; e < 8; ++e) ss += v[e] * v[e];
            ss = sum8(ss);
            const float rs = rsqrtf(ss * (1.0f / 64.0f) + EPS);
            const int hh = ch >> 3, d0 = (ch & 7) * 8;
            int seg, h;
            if (hh < 8) { seg = 0; h = hh; } else if (hh < 10) { seg = 1; h = hh - 8; } else if (hh < 12) { seg = 2; h = hh - 10; } else if (hh < 20) { seg = 3; h = hh - 12; } else if (hh < 28) { seg = 4; h = hh - 20; } else { seg = 5; h = hh - 28; }
            if (it < 4 && hasg[it < 4 ? it : 0]) {
#pragma unroll
                for (int e = 0; e < 8; ++e) v[e] = v[e] * rs * gv[it < 4 ? it : 0][e]; }
            if (seg <= 1 && lat) rope8(v, d0 >> 1, 16, grow, gcol);
            if (seg == 0) {
#pragma unroll
                for (int e = 0; e < 8; ++e) v[e] *= 8.0f * 0.125f * LOG2E; }
            bf16* dst;
            if (seg <= 1) {
                unsigned char* d8 = seg == 0 ? (unsigned char*)(ws + WS_QA) + ((size_t)(b * 8 + h) * SP + pos) * 64 : (unsigned char*)(ws + WS_KA) + ((size_t)(b * 2 + h) * SP + pos) * 64;
                u32x2 w8; w8.x = pg8::pk4_fp8(v[0], v[1], v[2], v[3]); w8.y = pg8::pk4_fp8(v[4], v[5], v[6], v[7]);
                if (on) *(u32x2*)(d8 + d0) = w8;
                continue; }
            if (seg == 0) dst = (bf16*)(ws + WS_QA) + ((size_t)(b * 8 + h) * SP + pos) * 64;
            else if (seg == 1) dst = (bf16*)(ws + WS_KA) + ((size_t)(b * 2 + h) * SP + pos) * 64;
            else if (seg == 2) dst = (bf16*)(ws + WS_VA) + ((size_t)(b * 2 + h) * SP + pos) * 64;
            else if (seg == 3) dst = (bf16*)(ws + WS_QB) + ((size_t)(b * 8 + h) * SP + pos) * 64;
            else if (seg == 4) dst = (bf16*)(ws + WS_KB) + ((size_t)(b * 8 + h) * SP + pos) * 64;
            else dst = (bf16*)(ws + WS_VB) + ((size_t)(b * 8 + h) * SP + pos) * 64;
            if (on && seg != 2) *(u32x4*)(dst + d0) = pack8(v);
        }
        if (hn) {
#pragma unroll
            for (int it = 0; it < 5; ++it) cw[it] = nw[it]; }
    }
#undef PE_LOAD
}

__device__ __forceinline__ void phase_postproj_odd(const Ctx& cx, int li) {
    unsigned char* ws = AWS(cx); const bf16* RAW = (const bf16*)(ws + WS_RAW);
    const float* cqg = AIN(cx, I_CQNG) + li * 256; const float* ckg = AIN(cx, I_CKVNG) + li * 128;
    u32x4 cw[4], nw[4];
#define PO_LOAD(W, T) do { const bf16* row_ = RAW + (size_t)(T) * RAWLD; _Pragma("unroll") for (int it = 0; it < 3; ++it) W[it] = *(const u32x4*)(row_ + (it * 64 + cx.lane) * 8); \
        W[3] = (u32x4){0u, 0u, 0u, 0u}; if (cx.lane < 48) W[3] = *(const u32x4*)(row_ + (256 + cx.lane) * 8); } while (0)
    float gqk[8];
#pragma unroll
    for (int e = 0; e < 8; ++e) gqk[e] = cx.lane < 32 ? cqg[cx.lane * 8 + e] : cx.lane < 48 ? ckg[(cx.lane - 32) * 8 + e] : 0.f;
    if (cx.gw < NTOK) PO_LOAD(cw, cx.gw);
    for (int tok = cx.gw; tok < NTOK; tok += cx.NGW) {
        int b, pos; bool lat; tok_decode(tok, b, pos, lat);
        const float grow = (float)(pos >> 6), gcol = (float)(pos & 63);
        const bool hn = tok + cx.NGW < NTOK;
        if (hn) PO_LOAD(nw, tok + cx.NGW);
#pragma unroll
        for (int it = 0; it < 3; ++it) {
            u32x4 w = cw[it];
            float v[8]; unpack8(w, v);
            const int h = cx.lane >> 4, d0 = (cx.lane & 15) * 8;
            if (it == 0) {
#pragma unroll
                for (int e = 0; e < 8; ++e) v[e] *= 0.08838834764831845f; }
            if (it < 2 && lat) rope8(v, d0 >> 1, 32, grow, gcol);
            bf16* dst = (bf16*)(ws + (it == 0 ? WS_RQ : it == 1 ? WS_RK : WS_RV)) + ((size_t)(b * 4 + h) * SP + pos) * 128 + d0;
            *(u32x4*)dst = pack8(v);
        }
        {
            const u32x4 w = cw[3];
            float v[8]; unpack8(w, v);
            float ss = 0.f;
#pragma unroll
            for (int e = 0; e < 8; ++e) ss += v[e] * v[e];
            ss = sum16(ss);
            const float ss16 = ss; { auto r = __builtin_amdgcn_permlane16_swap(__float_as_uint(ss), __float_as_uint(ss), false, false); ss = __uint_as_float(r[0]) + __uint_as_float(r[1]); }
            if (cx.lane < 32) { const float rs = rsqrtf(ss * (1.0f / 256.0f) + EPS); const int d0 = cx.lane * 8;
#pragma unroll
                for (int e = 0; e < 8; ++e) v[e] = v[e] * rs * gqk[e];
                *(u32x4*)((bf16*)(ws + WS_CQN) + (size_t)tok * 256 + d0) = pack8(v);
            } else if (cx.lane < 48) { const float rs = rsqrtf(ss16 * (1.0f / 128.0f) + EPS); const int d0 = (cx.lane - 32) * 8;
#pragma unroll
                for (int e = 0; e < 8; ++e) v[e] = v[e] * rs * gqk[e];
                *(u32x4*)((bf16*)(ws + WS_CKVN) + (size_t)tok * 256 + d0) = pack8(v);
            } else { *(u32x4*)((bf16*)(ws + WS_CKVN) + (size_t)tok * 256 + 128 + (cx.lane - 48) * 8) = zero4u(); }
        }
        if (hn) {
#pragma unroll
            for (int it = 0; it < 4; ++it) cw[it] = nw[it]; }
    }
#undef PO_LOAD
}

__device__ __forceinline__ void phase_mla_prep(const Ctx& cx, int li) {
    unsigned char* ws = AWS(cx); const bf16* RAW = (const bf16*)(ws + WS_RAW); const bf16* QMR = (const bf16*)(ws + WS_QMR); const bf16* KVR = (const bf16*)(ws + WS_KVR);
    const float* qg = AIN(cx, I_MQN) + li * 192; const float* kg = AIN(cx, I_MKN) + li * 192;
    const int li32 = cx.lane & 31, g2 = cx.lane >> 5; const bool on = li32 < 24; const int d0 = li32 * 8;
    u32x4 cq[2], ck[2], nq[2], nk[2];
#define MP_LOAD(Q, K, T) do { _Pragma("unroll") for (int j = 0; j < 2; ++j) { const int h_ = 2 * j + g2; Q[j] = (u32x4){0u, 0u, 0u, 0u}; K[j] = (u32x4){0u, 0u, 0u, 0u}; \
        if (on) Q[j] = *(const u32x4*)(QMR + (size_t)(T) * 768 + h_ * 192 + d0); \
        if (li32 < 16) K[j] = *(const u32x4*)(KVR + (size_t)(T) * 1024 + h_ * 256 + d0); else if (on) K[j] = *(const u32x4*)(RAW + (size_t)(T) * RAWLD + 2432 + (d0 - 128)); } } while (0)
    float qgv[8], kgv[8];
#pragma unroll
    for (int e = 0; e < 8; ++e) { qgv[e] = on ? qg[d0 + e] : 0.f; kgv[e] = on ? kg[d0 + e] : 0.f; }
    if (cx.gw < NTOK) MP_LOAD(cq, ck, cx.gw);
    for (int tok = cx.gw; tok < NTOK; tok += cx.NGW) {
        int b, pos; bool lat; tok_decode(tok, b, pos, lat);
        const float grow = (float)(pos >> 6), gcol = (float)(pos & 63);
        const bool hn = tok + cx.NGW < NTOK;
        if (hn) MP_LOAD(nq, nk, tok + cx.NGW);
#pragma unroll
        for (int j = 0; j < 2; ++j) {
            const int h = 2 * j + g2;
            { const u32x4 w = cq[j];
              float v[8]; unpack8(w, v); float ss = 0.f;
#pragma unroll
              for (int e = 0; e < 8; ++e) ss += v[e] * v[e];
              ss = sum32(ss);
              const float rs = rsqrtf(ss * (1.0f / 192.0f) + EPS);
              if (on) {
#pragma unroll
                  for (int e = 0; e < 8; ++e) v[e] = v[e] * rs * qgv[e];
                  if (li32 >= 16 && lat) rope8(v, (d0 - 128) >> 1, 16, grow, gcol);
#pragma unroll
                  for (int e = 0; e < 8; ++e) v[e] *= 16.0f * 0.07216878364870322f * LOG2E;
                  { u32x2 w8; w8.x = pg8::pk4_fp8(v[0], v[1], v[2], v[3]); w8.y = pg8::pk4_fp8(v[4], v[5], v[6], v[7]); *(u32x2*)((unsigned char*)(ws + WS_QM) + ((size_t)(b * 4 + h) * SP + pos) * 192 + d0) = w8; } } }
            { const u32x4 w = ck[j];
              float v[8]; unpack8(w, v); float ss = 0.f;
#pragma unroll
              for (int e = 0; e < 8; ++e) ss += v[e] * v[e];
              ss = sum32(ss);
              const float rs = rsqrtf(ss * (1.0f / 192.0f) + EPS);
              if (on) {
#pragma unroll
                  for (int e = 0; e < 8; ++e) v[e] = v[e] * rs * kgv[e];
                  if (li32 >= 16 && lat) rope8(v, (d0 - 128) >> 1, 16, grow, gcol);
                  { u32x2 w8; w8.x = pg8::pk4_fp8(v[0], v[1], v[2], v[3]); w8.y = pg8::pk4_fp8(v[4], v[5], v[6], v[7]); *(u32x2*)((unsigned char*)(ws + WS_KM) + ((size_t)(b * 4 + h) * SP + pos) * 192 + d0) = w8; } } }
        }
        if (hn) { cq[0] = nq[0]; cq[1] = nq[1]; ck[0] = nk[0]; ck[1] = nk[1]; }
    }
#undef MP_LOAD
}


template <int DV_>
__device__ __forceinline__ void phase_vtrans(const Ctx& cx, const bf16* src, int ld, int col0, int hstride, int nh, unsigned char* dst) {
    constexpr int TS = 80;
    unsigned char* T = (unsigned char*)cx.lds;
    const int nunits = NBATCH * (SP / 64) * nh;
    constexpr int CPR = DV_ / 8;
    constexpr int NLD = (64 * CPR) / 512;
    u32x4 cw[NLD], nw[NLD];
#define VT_LOAD(W, U) do { const int h_ = (U) % nh, g_ = ((U) / nh) % (SP / 64), b_ = (U) / (nh * (SP / 64)); const int p0_ = g_ * 64; \
        const size_t t0_ = p0_ < SEQ ? (size_t)b_ * SEQ + p0_ : (size_t)NL + b_ * CTXL + (p0_ - SEQ); \
        _Pragma("unroll") for (int i = 0; i < NLD; ++i) { const int id = cx.tid + i * 512, k = id / CPR, vc = (id % CPR) * 8; \
            W[i] = *(const u32x4*)(src + (t0_ + k) * (size_t)ld + col0 + h_ * hstride + vc); } } while (0)
    if (cx.bid < nunits) VT_LOAD(cw, cx.bid);
    for (int u = cx.bid; u < nunits; u += cx.G) {
        const int h = u % nh, g = (u / nh) % (SP / 64), b = u / (nh * (SP / 64));
        const int pos0 = g * 64;
        const bool hn = u + cx.G < nunits;
        if (hn) VT_LOAD(nw, u + cx.G);
#pragma unroll
        for (int i = 0; i < NLD; ++i) { const int id = cx.tid + i * 512, k = id / CPR, vc = (id % CPR) * 8;
            const u32x4 w = cw[i];
            float v[8]; unpack8(w, v);
            const int kk = k & 31, hi = (kk >> 2) & 1, r = (kk & 3) + 4 * (kk >> 3), byte = hi * 32 + 16 * (k >> 5) + r;
            const unsigned lo = pg8::pk4_fp8(v[0], v[1], v[2], v[3]), hi4 = pg8::pk4_fp8(v[4], v[5], v[6], v[7]);
#pragma unroll
            for (int e = 0; e < 4; ++e) { T[(vc + e) * TS + byte] = (unsigned char)(lo >> (8 * e)); T[(vc + 4 + e) * TS + byte] = (unsigned char)(hi4 >> (8 * e)); } }
        __syncthreads();
        if (cx.tid < DV_ * 4) { const int v = cx.tid >> 2, c = cx.tid & 3;
            *(u32x4*)(dst + ((size_t)(b * nh + h) * DV_ + v) * SP + pos0 + c * 16) = *(const u32x4*)(T + v * TS + c * 16); }
        __syncthreads();
        if (hn) {
#pragma unroll
            for (int i = 0; i < NLD; ++i) cw[i] = nw[i]; }
    }
#undef VT_LOAD
}
__device__ __forceinline__ float log2_sigmoid(float x) { return -__builtin_amdgcn_logf(1.0f + __builtin_amdgcn_exp2f(-x * LOG2E)); }
__device__ __forceinline__ void phase_ret_kv(const Ctx& cx, int li) {
    unsigned char* ws = AWS(cx); char* T0 = cx.lds; char* T1 = cx.lds + TBYTES; char* T2 = cx.lds + 2 * TBYTES;
    const int r32 = cx.lane & 31, hi = cx.lane >> 5, mb = cx.wave & 3, nb0 = 2 * (cx.wave >> 2);
    float l2tab[8];
#pragma unroll
    for (int i = 0; i < 8; ++i) l2tab[i] = log2_sigmoid(AIN(cx, I_RDEC)[li * 8 + i]);
    u32x4 ck[4], cv[4], nk[4], nv[4];
#define RK_LOAD(KW, VW, U) do { const int c_ = (U) % NCHUNK, bh_ = (U) / NCHUNK; const size_t base_ = ((size_t)bh_ * SP + ret_chunk_pos(c_)) * 128; \
        const bf16* Kc_ = (const bf16*)(ws + WS_RK) + base_; const bf16* Vc_ = (const bf16*)(ws + WS_RV) + base_; \
        _Pragma("unroll") for (int i = 0; i < 4; ++i) { const int id = cx.tid + i * 512, s = id >> 4, d0 = (id & 15) * 8; \
            KW[i] = *(const u32x4*)(Kc_ + (size_t)s * 128 + d0); VW[i] = *(const u32x4*)(Vc_ + (size_t)s * 128 + d0); } } while (0)
    if (cx.bid < 8 * NCHUNK) RK_LOAD(ck, cv, cx.bid);
    for (int u = cx.bid; u < 8 * NCHUNK; u += cx.G) {
        const int c = u % NCHUNK, bh = u / NCHUNK, h = bh & 3;
        const float l2f = h == 0 ? l2tab[0] : h == 1 ? l2tab[1] : h == 2 ? l2tab[2] : l2tab[3], l2b = h == 0 ? l2tab[4] : h == 1 ? l2tab[5] : h == 2 ? l2tab[6] : l2tab[7];
        const bool hn = u + cx.G < 8 * NCHUNK;
        if (hn) RK_LOAD(nk, nv, u + cx.G);
#pragma unroll
        for (int i = 0; i < 4; ++i) { const int id = cx.tid + i * 512, s = id >> 4, d0 = (id & 15) * 8;
            const u32x4 kw = ck[i], vw = cv[i];
            float kv[8]; unpack8(kw, kv);
            const float df = exp2f(l2f * (float)(127 - s)), db = exp2f(l2b * (float)s);
            const unsigned short* vs = (const unsigned short*)&vw;
#pragma unroll
            for (int e = 0; e < 8; ++e) { *(bf16*)(T0 + toff(d0 + e, s * 2)) = vs[e]; *(bf16*)(T1 + toff(d0 + e, s * 2)) = (bf16)f2bf(kv[e] * df); *(bf16*)(T2 + toff(d0 + e, s * 2)) = (bf16)f2bf(kv[e] * db); } }
        __syncthreads();
#pragma unroll
        for (int dir = 0; dir < 2; ++dir) {
            f32x16 c0 = (f32x16){0}, c1 = (f32x16){0};
            mm128(T0, dir ? T2 : T1, c0, c1, mb, nb0, r32, hi);
            float* dst = (float*)(ws + WS_KVP) + ((size_t)(dir * 8 + bh) * NCHUNK + c) * 16384;
#pragma unroll
            for (int r = 0; r < 16; ++r) { const int v = mb * 32 + crow(r, hi); dst[v * 128 + nb0 * 32 + r32] = c0[r]; dst[v * 128 + nb0 * 32 + 32 + r32] = c1[r]; }
        }
        __syncthreads();
        if (hn) {
#pragma unroll
            for (int i = 0; i < 4; ++i) { ck[i] = nk[i]; cv[i] = nv[i]; } }
    }
#undef RK_LOAD
}
__device__ __forceinline__ void phase_ret_scan(const Ctx& cx, int li) {
    unsigned char* ws = AWS(cx); const float* KVP = (const float*)(ws + WS_KVP); bf16* STP = (bf16*)(ws + WS_STP);
    for (int idx = cx.bid * 512 + cx.tid; idx < 16 * 8192; idx += cx.G * 512) {
        const int seq = idx >> 13, el = (idx & 8191) * 2, dir = seq >> 3, h = seq & 3;
        const float cd = __builtin_amdgcn_exp2f(128.0f * log2_sigmoid(AIN(cx, I_RDEC)[li * 8 + dir * 4 + h]));
        float s0 = 0.f, s1 = 0.f; const size_t sb = (size_t)seq * NCHUNK * 16384 + el;
#pragma unroll 1
        for (int g = 0; g < 5; ++g) {
            f32x2 kv[26];
#pragma unroll
            for (int j = 0; j < 26; ++j) { const int s = g * 26 + j, c = dir == 0 ? (s < 2 ? 128 + s : s - 2) : 129 - s; kv[j] = *(const f32x2*)(KVP + sb + (size_t)c * 16384); }
#pragma unroll
            for (int j = 0; j < 26; ++j) { const int s = g * 26 + j, c = dir == 0 ? (s < 2 ? 128 + s : s - 2) : 129 - s;
                *(unsigned*)(STP + sb + (size_t)c * 16384) = pk2(s0, s1); s0 = s0 * cd + kv[j].x; s1 = s1 * cd + kv[j].y; }
        }
    }
}
__device__ __forceinline__ void phase_ret_out(const Ctx& cx, int li, int nchunk  ) {
    unsigned char* ws = AWS(cx); char* T0 = cx.lds; char* T1 = cx.lds + TBYTES; char* T2 = cx.lds + 2 * TBYTES; char* T3 = cx.lds + 3 * TBYTES;
    static_assert(4 * TBYTES <= MISC_OFF, "retention tiles");
    float* red = (float*)(cx.lds + MISC_OFF + 1024);
    const int mb = cx.wave & 3, wv = cx.wave >> 2, nb0 = 2 * wv;
    const bf16* RAW = (const bf16*)(ws + WS_RAW); bf16* OCAT = (bf16*)(ws + WS_OCAT);
    float l2tab[8];
#pragma unroll
    for (int i = 0; i < 8; ++i) l2tab[i] = log2_sigmoid(AIN(cx, I_RDEC)[li * 8 + i]);
    for (int u = cx.bid; u < 8 * nchunk; u += cx.G) {
        int lane_l = cx.lane; asm volatile("" : "+v"(lane_l));
        const int r32 = lane_l & 31, hi = lane_l >> 5;
        const int c = u % nchunk, bh = u / nchunk, h = bh & 3, b = bh >> 2;
        const float l2f = h == 0 ? l2tab[0] : h == 1 ? l2tab[1] : h == 2 ? l2tab[2] : l2tab[3], l2b = h == 0 ? l2tab[4] : h == 1 ? l2tab[5] : h == 2 ? l2tab[6] : l2tab[7];
        const int p0 = ret_chunk_pos(c);
        const size_t base = ((size_t)bh * SP + p0) * 128;
        stage_nat((const bf16*)(ws + WS_RQ) + base, T0, cx.tid);
        stage_nat((const bf16*)(ws + WS_RK) + base, T1, cx.tid);
        stage_nat((const bf16*)(ws + WS_STP) + ((size_t)(0 * 8 + bh) * NCHUNK + c) * 16384, T3, cx.tid);
        u32x4 sbw[4];
        { const bf16* sb_ = (const bf16*)(ws + WS_STP) + ((size_t)(1 * 8 + bh) * NCHUNK + c) * 16384;
#pragma unroll
          for (int i = 0; i < 4; ++i) { const int id = cx.tid + i * 512, row = id >> 4, c8 = id & 15; sbw[i] = *(const u32x4*)(sb_ + (size_t)row * 128 + c8 * 8); } }
        { const bf16* Vc = (const bf16*)(ws + WS_RV) + base;
#pragma unroll
          for (int i = 0; i < 4; ++i) { const int id = cx.tid + i * 512, s = id >> 4, d0 = (id & 15) * 8; const u32x4 vw = *(const u32x4*)(Vc + (size_t)s * 128 + d0);
              const unsigned short* vs = (const unsigned short*)&vw;
#pragma unroll
              for (int e = 0; e < 8; ++e) *(bf16*)(T2 + toff(d0 + e, s * 2)) = vs[e]; } }
        __syncthreads();
        f32x16 s0 = (f32x16){0}, s1 = (f32x16){0}, y0 = (f32x16){0}, y1 = (f32x16){0};
        mm128(T0, T1, s0, s1, mb, nb0, r32, hi);
        mm128(T0, T3, y0, y1, mb, nb0, r32, hi);
#pragma unroll
        for (int r = 0; r < 16; ++r) { const int t = mb * 32 + crow(r, hi); const float qd = exp2f(l2f * (float)(t + 1)); y0[r] *= qd; y1[r] *= qd; }
        __syncthreads();
#pragma unroll
        for (int r = 0; r < 16; ++r) { const int t = mb * 32 + crow(r, hi);
            { const int s = nb0 * 32 + r32, n = t - s; const float d = exp2f(n >= 0 ? l2f * (float)n : -l2b * (float)n); *(bf16*)(T1 + toff(t, s * 2)) = (bf16)f2bf(s0[r] * d); }
            { const int s = nb0 * 32 + 32 + r32, n = t - s; const float d = exp2f(n >= 0 ? l2f * (float)n : -l2b * (float)n); *(bf16*)(T1 + toff(t, s * 2)) = (bf16)f2bf(s1[r] * d); } }
#pragma unroll
        for (int i = 0; i < 4; ++i) { const int id = cx.tid + i * 512, row = id >> 4, c8 = id & 15; *(u32x4*)(T3 + toff(row, c8 * 16)) = sbw[i]; }
        __syncthreads();
        mm128(T1, T2, y0, y1, mb, nb0, r32, hi);
        { f32x16 z0 = (f32x16){0}, z1 = (f32x16){0};
          mm128(T0, T3, z0, z1, mb, nb0, r32, hi);
#pragma unroll
          for (int r = 0; r < 16; ++r) { const int t = mb * 32 + crow(r, hi); const float qd = exp2f(l2b * (float)(128 - t)); y0[r] += qd * z0[r]; y1[r] += qd * z1[r]; } }
        const int tok0 = __builtin_amdgcn_readfirstlane(p0 < SEQ ? b * SEQ + p0 : NL + b * CTXL + (p0 - SEQ));
        const char* grb = (const char*)(RAW + (size_t)tok0 * RAWLD + 1536 + h * 128); char* orb = (char*)(OCAT + (size_t)tok0 * DM + h * 128);
        unsigned short gtv[32];
#pragma unroll
        for (int r = 0; r < 16; ++r) { const int t = mb * 32 + crow(r, hi); const unsigned go = (unsigned)(t * RAWLD + nb0 * 32 + r32) * 2u;
            gtv[2 * r] = *(const unsigned short*)(grb + go); gtv[2 * r + 1] = *(const unsigned short*)(grb + go + 64); }
        const float* gng = AIN(cx, I_RGN) + li * 512 + h * 128;
        const float g0 = gng[nb0 * 32 + r32], g1 = gng[nb0 * 32 + 32 + r32];
#pragma unroll
        for (int r = 0; r < 16; ++r) { float sm = y0[r] + y1[r], sq = y0[r] * y0[r] + y1[r] * y1[r];
            sm = sum32(sm); sq = sum32(sq);
            if (r32 == 0) { const int t = mb * 32 + crow(r, hi); red[(t * 2 + wv) * 2] = sm; red[(t * 2 + wv) * 2 + 1] = sq; } }
        __syncthreads();
#pragma unroll
        for (int r = 0; r < 16; ++r) { const int t = mb * 32 + crow(r, hi);
            const float sm = red[(t * 2) * 2] + red[(t * 2 + 1) * 2], sq = red[(t * 2) * 2 + 1] + red[(t * 2 + 1) * 2 + 1];
            const float mu = sm * (1.0f / 128.0f), var = fmaxf(sq * (1.0f / 128.0f) - mu * mu, 0.f), rs = rsqrtf(var + GN_EPS);
            const unsigned oo = (unsigned)(t * DM + nb0 * 32 + r32) * 2u;
            { const float gt = bf2f(gtv[2 * r]); *(bf16*)(orb + oo) = (bf16)f2bf((y0[r] - mu) * rs * g0 * silu_f(gt)); }
            { const float gt = bf2f(gtv[2 * r + 1]); *(bf16*)(orb + oo + 64) = (bf16)f2bf((y1[r] - mu) * rs * g1 * silu_f(gt)); }
            if ((r & 3) == 3) asm volatile("" ::: "memory"); }
        __syncthreads();
    }
}

__device__ __forceinline__ void phase_wout_ctx(const Ctx& cx, const bf16* W, const float* gate) {
    unsigned char* ws = AWS(cx);
    const bf16* A = (const bf16*)(ws + WS_OCAT); const bf16* X0 = (const bf16*)(ws + WS_X0); bf16* X1 = (bf16*)(ws + WS_X1);
    const int fr = cx.lane & 15, fq = cx.lane >> 4;
    for (int blk = cx.bid; blk < 256; blk += cx.G) {
        const int r0 = NL + (blk >> 4) * 32 + (cx.wave >> 2) * 16, c0 = (blk & 15) * 64 + (cx.wave & 3) * 16;
        const bf16* ap = A + (size_t)(r0 + fr) * DM + fq * 8; const bf16* wp = W + (size_t)(c0 + fr) * DM + fq * 8;
        f32x4 acc = {0.f, 0.f, 0.f, 0.f};
#pragma unroll
        for (int k0 = 0; k0 < 1024; k0 += 256) { bf16x8 a[8], w[8];
#pragma unroll
            for (int i = 0; i < 8; ++i) { a[i] = *(const bf16x8*)(ap + k0 + i * 32); w[i] = *(const bf16x8*)(wp + k0 + i * 32); }
#pragma unroll
            for (int i = 0; i < 8; ++i) acc = __builtin_amdgcn_mfma_f32_16x16x32_bf16(w[i], a[i], acc, 0, 0, 0); }
        const size_t off = (size_t)(r0 + fr) * DM + c0 + 4 * fq;
        const u32x2 bw = *(const u32x2*)(X0 + off); const f32x4 gv = *(const f32x4*)(gate + 2 * 6144 + c0 + 4 * fq);
        const f32x4 bs = {__uint_as_float(bw.x << 16), __uint_as_float(bw.x & 0xffff0000u), __uint_as_float(bw.y << 16), __uint_as_float(bw.y & 0xffff0000u)};
        const f32x4 r = bs + gv * acc;
        u32x2 wv; wv.x = pk2(r[0], r[1]); wv.y = pk2(r[2], r[3]); *(u32x2*)(X1 + off) = wv;
    }
}

__device__ __forceinline__ void router_finish(float (&acc)[32], int lane, int my_e, float bias, int tok, int* hist, int* TOPE, float* TOPG, int* TOPR) {
#pragma unroll
    for (int i = 0; i < 16; ++i) { auto r = __builtin_amdgcn_permlane32_swap(__float_as_uint(acc[i]), __float_as_uint(acc[i + 16]), false, false); acc[i] = __uint_as_float(r[0]) + __uint_as_float(r[1]); }
#pragma unroll
    for (int i = 0; i < 8; ++i) { auto r = __builtin_amdgcn_permlane16_swap(__float_as_uint(acc[i]), __float_as_uint(acc[i + 8]), false, false); acc[i] = __uint_as_float(r[0]) + __uint_as_float(r[1]); }
    { const bool up = (lane & 8) != 0;
#pragma unroll
      for (int i = 0; i < 4; ++i) { const float t1 = acc[i] + dppf<0x128>(acc[i]), t2 = acc[i + 4] + dppf<0x128>(acc[i + 4]); acc[i] = up ? t2 : t1; } }
    { const bool up = (lane & 4) != 0;
#pragma unroll
      for (int i = 0; i < 2; ++i) { const float t1 = acc[i] + dppf<0x141>(acc[i]), t2 = acc[i + 2] + dppf<0x141>(acc[i + 2]); acc[i] = up ? t2 : t1; } }
    { const bool up = (lane & 2) != 0;
      const float t1 = acc[0] + dppf<0x4E>(acc[0]), t2 = acc[1] + dppf<0x4E>(acc[1]); acc[0] = up ? t2 : t1; }
    float v = acc[0] + dppf<0xB1>(acc[0]) + bias;
    float tv[4]; int te[4];
#pragma unroll
    for (int k = 0; k < 4; ++k) {
        float m = fmaxf(v, dppf<0xB1>(v)); m = fmaxf(m, dppf<0x4E>(m)); m = fmaxf(m, dppf<0x141>(m)); m = fmaxf(m, dppf<0x140>(m));
        { auto r = __builtin_amdgcn_permlane16_swap(__float_as_uint(m), __float_as_uint(m), false, false); m = fmaxf(__uint_as_float(r[0]), __uint_as_float(r[1])); }
        { auto r = __builtin_amdgcn_permlane32_swap(__float_as_uint(m), __float_as_uint(m), false, false); m = fmaxf(__uint_as_float(r[0]), __uint_as_float(r[1])); }
        const unsigned long long bm = __ballot(v == m);
        const int be = (int)(__builtin_ctzll(bm) >> 1);
        tv[k] = m; te[k] = be; if (my_e == be) v = -INFINITY; }
    if (lane == 0) {
        const float e1 = __expf(tv[1] - tv[0]), e2 = __expf(tv[2] - tv[0]), e3 = __expf(tv[3] - tv[0]); const float inv = 1.0f / (1.0f + e1 + e2 + e3);
        const float gs[4] = {inv, e1 * inv, e2 * inv, e3 * inv};
#pragma unroll
        for (int k = 0; k < 4; ++k) { const int rk = atomicAdd(&hist[te[k]], 1); TOPE[tok * 4 + k] = te[k]; TOPG[tok * 4 + k] = gs[k]; TOPR[tok * 4 + k] = rk; }
    }
}
__device__ __forceinline__ void router_top4(float v, int lane, int my_e, int tok, int* hist, int* TOPE, float* TOPG, int* TOPR) {
    float tv[4]; int te[4];
#pragma unroll
    for (int k = 0; k < 4; ++k) {
        float m = fmaxf(v, dppf<0xB1>(v)); m = fmaxf(m, dppf<0x4E>(m)); m = fmaxf(m, dppf<0x141>(m)); m = fmaxf(m, dppf<0x140>(m));
        { auto r = __builtin_amdgcn_permlane16_swap(__float_as_uint(m), __float_as_uint(m), false, false); m = fmaxf(__uint_as_float(r[0]), __uint_as_float(r[1])); }
        { auto r = __builtin_amdgcn_permlane32_swap(__float_as_uint(m), __float_as_uint(m), false, false); m = fmaxf(__uint_as_float(r[0]), __uint_as_float(r[1])); }
        const unsigned long long bm = __ballot(v == m);
        const int be = (int)(__builtin_ctzll(bm) >> 1);
        tv[k] = m; te[k] = be; if (my_e == be) v = -INFINITY; }
    {
        const float e1 = __expf(tv[1] - tv[0]), e2 = __expf(tv[2] - tv[0]), e3 = __expf(tv[3] - tv[0]); const float inv = 1.0f / (1.0f + e1 + e2 + e3);
        if (lane < 4) { const float g = lane == 0 ? inv : lane == 1 ? e1 * inv : lane == 2 ? e2 * inv : e3 * inv; const int e = lane == 0 ? te[0] : lane == 1 ? te[1] : lane == 2 ? te[2] : te[3];
            const int rk = atomicAdd(&hist[e], 1); TOPE[tok * 4 + lane] = e; TOPG[tok * 4 + lane] = g; TOPR[tok * 4 + lane] = rk; }
    }
}
#ifndef ROUTER_MFMA
#define ROUTER_MFMA 1
#endif
#if ROUTER_MFMA
__device__ __forceinline__ void phase_router(const Ctx& cx, int l, int n) {
    unsigned char* ws = AWS(cx); const bf16* X1 = (const bf16*)(ws + WS_X1); bf16* ACT = (bf16*)(ws + WS_ACT); const float* MOD = (const float*)(ws + WS_MOD) + (size_t)l * 3 * 6144;
    int* hist = (int*)(cx.lds + SCR_OFF + 4096);
    const float* wr = AIN(cx, I_WR) + (size_t)l * 1024 * 32; const float* br = AIN(cx, I_BR) + l * 32;
    float* LG = (float*)(ws + WS_LG); const float* RB2 = (const float*)(ws + WS_RB2) + l * 96;
    if (cx.tid < 32) hist[cx.tid] = 0;
    const int tpb = (n + cx.G - 1) / cx.G, t0 = cx.bid * tpb, t1 = (t0 + tpb < n) ? t0 + tpb : n;
    const int lane = cx.lane, fr = lane & 15, fq = lane >> 4;
    if (t1 > t0) {
        const int mr_lo = mrow_of(t0), mr_hi = mrow_of(t1 - 1);
        for (int mrw = mr_lo; mrw <= mr_hi; ++mrw) {
            const int lo_b = mrw == 0 ? 0 : (mrw == 1 ? SEQ : NL), hi_b = mrw == 0 ? SEQ : (mrw == 1 ? NL : NTOK);
            const int s0 = t0 > lo_b ? t0 : lo_b, s1 = t1 < hi_b ? t1 : hi_b;
            if (s1 <= s0) continue;
            __syncthreads();
            { const unsigned char* img = ws + WS_RW + (size_t)(l * 3 + mrw) * RW_IMG;
              for (int pc = cx.wave; pc < 129; pc += 8) pg8::glds16((const void*)img, (unsigned)(pc * 1024 + lane * 16), (unsigned)(uintptr_t)cx.lds + (unsigned)(pc * 1024));
              asm volatile("s_waitcnt vmcnt(0)" ::: "memory"); }
            __syncthreads();
            f32x4 bias0, bias1;
#pragma unroll
            for (int i = 0; i < 4; ++i) { bias0[i] = RB2[mrw * 32 + 4 * fq + i] + br[4 * fq + i]; bias1[i] = RB2[mrw * 32 + 16 + 4 * fq + i] + br[16 + 4 * fq + i]; }
            const int ng = (s1 - s0 + 15) >> 4;
            for (int gi = cx.wave; gi < ng; gi += 8) {
                const int tk = s0 + gi * 16 + fr, tkc = tk < s1 ? tk : s1 - 1;
                const bf16* ap = X1 + (size_t)tkc * DM + fq * 8;
                f32x4 acc0 = {0.f, 0.f, 0.f, 0.f}, acc1 = {0.f, 0.f, 0.f, 0.f}, gr = {0.f, 0.f, 0.f, 0.f};
                const char* bq = cx.lds + fr * 2064 + fq * 16;
                bf16x8 a[8], an[8];
#pragma unroll
                for (int i = 0; i < 8; ++i) a[i] = *(const bf16x8*)(ap + i * 32);
#pragma unroll 1
                for (int k0 = 0; k0 < 1024; k0 += 256) {
                    if (k0 + 256 < 1024) {
#pragma unroll
                        for (int i = 0; i < 8; ++i) an[i] = *(const bf16x8*)(ap + k0 + 256 + i * 32); }
#pragma unroll
                    for (int i = 0; i < 8; ++i) { const char* bp = bq + ((k0 >> 5) + i) * 64;
                        const bf16x8 bh0 = *(const bf16x8*)bp, bh1 = *(const bf16x8*)(bp + 33024), bl0 = *(const bf16x8*)(bp + 66048), bl1 = *(const bf16x8*)(bp + 66048 + 33024);
                        acc0 = __builtin_amdgcn_mfma_f32_16x16x32_bf16(bh0, a[i], acc0, 0, 0, 0); acc1 = __builtin_amdgcn_mfma_f32_16x16x32_bf16(bh1, a[i], acc1, 0, 0, 0);
                        acc0 = __builtin_amdgcn_mfma_f32_16x16x32_bf16(bl0, a[i], acc0, 0, 0, 0); acc1 = __builtin_amdgcn_mfma_f32_16x16x32_bf16(bl1, a[i], acc1, 0, 0, 0);
                        gr = __builtin_amdgcn_mfma_f32_16x16x32_bf16(a[i], a[i], gr, 0, 0, 0); }
#pragma unroll
                    for (int i = 0; i < 8; ++i) a[i] = an[i]; }
                const int q = fr & 3; float d = q == 0 ? gr[0] : q == 1 ? gr[1] : q == 2 ? gr[2] : gr[3]; d = (fr >> 2) == fq ? d : 0.f;
                { auto r = __builtin_amdgcn_permlane16_swap(__float_as_uint(d), __float_as_uint(d), false, false); d = __uint_as_float(r[0]) + __uint_as_float(r[1]); }
                { auto r = __builtin_amdgcn_permlane32_swap(__float_as_uint(d), __float_as_uint(d), false, false); d = __uint_as_float(r[0]) + __uint_as_float(r[1]); }
                const float rs = rsqrtf(d * (1.0f / DM) + EPS);
                if (tk < s1) { *(f32x4*)(LG + (size_t)tk * 32 + 4 * fq) = acc0 * rs + bias0; *(f32x4*)(LG + (size_t)tk * 32 + 16 + 4 * fq) = acc1 * rs + bias1; }
            }
        }
    }
    __syncthreads();
    int* TOPE = (int*)(ws + WS_TOPE); float* TOPG = (float*)(ws + WS_TOPG); int* TOPR = (int*)(ws + WS_TOPR);
    const int my_e = lane >> 1;
    u32x2 pra[4], prb[4];
    float pva = 0.f, pvb = 0.f;
#define RT_LG(T) __uint_as_float(__hip_atomic_load((const unsigned*)(LG + (size_t)(T) * 32 + my_e), __ATOMIC_RELAXED, __HIP_MEMORY_SCOPE_AGENT))
    { const int tk = t0 + 2 * cx.wave;
      if (tk < t1) { const int tkb = tk + 1 < t1 ? tk + 1 : tk; pva = RT_LG(tk); pvb = RT_LG(tkb);
#pragma unroll
          for (int j = 0; j < 4; ++j) { pra[j] = *(const u32x2*)(X1 + (size_t)tk * DM + 4 * lane + 256 * j); prb[j] = *(const u32x2*)(X1 + (size_t)tkb * DM + 4 * lane + 256 * j); } } }
    f32x4 rg[4], rsh[4], rsc[4]; int cur_mr = -1;
#pragma unroll
    for (int j = 0; j < 4; ++j) rg[j] = *(const f32x4*)(AIN(cx, I_N2G) + l * 1024 + 4 * lane + 256 * j);
    for (int tok = t0 + 2 * cx.wave; tok < t1; tok += 16) {
        const bool has2 = tok + 1 < t1; const int tokb = has2 ? tok + 1 : tok;
        const float va = pva, vb = pvb;
        { f32x4 x[4], xb[4], ya[4], yb[4];
#pragma unroll
          for (int j = 0; j < 4; ++j) { const u32x2 w = pra[j], w2 = prb[j];
              x[j] = (f32x4){__uint_as_float(w.x << 16), __uint_as_float(w.x & 0xffff0000u), __uint_as_float(w.y << 16), __uint_as_float(w.y & 0xffff0000u)};
              xb[j] = (f32x4){__uint_as_float(w2.x << 16), __uint_as_float(w2.x & 0xffff0000u), __uint_as_float(w2.y << 16), __uint_as_float(w2.y & 0xffff0000u)}; }
          { const int tn = tok + 16;
            if (tn < t1) { const int tnb = tn + 1 < t1 ? tn + 1 : tn; pva = RT_LG(tn); pvb = RT_LG(tnb);
#pragma unroll
                for (int j = 0; j < 4; ++j) { pra[j] = *(const u32x2*)(X1 + (size_t)tn * DM + 4 * lane + 256 * j); prb[j] = *(const u32x2*)(X1 + (size_t)tnb * DM + 4 * lane + 256 * j); } } }
          const int mra = mrow_of(tok), mrb = mrow_of(tokb);
          if (mra != cur_mr) { cur_mr = mra; const float* mr = MOD + (size_t)mra * 6144;
#pragma unroll
              for (int j = 0; j < 4; ++j) { rsh[j] = *(const f32x4*)(mr + 3 * 1024 + 4 * lane + 256 * j); rsc[j] = *(const f32x4*)(mr + 4 * 1024 + 4 * lane + 256 * j); } }
          modulate_row_c(x, rg, rsh, rsc, lane, ya);
#pragma unroll
          for (int j = 0; j < 4; ++j) *(unsigned*)((unsigned char*)ACT + (size_t)tok * DM + 4 * lane + 256 * j) = pg8::pk4_fp8(ya[j].x, ya[j].y, ya[j].z, ya[j].w);
          if (mrb == mra) modulate_row_c(xb, rg, rsh, rsc, lane, yb);
          else { const float* mr2 = MOD + (size_t)mrb * 6144; modulate_row(xb, AIN(cx, I_N2G) + l * 1024, mr2 + 3 * 1024, mr2 + 4 * 1024, lane, yb); }
#pragma unroll
          for (int j = 0; j < 4; ++j) *(unsigned*)((unsigned char*)ACT + (size_t)tokb * DM + 4 * lane + 256 * j) = pg8::pk4_fp8(yb[j].x, yb[j].y, yb[j].z, yb[j].w); }
        router_top4(va, lane, my_e, tok, hist, TOPE, TOPG, TOPR);
        if (has2) router_top4(vb, lane, my_e, tokb, hist, TOPE, TOPG, TOPR);
    }
#undef RT_LG
    __syncthreads();
    if (cx.tid < 32) ((int*)(ws + WS_HIST))[cx.bid * 32 + cx.tid] = hist[cx.tid];
}
#else
__device__ __forceinline__ void phase_router(const Ctx& cx, int l, int n) {
    unsigned char* ws = AWS(cx); const bf16* X1 = (const bf16*)(ws + WS_X1); bf16* ACT = (bf16*)(ws + WS_ACT); const float* MOD = (const float*)(ws + WS_MOD) + (size_t)l * 3 * 6144;
    int* hist = (int*)(cx.lds + SCR_OFF);
    float* wT = (float*)cx.lds;
    const float* wr = AIN(cx, I_WR) + (size_t)l * 1024 * 32; const float* br = AIN(cx, I_BR) + l * 32;
    if (cx.tid < 32) hist[cx.tid] = 0;
#pragma unroll 4
    for (int it = 0; it < 16; ++it) { const int idx = cx.tid + 512 * it, k = idx & 1023, e4 = idx >> 10; const f32x4 wv = *(const f32x4*)(wr + (size_t)k * 32 + e4 * 4);
        wT[(e4 * 4 + 0) * 1024 + k] = wv.x; wT[(e4 * 4 + 1) * 1024 + k] = wv.y; wT[(e4 * 4 + 2) * 1024 + k] = wv.z; wT[(e4 * 4 + 3) * 1024 + k] = wv.w; }
    __syncthreads();
    const int tpb = (n + cx.G - 1) / cx.G, t0 = cx.bid * tpb, t1 = (t0 + tpb < n) ? t0 + tpb : n;
    int* TOPE = (int*)(ws + WS_TOPE); float* TOPG = (float*)(ws + WS_TOPG); int* TOPR = (int*)(ws + WS_TOPR);
    const int lane = cx.lane;
    const int my_e = ((lane >> 5) & 1) * 16 + ((lane >> 4) & 1) * 8 + ((lane >> 3) & 1) * 4 + ((lane >> 2) & 1) * 2 + ((lane >> 1) & 1);
    const float bias = br[my_e];
    u32x2 pra[4], prb[4];
    { const int tk = t0 + 2 * cx.wave;
      if (tk < t1) { const int tkb = tk + 1 < t1 ? tk + 1 : tk;
#pragma unroll
          for (int j = 0; j < 4; ++j) { pra[j] = *(const u32x2*)(X1 + (size_t)tk * DM + 4 * lane + 256 * j); prb[j] = *(const u32x2*)(X1 + (size_t)tkb * DM + 4 * lane + 256 * j); } } }
    for (int tok = t0 + 2 * cx.wave; tok < t1; tok += 16) {
        const bool has2 = tok + 1 < t1; const int tokb = has2 ? tok + 1 : tok;
        f32x2 y2[4][4];
        { f32x4 x[4], xb[4], ya[4], yb[4];
#pragma unroll
          for (int j = 0; j < 4; ++j) { const u32x2 w = pra[j], w2 = prb[j];
              x[j] = (f32x4){__uint_as_float(w.x << 16), __uint_as_float(w.x & 0xffff0000u), __uint_as_float(w.y << 16), __uint_as_float(w.y & 0xffff0000u)};
              xb[j] = (f32x4){__uint_as_float(w2.x << 16), __uint_as_float(w2.x & 0xffff0000u), __uint_as_float(w2.y << 16), __uint_as_float(w2.y & 0xffff0000u)}; }
          { const int tn = tok + 16;
            if (tn < t1) { const int tnb = tn + 1 < t1 ? tn + 1 : tn;
#pragma unroll
                for (int j = 0; j < 4; ++j) { pra[j] = *(const u32x2*)(X1 + (size_t)tn * DM + 4 * lane + 256 * j); prb[j] = *(const u32x2*)(X1 + (size_t)tnb * DM + 4 * lane + 256 * j); } } }
          const float* mr = MOD + (size_t)mrow_of(tok) * 6144;
          modulate_row(x, AIN(cx, I_N2G) + l * 1024, mr + 3 * 1024, mr + 4 * 1024, lane, ya);
#pragma unroll
          for (int j = 0; j < 4; ++j) *(unsigned*)((unsigned char*)ACT + (size_t)tok * DM + 4 * lane + 256 * j) = pg8::pk4_fp8(ya[j].x, ya[j].y, ya[j].z, ya[j].w);
          const float* mr2 = MOD + (size_t)mrow_of(tokb) * 6144;
          modulate_row(xb, AIN(cx, I_N2G) + l * 1024, mr2 + 3 * 1024, mr2 + 4 * 1024, lane, yb);
#pragma unroll
          for (int j = 0; j < 4; ++j) *(unsigned*)((unsigned char*)ACT + (size_t)tokb * DM + 4 * lane + 256 * j) = pg8::pk4_fp8(yb[j].x, yb[j].y, yb[j].z, yb[j].w);
#pragma unroll
          for (int j = 0; j < 4; ++j)
#pragma unroll
              for (int i = 0; i < 4; ++i) y2[j][i] = (f32x2){ya[j][i], yb[j][i]}; }
        float acc0[32], acc1[32];
#pragma unroll
        for (int e = 0; e < 32; ++e) { f32x2 s2 = (f32x2){0.f, 0.f};
#pragma unroll
            for (int j = 0; j < 4; ++j) { const f32x4 wv = *(const f32x4*)(wT + e * 1024 + 256 * j + 4 * lane);
                s2 += y2[j][0] * wv.x; s2 += y2[j][1] * wv.y; s2 += y2[j][2] * wv.z; s2 += y2[j][3] * wv.w; }
            acc0[e] = s2.x; acc1[e] = s2.y; }
        router_finish(acc0, lane, my_e, bias, tok, hist, TOPE, TOPG, TOPR);
        if (has2) router_finish(acc1, lane, my_e, bias, tokb, hist, TOPE, TOPG, TOPR);
    }
    __syncthreads();
    if (cx.tid < 32) ((int*)(ws + WS_HIST))[cx.bid * 32 + cx.tid] = hist[cx.tid];
}
#endif
__device__ __forceinline__ void phase_scatter(const Ctx& cx, int n) {
    unsigned char* ws = AWS(cx); int* sm = (int*)(cx.lds + SCR_OFF);
    const int* HIST = (const int*)(ws + WS_HIST);
    if (cx.tid < 64) sm[cx.tid] = 0;
    __syncthreads();
    { const int e = cx.tid & 31, part = cx.tid >> 5; int cnt = 0, bs = 0;
      for (int bb = part; bb < cx.G; bb += 16) { const int hv = HIST[bb * 32 + e]; cnt += hv; if (bb < cx.bid) bs += hv; }
      atomicAdd(&sm[e], cnt); atomicAdd(&sm[32 + e], bs); }
    __syncthreads();
    if (cx.tid == 0) { int ps = 0; int* TE = (int*)(ws + WS_TILEE); int nt = 0;
        for (int e = 0; e < 32; ++e) { sm[64 + e] = ps; const int tl = (sm[e] + 255) >> 8; if (cx.bid == 0) for (int q = 0; q < tl; ++q) TE[1 + nt + q] = e; nt += tl; ps += tl << 8; }
        if (cx.bid == 0) TE[0] = nt; }
    __syncthreads();
    const int tpb = (n + cx.G - 1) / cx.G, t0 = cx.bid * tpb, t1 = (t0 + tpb < n) ? t0 + tpb : n;
    const int* TOPE = (const int*)(ws + WS_TOPE); const float* TOPG = (const float*)(ws + WS_TOPG); const int* TOPR = (const int*)(ws + WS_TOPR);
    int* POS = (int*)(ws + WS_POS); float* GATES = (float*)(ws + WS_GATES); const bf16* ACT = (const bf16*)(ws + WS_ACT); bf16* XS = (bf16*)(ws + WS_XS);
    typedef int i4s __attribute__((ext_vector_type(4)));
    u32x4 r0 = {0u, 0u, 0u, 0u}, rn = r0; i4s ce = {0, 0, 0, 0}, cr = ce, ne = ce, nr = ce; f32x4 cgt = {0.f, 0.f, 0.f, 0.f}, ngt = cgt;
#define SC_LOAD(R, E, RK, GT, T) do { R = *(const u32x4*)((const unsigned char*)ACT + (size_t)(T) * DM + cx.lane * 16); E = *(const i4s*)(TOPE + (size_t)(T) * 4); RK = *(const i4s*)(TOPR + (size_t)(T) * 4); GT = *(const f32x4*)(TOPG + (size_t)(T) * 4); } while (0)
    if (t0 + cx.wave < t1) SC_LOAD(r0, ce, cr, cgt, t0 + cx.wave);
    for (int tok = t0 + cx.wave; tok < t1; tok += 8) {
        const bool hn = tok + 8 < t1;
        if (hn) SC_LOAD(rn, ne, nr, ngt, tok + 8);
#pragma unroll
        for (int k = 0; k < 4; ++k) { const int e = ce[k]; const int dest = sm[64 + e] + sm[32 + e] + cr[k];
            *(u32x4*)((unsigned char*)XS + (size_t)dest * DM + cx.lane * 16) = r0;
            if (cx.lane == 0) { POS[tok * 4 + k] = dest; GATES[dest] = cgt[k]; } }
        if (hn) { r0 = rn; ce = ne; cr = nr; cgt = ngt; }
    }
#undef SC_LOAD
}
__device__ __forceinline__ void phase_combine(const Ctx& cx, int l, int n) {
    unsigned char* ws = AWS(cx); const bf16* X1 = (const bf16*)(ws + WS_X1); bf16* X0 = (bf16*)(ws + WS_X0); bf16* ACT = (bf16*)(ws + WS_ACT);
    const float* MOD = (const float*)(ws + WS_MOD) + (size_t)l * 3 * 6144; const unsigned char* YS = (const unsigned char*)(ws + WS_XS); const int* POS = (const int*)(ws + WS_POS);
    const bool lastl = (l == DEPTH - 1);
    typedef int i4 __attribute__((ext_vector_type(4)));
    int tok = cx.gw; if (tok >= n) return;
    unsigned cy[4][4], ny[4][4]; u32x2 cxr[4], nxr[4];
#define CB_LOAD(Y, XR, T, P) do { _Pragma("unroll") for (int k = 0; k < 4; ++k) { const unsigned char* yr = YS + (size_t)(P)[k] * DM; \
        _Pragma("unroll") for (int j = 0; j < 4; ++j) Y[k][j] = *(const unsigned*)(yr + 4 * cx.lane + 256 * j); } \
        _Pragma("unroll") for (int j = 0; j < 4; ++j) XR[j] = *(const u32x2*)(X1 + (size_t)(T) * DM + 4 * cx.lane + 256 * j); } while (0)
    i4 p0 = *(const i4*)(POS + (size_t)tok * 4);
    CB_LOAD(cy, cxr, tok, p0);
    i4 pn = p0; if (tok + cx.NGW < n) pn = *(const i4*)(POS + (size_t)(tok + cx.NGW) * 4);
    f32x4 cgate[4], cg1[4], csh[4], csc[4]; int cur_mr = -1;
    if (!lastl) {
#pragma unroll
        for (int j = 0; j < 4; ++j) cg1[j] = *(const f32x4*)(AIN(cx, I_N1G) + (l + 1) * 1024 + 4 * cx.lane + 256 * j); }
    for (; tok < n; tok += cx.NGW) {
        const bool hn = tok + cx.NGW < n;
        if (hn) CB_LOAD(ny, nxr, tok + cx.NGW, pn);
        i4 pn2 = pn; if (tok + 2 * cx.NGW < n) pn2 = *(const i4*)(POS + (size_t)(tok + 2 * cx.NGW) * 4);
        const int mr = mrow_of(tok);
        if (mr != cur_mr) { cur_mr = mr; const float* g2 = MOD + (size_t)mr * 6144 + 5 * 1024; const float* mn = (const float*)(ws + WS_MOD) + (size_t)(lastl ? l : l + 1) * 3 * 6144 + (size_t)mr * 6144;
#pragma unroll
            for (int j = 0; j < 4; ++j) { cgate[j] = *(const f32x4*)(g2 + 4 * cx.lane + 256 * j); csh[j] = *(const f32x4*)(mn + 4 * cx.lane + 256 * j); csc[j] = *(const f32x4*)(mn + 1024 + 4 * cx.lane + 256 * j); } }
        f32x4 x[4];
#pragma unroll
        for (int j = 0; j < 4; ++j) { f32x4 ys = (f32x4){0.f, 0.f, 0.f, 0.f};
#pragma unroll
            for (int k = 0; k < 4; ++k) { const unsigned w = cy[k][j]; const auto lo = __builtin_amdgcn_cvt_pk_f32_fp8(w, false), hi = __builtin_amdgcn_cvt_pk_f32_fp8(w, true);
                ys.x += lo[0]; ys.y += lo[1]; ys.z += hi[0]; ys.w += hi[1]; }
            const u32x2 xw = cxr[j]; const f32x4 xv = {__uint_as_float(xw.x << 16), __uint_as_float(xw.x & 0xffff0000u), __uint_as_float(xw.y << 16), __uint_as_float(xw.y & 0xffff0000u)};
            x[j] = xv + cgate[j] * (ys * 0.03125f); }
        if (lastl) {
#pragma unroll
            for (int j = 0; j < 4; ++j) *(f32x4*)(AOUT(cx) + (size_t)tok * DM + 4 * cx.lane + 256 * j) = x[j];
        } else {
            store_row_bf16(X0 + (size_t)tok * DM, x, cx.lane);
            f32x4 y[4];
            modulate_row_c(x, cg1, csh, csc, cx.lane, y);
            store_row_fp8((unsigned char*)ACT + (size_t)tok * DM, y, cx.lane);
        }
        if (hn) {
#pragma unroll
            for (int k = 0; k < 4; ++k)
#pragma unroll
                for (int j = 0; j < 4; ++j) cy[k][j] = ny[k][j];
#pragma unroll
            for (int j = 0; j < 4; ++j) cxr[j] = nxr[j]; }
        pn = pn2;
    }
#undef CB_LOAD
}
#ifndef SEAM_DBL
#define SEAM_DBL 0
#endif
#ifndef GQA_128
#define GQA_128 1
#endif
#ifndef GQA_PING
#define GQA_PING true
#endif
#ifndef ATT_V2
#define ATT_V2 1
#endif
#ifndef ATT_V2C
#define ATT_V2C ATT_V2
#endif
#ifndef ATT_DBG_DEAD
#define ATT_DBG_DEAD 0
#endif
#ifndef ATT_V2CE
#define ATT_V2CE ATT_V2C
#endif
#ifndef ATT_V2CO
#define ATT_V2CO ATT_V2C
#endif
constexpr float C64 = 0.125f * LOG2E, THR64 = 8.0f / 0.125f;
constexpr float SC192 = 0.07216878364870322f, C192 = SC192 * LOG2E, THR192 = 8.0f / SC192;

__device__ __forceinline__ float max_abs_gain(const float* g, int n, int lane) {
    asm volatile("" : "+v"(lane));
    float m = 0.f; for (int i = lane; i < n; i += 64) m = fmaxf(m, fabsf(g[i]));
#pragma unroll
    for (int o = 1; o < 64; o <<= 1) m = fmaxf(m, shx(m, o, lane));
    return m;
}
__device__ __forceinline__ void phase_attn_even(const Ctx& cx, int li, bool need_ctx) {
    unsigned char* ws = AWS(cx); bf16* OCAT = (bf16*)(ws + WS_OCAT);
    const bf16* QA = (const bf16*)(ws + WS_QA); const bf16* KA = (const bf16*)(ws + WS_KA); const bf16* VA = (const bf16*)(ws + WS_VA);
    const bf16* QB = (const bf16*)(ws + WS_QB); const bf16* KB = (const bf16*)(ws + WS_KB); const bf16* VB = (const bf16*)(ws + WS_VB);
    AttnNA na0; na0.krow0 = 0; na0.rq = 0; na0.r0 = 0; na0.cq = 0; na0.c0 = 0; na0.rpb = nullptr;
    const float MCa0 = 64.f * max_abs_gain(AIN(cx, I_AQN) + li * 64, 64, cx.lane) * max_abs_gain(AIN(cx, I_AKN) + li * 64, 64, cx.lane) * C64;
    for (int u = cx.bid; u < 1024; u += cx.G) {
        const int qb = u & 63, h = (u >> 6) & 7, b = u >> 9;
        #if ATT_V2
#if GQA_128
        attn_gqa128((const unsigned char*)QA + ((size_t)(b * 8 + h) * SP + qb * 256) * 64, (const unsigned char*)KA + (size_t)(b * 2 + (h >> 2)) * SP * 64, (const unsigned char*)(ws + WS_VTA) + (size_t)((b * 2 + (h >> 2)) * 64) * SP,
                    0, SP / 64, OCAT + ((size_t)b * SEQ + qb * 256) * DM + h * 64, cx.lds, MCa0, cx.wave);
#else
        attn_dense2<64, 64, 2, true, 4, GQA_PING, true>(QA + ((size_t)(b * 8 + h) * SP + qb * 256) * 64, KA + (size_t)(b * 2 + (h >> 2)) * SP * 64, VA + (size_t)(b * 2 + (h >> 2)) * SP * 64,
                                     0, SP / 64, OCAT + ((size_t)b * SEQ + qb * 256) * DM + h * 64, cx.lds, C64, MCa0, cx.wave);
#endif
#else
        attn_unit<64, 64, false, 2>(QA + ((size_t)(b * 8 + h) * SP + qb * 256) * 64, KA + (size_t)(b * 2 + (h >> 2)) * SP * 64, VA + (size_t)(b * 2 + (h >> 2)) * SP * 64,
                                 SP / 64, 0, 0, SP / 64, OCAT + ((size_t)b * SEQ + qb * 256) * DM + h * 64, cx.lds, C64, THR64, na0, cx.wave);
#endif
    }
    float* rpb_l = (float*)(cx.lds + SCR_OFF);
    const int lane_n = lane_id_v(), tid_n = cx.wave * 64 + lane_n;
#ifndef REP_NA
#define REP_NA 1
#endif
    for (int rna_ = 0; rna_ < REP_NA; ++rna_)
    for (int u = cx.bid; u < 1024; u += cx.G) {
        const int qb = u & 63, h = (u >> 6) & 7, b = u >> 9;
        if (tid_n < 465) rpb_l[tid_n] = AIN(cx, I_RPB)[((size_t)li * 8 + h) * 465 + tid_n] * 8.0f;
        const int R = qb * 4;
        int k0 = R - 4; k0 = k0 < 0 ? 0 : (k0 > 248 ? 248 : k0);
        int kl = R + 3 - 4; kl = kl < 0 ? 0 : (kl > 248 ? 248 : kl); kl += 7;
        AttnNA na; na.krow0 = k0; na.rq = R + (cx.wave >> 1);
        { int r0 = na.rq - 4; na.r0 = r0 < 0 ? 0 : (r0 > 248 ? 248 : r0); }
        na.cq = (cx.wave & 1) * 32 + (lane_n & 31);
        { int c0 = na.cq - 8; na.c0 = c0 < 0 ? 0 : (c0 > 48 ? 48 : c0); }
        na.rpb = rpb_l;
        const int n1 = kl - k0 + 1;
        attn_unit<64, 64, true, 2>(QB + ((size_t)(b * 8 + h) * SP + qb * 256) * 64, KB + (size_t)(b * 8 + h) * SP * 64, VB + (size_t)(b * 8 + h) * SP * 64,
                                n1, k0 * 64, SEQ, n1 + 4, OCAT + ((size_t)b * SEQ + qb * 256) * DM + 512 + h * 64, cx.lds, C64, THR64, na, cx.wave);
    }
    if (need_ctx) for (int u = cx.bid; u < 32; u += cx.G) {
        const int part = u >> 4, h = u & 7, b = (u >> 3) & 1;
        const int lane_c = lane_id_v();
        const float MCa = 64.f * max_abs_gain(AIN(cx, I_AQN) + li * 64, 64, lane_c) * max_abs_gain(AIN(cx, I_AKN) + li * 64, 64, lane_c) * C64;
        const float MCb = 64.f * max_abs_gain(AIN(cx, I_BQN) + li * 64, 64, lane_c) * max_abs_gain(AIN(cx, I_BKN) + li * 64, 64, lane_c) * C64;
#if ATT_DBG_DEAD
        if (cx.G == 12345) {
        if (part == 0) attn_gqa128((const unsigned char*)QA + ((size_t)(b * 8 + h) * SP + SEQ) * 64, (const unsigned char*)KA + (size_t)(b * 2 + (h >> 2)) * SP * 64, (const unsigned char*)(ws + WS_VTA) + (size_t)((b * 2 + (h >> 2)) * 64) * SP,
                                   SEQ, 4, OCAT + ((size_t)NL + b * CTXL) * DM + h * 64, cx.lds, MCa, cx.wave);
        else attn_dense2<64, 64, 2, true>(QB + ((size_t)(b * 8 + h) * SP + SEQ) * 64, KB + (size_t)(b * 8 + h) * SP * 64, VB + (size_t)(b * 8 + h) * SP * 64,
                                          SEQ, 4, OCAT + ((size_t)NL + b * CTXL) * DM + 512 + h * 64, cx.lds, C64, MCb, cx.wave);
        }
#endif
#if ATT_V2CE
        if (part == 0) attn_gqa128((const unsigned char*)QA + ((size_t)(b * 8 + h) * SP + SEQ) * 64, (const unsigned char*)KA + (size_t)(b * 2 + (h >> 2)) * SP * 64, (const unsigned char*)(ws + WS_VTA) + (size_t)((b * 2 + (h >> 2)) * 64) * SP,
                                   SEQ, 4, OCAT + ((size_t)NL + b * CTXL) * DM + h * 64, cx.lds, MCa, cx.wave);
        else attn_dense2<64, 64, 2, true>(QB + ((size_t)(b * 8 + h) * SP + SEQ) * 64, KB + (size_t)(b * 8 + h) * SP * 64, VB + (size_t)(b * 8 + h) * SP * 64,
                                          SEQ, 4, OCAT + ((size_t)NL + b * CTXL) * DM + 512 + h * 64, cx.lds, C64, MCb, cx.wave);
#else
        if (part == 0) attn_unit<64, 64, false, 2>(QA + ((size_t)(b * 8 + h) * SP + SEQ) * 64, KA + (size_t)(b * 2 + (h >> 2)) * SP * 64, VA + (size_t)(b * 2 + (h >> 2)) * SP * 64,
                                                4, SEQ, 0, 4, OCAT + ((size_t)NL + b * CTXL) * DM + h * 64, cx.lds, C64, THR64, na0, cx.wave);
        else attn_unit<64, 64, false, 2>(QB + ((size_t)(b * 8 + h) * SP + SEQ) * 64, KB + (size_t)(b * 8 + h) * SP * 64, VB + (size_t)(b * 8 + h) * SP * 64,
                                      4, SEQ, 0, 4, OCAT + ((size_t)NL + b * CTXL) * DM + 512 + h * 64, cx.lds, C64, THR64, na0, cx.wave);
#endif
    }
}
#ifndef MLA_128
#define MLA_128 0
#endif
#if MLA_128
#define MLA_FN attn_mla8x
#else
#define MLA_FN attn_mla8
#endif
__device__ __forceinline__ void phase_attn_mla(const Ctx& cx, int li, bool need_ctx) {
    unsigned char* ws = AWS(cx); bf16* OCAT = (bf16*)(ws + WS_OCAT);
    const bf16* QM = (const bf16*)(ws + WS_QM); const bf16* KM = (const bf16*)(ws + WS_KM); const bf16* VM = (const bf16*)(ws + WS_VM);
    const float MCm = 192.f * max_abs_gain(AIN(cx, I_MQN) + li * 192, 192, cx.lane) * max_abs_gain(AIN(cx, I_MKN) + li * 192, 192, cx.lane) * C192;
    for (int u = cx.bid; u < 512; u += cx.G) {
        const int qb = u & 63, h = (u >> 6) & 3, b = u >> 8;
#if ATT_V2
        MLA_FN((const unsigned char*)QM + ((size_t)(b * 4 + h) * SP + qb * 256) * 192, (const unsigned char*)KM + (size_t)(b * 4 + h) * SP * 192, (const unsigned char*)(ws + WS_VTM) + (size_t)((b * 4 + h) * 128) * SP,
                  0, SP / 64, OCAT + ((size_t)b * SEQ + qb * 256) * DM + 512 + h * 128, cx.lds, MCm, cx.wave);
#else
        { AttnNA na0; na0.krow0 = 0; na0.rq = 0; na0.r0 = 0; na0.cq = 0; na0.c0 = 0; na0.rpb = nullptr;
          attn_unit<192, 128, false, 1>(QM + ((size_t)(b * 4 + h) * SP + qb * 256) * 192, KM + (size_t)(b * 4 + h) * SP * 192, VM + (size_t)(b * 4 + h) * SP * 128,
                                   SP / 64, 0, 0, SP / 64, OCAT + ((size_t)b * SEQ + qb * 256) * DM + 512 + h * 128, cx.lds, C192, THR192, na0, cx.wave); }
#endif
    }
    if (need_ctx) for (int u = cx.bid; u < 8; u += cx.G) {
        const int h = u & 3, b = u >> 2;
#if ATT_V2CO
        MLA_FN((const unsigned char*)QM + ((size_t)(b * 4 + h) * SP + SEQ) * 192, (const unsigned char*)KM + (size_t)(b * 4 + h) * SP * 192, (const unsigned char*)(ws + WS_VTM) + (size_t)((b * 4 + h) * 128) * SP,
                  SEQ, 4, OCAT + ((size_t)NL + b * CTXL) * DM + 512 + h * 128, cx.lds, MCm, cx.wave);
#else
        { AttnNA na0; na0.krow0 = 0; na0.rq = 0; na0.r0 = 0; na0.cq = 0; na0.c0 = 0; na0.rpb = nullptr;
          attn_unit<192, 128, false, 1>(QM + ((size_t)(b * 4 + h) * SP + SEQ) * 192, KM + (size_t)(b * 4 + h) * SP * 192, VM + (size_t)(b * 4 + h) * SP * 128,
                                   4, SEQ, 0, 4, OCAT + ((size_t)NL + b * CTXL) * DM + 512 + h * 128, cx.lds, C192, THR192, na0, cx.wave); }
#endif
    }
}

constexpr int NSLOT = 11, NPHASE = 2 + DEPTH * NSLOT;
__host__ __device__ constexpr bool phase_nonempty(int p) { return p < 2 ? true : !((((p - 2) / NSLOT) & 1) == 0 && (((p - 2) % NSLOT) == 2 || ((p - 2) % NSLOT) == 3)); }

__global__ void __launch_bounds__(512, 2) mk_fwd(Args a_k) {
    extern __shared__ __attribute__((aligned(16))) unsigned char lds_raw[];
    Ctx cx; cx.wave = __builtin_amdgcn_readfirstlane(threadIdx.x >> 6); cx.lane = lane_id_v(); cx.tid = cx.wave * 64 + cx.lane; cx.G = gridDim.x; cx.bid = blockIdx.x;
    cx.gw = cx.bid * 8 + cx.wave; cx.NGW = cx.G * 8; cx.lds = (char*)lds_raw;
    LAS unsigned char* ldsl = (LAS unsigned char*)lds_raw;
    volatile LAS unsigned* MISC = (volatile LAS unsigned*)(ldsl + MISC_OFF);
    if (cx.tid < 32) MISC[cx.tid] = 0u;
    if (cx.tid == 0) {
        volatile unsigned long long* tb = (volatile unsigned long long*)(cx.lds + ARG_OFF);
#pragma unroll
        for (int i = 0; i < 31; ++i) tb[i] = (unsigned long long)a_k.in[i];
        tb[31] = (unsigned long long)a_k.out; tb[32] = (unsigned long long)a_k.ws;
    }
    __syncthreads();
    const int lo = a_k.ph_lo, hi = a_k.ph_hi;
    if (hi - lo > 1) (void)xcd_barrier_post((unsigned*)(a_k.ws + WS_CTL) + CW_BAR, MISC + 8, cx.wave);
#ifndef SITE_MASK
#define SITE_MASK 0xFFFFFFFFu
#endif
#define SITE(n) ((SITE_MASK >> (n)) & 1u)
#ifndef REP_MASK
#define REP_MASK 0u
#endif
#define REP2(n) ((REP_MASK >> (n)) & 1u)
#define IN(k) (lo <= (k) && (k) < hi)
#define SITE_CTX() Ctx cs = cx; cs.lane = lane_id_v(); asm volatile("" : "+v"(cs.lane), "+s"(cs.wave), "+s"(cs.bid)); cs.tid = cs.wave * 64 + cs.lane; cs.gw = cs.bid * 8 + cs.wave; cs.atb = cx.lds + ARG_OFF; asm volatile("" : "+s"(cs.atb))
#define SEAM(k) do { if ((k) + 1 < hi) { SITE_CTX(); XcdBarrier b2_; b2_.bar = (unsigned*)(AWS(cs) + WS_CTL) + CW_BAR; b2_.x = xb_xcc_id(); b2_.st = MISC + 8; b2_.wave = cs.wave; xcd_barrier(b2_); if (SEAM_DBL) xcd_barrier(b2_); } } while (0)
    for (int rep_ = 0; rep_ < ((SITE(0) && IN(0)) ? 1 + (int)REP2(0) : 0); ++rep_) { { SITE_CTX(); phase_prologue(cs); }; SEAM(0); }
    for (int rep_ = 0; rep_ < ((SITE(1) && IN(1)) ? 1 + (int)REP2(1) : 0); ++rep_) { { SITE_CTX(); phase_init(cs); }; SEAM(1); }
    for (int l = 0; l < DEPTH; ++l) {
        const int pb = 2 + l * NSLOT, li = l >> 1; const bool odd = (l & 1) != 0, need_ctx = l < DEPTH - 1;
        if (pb >= hi) break;
        const int nrows = need_ctx ? NTOK : NL;
        for (int rep_ = 0; rep_ < ((SITE(2) && IN(pb + 0)) ? 1 + (int)REP2(2) : 0); ++rep_) {
            SITE_CTX();
            pg8::Gemm g{(const bf16*)(AWS(cs) + WS_ACT), (const bf16*)(odd ? AWS(cs) + WS_WINO + (size_t)li * OINP * 1024 : AWS(cs) + WS_WINE + (size_t)li * EIN * 1024), 512, 0};
            pg8::StaticOrder S; S.init(NTOK, odd ? OINP : EIN, cs.G, cs.bid);
            pg8::EpiBf16 E{(bf16*)(AWS(cs) + WS_RAW), RAWLD, 0.03125f};
            pg8::gemm_phase_f8(ldsl, g, S, E, cs.wave);
            SEAM(pb + 0);
        }
        if (!odd) {
            for (int rep_ = 0; rep_ < ((SITE(3) && IN(pb + 1)) ? 1 + (int)REP2(3) : 0); ++rep_) { { SITE_CTX(); phase_postproj_even(cs, li); } { SITE_CTX(); __syncthreads(); phase_vtrans<64>(cs, (const bf16*)(AWS(cs) + WS_RAW), RAWLD, 640, 64, 2, (unsigned char*)(AWS(cs) + WS_VTA)); }; SEAM(pb + 1); }
            for (int rep_ = 0; rep_ < ((SITE(4) && IN(pb + 4)) ? 1 + (int)REP2(4) : 0); ++rep_) { { SITE_CTX(); phase_attn_even(cs, li, need_ctx); }; SEAM(pb + 4); }
        } else {
            for (int rep_ = 0; rep_ < ((SITE(5) && IN(pb + 1)) ? 1 + (int)REP2(5) : 0); ++rep_) { { SITE_CTX(); phase_postproj_odd(cs, li); }; SEAM(pb + 1); }
            for (int rep_ = 0; rep_ < ((SITE(6) && IN(pb + 2)) ? 1 + (int)REP2(6) : 0); ++rep_) {
                SITE_CTX();
                pg8::Gemm g{(const bf16*)(AWS(cs) + WS_CQN), (const bf16*)(AWS(cs) + WS_WUQ) + (size_t)li * 768 * 256, 256, 0};
                pg8::StaticOrder S; S.init(NTOK, 768, cx.G, cx.bid); pg8::EpiBf16 E{(bf16*)(AWS(cs) + WS_QMR), 768, 1.0f};
                pg8::gemm_phase(ldsl, g, S, E, cs.wave);
            }
            for (int rep_ = 0; rep_ < ((SITE(15) && IN(pb + 2)) ? 1 + (int)REP2(15) : 0); ++rep_) {
                SITE_CTX();
                pg8::Gemm g{(const bf16*)(AWS(cs) + WS_CKVN), (const bf16*)(AWS(cs) + WS_WUKV) + (size_t)li * 1024 * 256, 256, 0};
                pg8::StaticOrder S; S.init(NTOK, 1024, cx.G, cx.bid); pg8::EpiBf16 E{(bf16*)(AWS(cs) + WS_KVR), 1024, 1.0f};
                pg8::gemm_phase(ldsl, g, S, E, cs.wave);
            }
            for (int rep_ = 0; rep_ < ((SITE(16) && IN(pb + 2)) ? 1 + (int)REP2(16) : 0); ++rep_) { __syncthreads(); { SITE_CTX(); phase_ret_kv(cs, li); }; SEAM(pb + 2); }
            for (int rep_ = 0; rep_ < ((SITE(7) && IN(pb + 3)) ? 1 + (int)REP2(7) : 0); ++rep_) { { SITE_CTX(); phase_mla_prep(cs, li); } { SITE_CTX(); __syncthreads(); phase_vtrans<128>(cs, (const bf16*)(AWS(cs) + WS_KVR), 1024, 128, 256, 4, (unsigned char*)(AWS(cs) + WS_VTM)); }; { SITE_CTX(); phase_ret_scan(cs, li); }; SEAM(pb + 3); }
            for (int rep_ = 0; rep_ < ((SITE(8) && IN(pb + 4)) ? 1 + (int)REP2(8) : 0); ++rep_) { { SITE_CTX(); phase_attn_mla(cs, li, need_ctx); }; }
            for (int rep_ = 0; rep_ < ((SITE(17) && IN(pb + 4)) ? 1 + (int)REP2(17) : 0); ++rep_) { __syncthreads(); { SITE_CTX(); phase_ret_out(cs, li, need_ctx ? NCHUNK : 128); }; SEAM(pb + 4); }
        }
        for (int rep_ = 0; rep_ < ((SITE(9) && IN(pb + 5)) ? 1 + (int)REP2(9) : 0); ++rep_) {
            SITE_CTX();
            pg8::Gemm g{(const bf16*)(AWS(cs) + WS_OCAT), odd ? (const bf16*)(AWS(cs) + WS_WOUTO) + (size_t)li * 1024 * 1024 : (const bf16*)(AWS(cs) + WS_WOUTE) + (size_t)li * 1024 * 1024, 1024, 0};
            if (need_ctx) { SITE_CTX(); phase_wout_ctx(cs, odd ? (const bf16*)(AWS(cs) + WS_WOUTO) + (size_t)li * 1024 * 1024 : (const bf16*)(AWS(cs) + WS_WOUTE) + (size_t)li * 1024 * 1024, (const float*)(AWS(cs) + WS_MOD) + (size_t)l * 3 * 6144 + 2 * 1024); }
            pg8::StaticOrder S; S.init(NL, 1024, cx.G, cx.bid);
            pg8::EpiRes E{(const bf16*)(AWS(cs) + WS_X0), (bf16*)(AWS(cs) + WS_X1), (const float*)(AWS(cs) + WS_MOD) + (size_t)l * 3 * 6144 + 2 * 1024};
            pg8::gemm_phase(ldsl, g, S, E, cs.wave);
            SEAM(pb + 5);
        }
        for (int rep_ = 0; rep_ < ((SITE(10) && IN(pb + 6)) ? 1 + (int)REP2(10) : 0); ++rep_) { { SITE_CTX(); phase_router(cs, l, nrows); }; SEAM(pb + 6); }
        for (int rep_ = 0; rep_ < ((SITE(11) && IN(pb + 7)) ? 1 + (int)REP2(11) : 0); ++rep_) { { SITE_CTX(); phase_scatter(cs, nrows); }; SEAM(pb + 7); }
        for (int rep_ = 0; rep_ < ((SITE(12) && IN(pb + 8)) ? 1 + (int)REP2(12) : 0); ++rep_) {
            SITE_CTX();
            pg8::Gemm g{(const bf16*)(AWS(cs) + WS_XS), (const bf16*)(AWS(cs) + WS_W1 + (size_t)l * 32 * 2048 * 1024), 512, (size_t)2048 * 1024};
            pg8::MoeOrder S; S.init((const int*)(AWS(cs) + WS_TILEE), 8, cx.G, cx.bid, (LAS int*)(ldsl + SCR_OFF + 4096), cs.tid);
            pg8::EpiSwiGLU8 E{(unsigned char*)(AWS(cs) + WS_ACTS), AIN(cs, I_B1) + (size_t)l * 32 * 2048};
#ifdef REP_NOEPI
            if (rep_ == 1) pg8::gemm_phase_f8(ldsl, g, S, pg8::EpiKeep{}, cs.wave); else
#endif
            pg8::gemm_phase_f8(ldsl, g, S, E, cs.wave);
            SEAM(pb + 8);
        }
        for (int rep_ = 0; rep_ < ((SITE(13) && IN(pb + 9)) ? 1 + (int)REP2(13) : 0); ++rep_) {
            SITE_CTX();
            pg8::Gemm g{(const bf16*)(AWS(cs) + WS_ACTS), (const bf16*)(AWS(cs) + WS_W2 + (size_t)l * 32 * 1024 * 1024), 512, (size_t)1024 * 1024};
            pg8::MoeOrder S; S.init((const int*)(AWS(cs) + WS_TILEE), 4, cx.G, cx.bid, (LAS int*)(ldsl + SCR_OFF + 4096), cs.tid);
            pg8::EpiMoe2F8 E{(unsigned char*)(AWS(cs) + WS_XS), AIN(cs, I_B2) + (size_t)l * 32 * 1024, (const float*)(AWS(cs) + WS_GATES)};
#ifdef REP_NOEPI
            if (rep_ == 1) pg8::gemm_phase_f8(ldsl, g, S, pg8::EpiKeep{}, cs.wave); else
#endif
            pg8::gemm_phase_f8(ldsl, g, S, E, cs.wave);
            SEAM(pb + 9);
        }
        for (int rep_ = 0; rep_ < ((SITE(14) && IN(pb + 10)) ? 1 + (int)REP2(14) : 0); ++rep_) { { SITE_CTX(); phase_combine(cs, l, nrows); }; SEAM(pb + 10); }
    }
#undef IN
#undef SEAM
}

extern "C" void kernel_launch(void* const* d_in, const int* in_sizes, int n_in, void* d_out, int out_size, void* d_ws, size_t ws_size, hipStream_t stream) {
    static int grid = 0;
    if (grid == 0) {
        if (n_in != 31 || out_size != NL * DM || ws_size < WS_END) { fprintf(stderr, "kernel_launch: unexpected shapes (n_in %d out %d ws %zu need %zu)\n", n_in, out_size, ws_size, (size_t)WS_END); grid = -1; return; }
        int dev = 0, cus = 0, per_cu = 0;
        if (hipGetDevice(&dev) != hipSuccess || hipDeviceGetAttribute(&cus, hipDeviceAttributeMultiprocessorCount, dev) != hipSuccess) { grid = -1; return; }
        if (hipFuncSetAttribute((const void*)mk_fwd, hipFuncAttributeMaxDynamicSharedMemorySize, LDS_BYTES) != hipSuccess) { fprintf(stderr, "kernel_launch: hipFuncSetAttribute failed\n"); grid = -1; return; }
        if (hipOccupancyMaxActiveBlocksPerMultiprocessor(&per_cu, (const void*)mk_fwd, 512, LDS_BYTES) != hipSuccess || per_cu < 1) { fprintf(stderr, "kernel_launch: occupancy query says %d\n", per_cu); (void)hipGetLastError(); grid = -1; return; }
        grid = cus;
    }
    if (grid < 0) return;
    (void)hipMemsetAsync((char*)d_ws + WS_CTL, 0, CTL_BYTES, stream);
    Args a{};
    for (int i = 0; i < 31; ++i) a.in[i] = (const float*)d_in[i];
    a.out = (float*)d_out; a.ws = (unsigned char*)d_ws;
    const int stop = MK_STOP < NPHASE ? MK_STOP : NPHASE;
#if MK_MULTI
    for (int p = 0; p < stop; ++p) { if (!phase_nonempty(p)) continue; a.ph_lo = p; a.ph_hi = p + 1; hipLaunchKernelGGL(mk_fwd, dim3(grid), dim3(512), LDS_BYTES, stream, a); }
#else
    a.ph_lo = 0; a.ph_hi = stop; hipLaunchKernelGGL(mk_fwd, dim3(grid), dim3(512), LDS_BYTES, stream, a);
#endif
    const hipError_t le = hipPeekAtLastError();
    if (le != hipSuccess) fprintf(stderr, "kernel_launch: launch failed: %s\n", hipGetErrorName(le));
}
```

```cpp
#include <hip/hip_runtime.h>
#include <cstdio>
#include <cstdint>

#ifndef MK_MULTI
#define MK_MULTI 0
#endif
#ifndef MK_STOP
#define MK_STOP 9999
#endif

#define LAS __attribute__((address_space(3)))
typedef unsigned short bf16;
typedef short bf16x8 __attribute__((ext_vector_type(8)));
typedef short s16x4 __attribute__((ext_vector_type(4)));
typedef float f32x4 __attribute__((ext_vector_type(4)));
typedef float f32x2 __attribute__((ext_vector_type(2)));
typedef float f32x16 __attribute__((ext_vector_type(16)));
typedef unsigned u32x4 __attribute__((ext_vector_type(4)));
typedef unsigned u32x2 __attribute__((ext_vector_type(2)));
typedef int i32x4 __attribute__((ext_vector_type(4)));
typedef int i32x8 __attribute__((ext_vector_type(8)));

constexpr int DM = 1024, NBATCH = 2, SEQ = 16384, CTXL = 256, SP = SEQ + CTXL, NL = NBATCH * SEQ, NCX = NBATCH * CTXL, NTOK = NL + NCX, DEPTH = 4;
constexpr int EIN = 2304, OIN = 2496, OINP = 2560, RAWLD = 2560;
constexpr int NEXP = 32, DFF = 1024, CAP = 141312;
constexpr float EPS = 1e-6f, GN_EPS = 1e-5f, L2T = 13.287712379549449f  , LOG2E = 1.4426950408889634f;
constexpr int NCHUNK = 130;

constexpr size_t al256(size_t x) { return (x + 255) & ~(size_t)255; }
constexpr size_t WS_CTL = 0, CTL_BYTES = 1u << 20;
constexpr size_t WS_MOD = WS_CTL + CTL_BYTES;
constexpr size_t WS_WINE = al256(WS_MOD + (size_t)4 * 3 * 6144 * 4);
constexpr size_t WS_WOUTE = WS_WINE + (size_t)2 * EIN * DM * 2;
constexpr size_t WS_WINO = WS_WOUTE + (size_t)2 * DM * DM * 2;
constexpr size_t WS_WOUTO = WS_WINO + (size_t)2 * OINP * DM * 2;
constexpr size_t WS_WUQ = WS_WOUTO + (size_t)2 * DM * DM * 2;
constexpr size_t WS_WUKV = WS_WUQ + (size_t)2 * 768 * 256 * 2;
constexpr size_t WS_W1 = WS_WUKV + (size_t)2 * 1024 * 256 * 2;
constexpr size_t WS_W2 = WS_W1 + (size_t)4 * 32 * 2048 * 1024 * 2;
constexpr size_t WS_X0 = WS_W2 + (size_t)4 * 32 * 1024 * 1024 * 2;
constexpr size_t WS_X1 = WS_X0 + (size_t)NTOK * DM * 4;
constexpr size_t WS_ACT = WS_X1 + (size_t)NTOK * DM * 4;
constexpr size_t WS_RAW = WS_ACT + (size_t)NTOK * DM * 2;
constexpr size_t WS_OCAT = WS_RAW + (size_t)NTOK * RAWLD * 2;
constexpr size_t SZ_H8 = (size_t)NBATCH * 8 * SP * 64 * 2, SZ_H2 = (size_t)NBATCH * 2 * SP * 64 * 2;
constexpr size_t WS_QA = WS_OCAT + (size_t)NTOK * DM * 2, WS_KA = WS_QA + SZ_H8, WS_VA = WS_KA + SZ_H2, WS_QB = WS_VA + SZ_H2, WS_KB = WS_QB + SZ_H8, WS_VB = WS_KB + SZ_H8;
constexpr size_t SZ_R = (size_t)NBATCH * 4 * SP * 128 * 2, SZ_M192 = (size_t)NBATCH * 4 * SP * 192 * 2;
constexpr size_t WS_RQ = WS_VB + SZ_H8, WS_RK = WS_RQ + SZ_R, WS_RV = WS_RK + SZ_R;
constexpr size_t WS_CQN = WS_RV + SZ_R;
constexpr size_t WS_CKVN = WS_CQN + (size_t)NTOK * 256 * 2;
constexpr size_t WS_QMR = WS_CKVN + (size_t)NTOK * 256 * 2;
constexpr size_t WS_KVR = WS_QMR + (size_t)NTOK * 768 * 2;
constexpr size_t WS_QM = WS_KVR + (size_t)NTOK * 1024 * 2, WS_KM = WS_QM + SZ_M192, WS_VM = WS_KM + SZ_M192;
constexpr size_t WS_KVP = WS_VM + SZ_R;
constexpr size_t WS_STP = WS_KVP + (size_t)2 * 8 * NCHUNK * 16384 * 4;
constexpr size_t WS_TOPE = WS_STP + (size_t)2 * 8 * NCHUNK * 16384 * 2;
constexpr size_t WS_TOPG = WS_TOPE + (size_t)NTOK * 4 * 4;
constexpr size_t WS_TOPR = WS_TOPG + (size_t)NTOK * 4 * 4;
constexpr size_t WS_POS = WS_TOPR + (size_t)NTOK * 4 * 4;
constexpr size_t WS_HIST = WS_POS + (size_t)NTOK * 4 * 4;
constexpr size_t WS_TILEE = WS_HIST + (size_t)1024 * 32 * 4;
constexpr size_t WS_GATES = WS_TILEE + 4096 * 4;
constexpr size_t WS_XS = al256(WS_GATES + (size_t)CAP * 4);
constexpr size_t WS_ACTS = WS_XS + (size_t)CAP * DM * 2;
constexpr size_t WS_CHK = WS_ACTS + (size_t)CAP * DM * 2;
constexpr size_t WS_VTA = WS_CHK + 65536;
constexpr size_t WS_VTM = WS_VTA + (size_t)NBATCH * 2 * 64 * SP;
constexpr size_t WS_RB2 = al256(WS_VTM + (size_t)NBATCH * 4 * 128 * SP);
constexpr size_t WS_LG = WS_RB2 + 4096;
constexpr size_t WS_RW = al256(WS_LG + (size_t)NTOK * 32 * 4);
constexpr size_t RW_IMG = 132096;
constexpr size_t WS_END = WS_RW + (size_t)12 * RW_IMG;

constexpr int CW_BAR = 4096;

constexpr int RING_BYTES = 131072, SCR_OFF = 131072, SCR_BYTES = 8192, MISC_OFF = SCR_OFF + SCR_BYTES, ARG_OFF = MISC_OFF + 4096, LDS_BYTES = 147456;

#define LDS_WAIT() asm volatile("s_waitcnt lgkmcnt(0)" ::: "memory")
#define VM_WAIT() asm volatile("s_waitcnt vmcnt(0)" ::: "memory")
#define SBAR() __builtin_amdgcn_sched_barrier(0)
__device__ __forceinline__ float bf2f(unsigned b) { return __uint_as_float(b << 16); }
__device__ __forceinline__ unsigned f2bf(float f) { unsigned u = __float_as_uint(f); return (u + 0x7fffu + ((u >> 16) & 1u)) >> 16; }
typedef __bf16 bf16v2_t __attribute__((ext_vector_type(2)));
__device__ __forceinline__ unsigned pk2(float lo, float hi) { const f32x2 v = {lo, hi}; const bf16v2_t r = __builtin_convertvector(v, bf16v2_t); return __builtin_bit_cast(unsigned, r); }
__device__ __forceinline__ void unpack8(const u32x4 w, float (&v)[8]) {
    v[0] = __uint_as_float(w.x << 16); v[1] = __uint_as_float(w.x & 0xffff0000u); v[2] = __uint_as_float(w.y << 16); v[3] = __uint_as_float(w.y & 0xffff0000u);
    v[4] = __uint_as_float(w.z << 16); v[5] = __uint_as_float(w.z & 0xffff0000u); v[6] = __uint_as_float(w.w << 16); v[7] = __uint_as_float(w.w & 0xffff0000u); }
__device__ __forceinline__ u32x4 pack8(const float (&v)[8]) { u32x4 w; w.x = pk2(v[0], v[1]); w.y = pk2(v[2], v[3]); w.z = pk2(v[4], v[5]); w.w = pk2(v[6], v[7]); return w; }
__device__ __forceinline__ float shx(float v, int o, int lane) { return __int_as_float(__builtin_amdgcn_ds_bpermute((lane ^ o) << 2, __float_as_int(v))); }
__device__ __forceinline__ int shxi(int v, int o, int lane) { return __builtin_amdgcn_ds_bpermute((lane ^ o) << 2, v); }
template <int CTRL> __device__ __forceinline__ float dppf(float x) { return __builtin_bit_cast(float, __builtin_amdgcn_mov_dpp(__builtin_bit_cast(int, x), CTRL, 0xf, 0xf, true)); }
__device__ __forceinline__ float sum8(float v) { v += dppf<0xB1>(v); v += dppf<0x4E>(v); v += dppf<0x141>(v); return v; }
__device__ __forceinline__ float sum16(float v) { v = sum8(v); v += dppf<0x140>(v); return v; }
__device__ __forceinline__ float sum32(float v) { v = sum16(v); auto r = __builtin_amdgcn_permlane16_swap(__float_as_uint(v), __float_as_uint(v), false, false); return __uint_as_float(r[0]) + __uint_as_float(r[1]); }
__device__ __forceinline__ float wave_sum(float v, int lane) { v = sum32(v); auto r = __builtin_amdgcn_permlane32_swap(__float_as_uint(v), __float_as_uint(v), false, false); return __uint_as_float(r[0]) + __uint_as_float(r[1]); }
__device__ __forceinline__ int crow(int r, int hi) { return (r & 3) + 8 * (r >> 2) + 4 * hi; }
__device__ __forceinline__ int lane_id_v() { int l; asm volatile("v_mbcnt_lo_u32_b32 %0, -1, 0\n\tv_mbcnt_hi_u32_b32 %0, -1, %0" : "=v"(l)); return l; }

#define XB_TMO      128
#define XB_XCNT(j)  (256  + 64 * (j))
#define XB_XSUB(j)  (1280 + 64 * (j))
#define XB_XGEN(j)  (2304 + 64 * (j))
#define XB_TOP      3328
#define XB_TOPGEN   3392
#define XCD_BAR_WORDS 3456
#define XB_SPIN_CAP (1u << 22)
__device__ __forceinline__ unsigned xb_ld(unsigned* p)              { return __hip_atomic_load(p, __ATOMIC_RELAXED, __HIP_MEMORY_SCOPE_AGENT); }
__device__ __forceinline__ unsigned xb_add(unsigned* p, unsigned v) { return __hip_atomic_fetch_add(p, v, __ATOMIC_RELAXED, __HIP_MEMORY_SCOPE_AGENT); }
__device__ __forceinline__ unsigned xb_xcc_id() { return (unsigned)__builtin_amdgcn_s_getreg((3 << 11) | 20) & 0xFu; }
#define XB_SPIN(cond, bar) do { unsigned _sp = 0; while (cond) { __builtin_amdgcn_s_sleep(1); \
    if ((++_sp & 255u) == 0u) { if (xb_ld(&(bar)[XB_TMO])) break; if (_sp > XB_SPIN_CAP) { atomicAdd(&(bar)[XB_TMO], 1u); break; } } } } while (0)
struct XcdBarrier { unsigned* bar; unsigned x; volatile LAS unsigned* st; int wave; };
__device__ __forceinline__ XcdBarrier xcd_barrier_post(unsigned* bar, volatile LAS unsigned* st, int wave) {
    XcdBarrier b; b.bar = bar; b.x = xb_xcc_id(); b.st = st; b.wave = wave;
    if (wave == 0 && lane_id_v() == 0) (void)xb_add(&bar[XB_XCNT(b.x)], 1u);
    return b;
}
__device__ __forceinline__ void xcd_barrier_complete(unsigned* bar, unsigned x, unsigned& nloc, unsigned& nx) {
    const unsigned G = gridDim.x * gridDim.y * gridDim.z;
    unsigned sum, cnt, mine, sp = 0u;
    for (;;) {
        sum = 0u; cnt = 0u; mine = 0u;
#pragma unroll
        for (unsigned j = 0; j < 16; ++j) { const unsigned c = xb_ld(&bar[XB_XCNT(j)]); sum += c; cnt += (c > 0u) ? 1u : 0u; mine = (j == x) ? c : mine; }
        if (sum == G) break;
        __builtin_amdgcn_s_sleep(1);
        if ((++sp & 255u) == 0u) { if (xb_ld(&bar[XB_TMO])) break; if (sp > XB_SPIN_CAP) { atomicAdd(&bar[XB_TMO], 1u); break; } }
    }
    nloc = mine > 0u ? mine : 1u; nx = cnt > 0u ? cnt : 1u;
}
__device__ __forceinline__ void xcd_barrier(const XcdBarrier& b) {
    asm volatile("s_waitcnt vmcnt(0)" ::: "memory");
    __syncthreads();
    if (b.wave == 0 && lane_id_v() == 0) {
        unsigned* bar = b.bar;
        __builtin_amdgcn_s_waitcnt(0);
        unsigned nloc = b.st[0], nx = b.st[1];
        if (nloc == 0u) { xcd_barrier_complete(bar, b.x, nloc, nx); b.st[0] = nloc; b.st[1] = nx; }
        const unsigned old = xb_add(&bar[XB_XSUB(b.x)], 1u);
        const unsigned gen = old / nloc;
        if (old + 1u == (gen + 1u) * nloc) {
            __builtin_amdgcn_fence(__ATOMIC_RELEASE, "agent");
            asm volatile("s_waitcnt vmcnt(0)" ::: "memory");
            const unsigned og = xb_add(&bar[XB_TOP], 1u);
            const unsigned tg = og / nx;
            if (og + 1u == (tg + 1u) * nx) xb_add(&bar[XB_TOPGEN], 1u);
            else XB_SPIN(xb_ld(&bar[XB_TOPGEN]) == tg, bar);
            __builtin_amdgcn_fence(__ATOMIC_ACQUIRE, "agent");
            xb_add(&bar[XB_XGEN(b.x)], 1u);
            asm volatile("s_waitcnt vmcnt(0)" ::: "memory");
        } else {
            XB_SPIN(xb_ld(&bar[XB_XGEN(b.x)]) == gen, bar);
            __builtin_amdgcn_fence(__ATOMIC_ACQUIRE, "agent");
            asm volatile("s_waitcnt vmcnt(0)" ::: "memory");
        }
    }
    __syncthreads();
}

namespace pg8 {
constexpr int BM = 256, BK = 64, HALF = 128, HTB = HALF * BK * 2, STAGE_BYTES = 8 * HTB, NXCD = 8, WGM = 8;
__device__ __forceinline__ void glds16(const void* base, unsigned voff, unsigned lds_dst) {
    unsigned keep;
    lds_dst = (unsigned)__builtin_amdgcn_readfirstlane((int)lds_dst);
    const unsigned long long b64 = (unsigned long long)base;
    const unsigned long long bu = ((unsigned long long)(unsigned)__builtin_amdgcn_readfirstlane((int)(b64 >> 32)) << 32) | (unsigned)__builtin_amdgcn_readfirstlane((int)b64);
    asm volatile("s_mov_b32 %0, m0\n\ts_mov_b32 m0, %3\n\ts_nop 0\n\tglobal_load_lds_dwordx4 %1, %2\n\ts_mov_b32 m0, %0" : "=&s"(keep) : "v"(voff), "s"(bu), "s"(lds_dst) : "memory");
}
__host__ __device__ __forceinline__ int lds_byte(int r, int c) { const int st = (r >> 4) * 2 + (c >> 5), rr = r & 15, cc = c & 31, ob = rr * 64 + cc * 2; return st * 1024 + (ob ^ (((ob >> 9) & 1) << 5)); }
__host__ __device__ __forceinline__ void stage_rc(int b, int& R, int& C) { const int st = b / 1024, sb = b % 1024, swz = sb ^ (((sb >> 9) & 1) << 5); R = (st >> 1) * 16 + swz / 64; C = (st & 1) * 32 + (swz % 64) / 2; }
__host__ __device__ __forceinline__ int perm32(int rho) { const int n = rho >> 4, i = rho & 15; return 8 * (i >> 2) + 4 * n + (i & 3); }

struct Unit { int pm, pn, e; };
struct Gemm { const bf16* A; const bf16* Bt; int K; size_t bexp; };

struct StaticOrder {
    int nM, nN, nwg, G, c;
    __device__ void init(int M, int N, int G_, int c_) { nM = M / BM; nN = N / BM; nwg = nM * nN; G = G_; c = c_; }
    __device__ bool next(int i, Unit& u) const {
        const long L = (long)i * G + c; if (L >= nwg) return false;
        int wgid = (int)L; { const int q = nwg / NXCD, r = nwg % NXCD, xcd = wgid % NXCD, off = wgid / NXCD; wgid = (xcd < r ? xcd * (q + 1) : r * (q + 1) + (xcd - r) * q) + off; }
        const int nig = WGM * nN, gid = wgid / nig, fm = gid * WGM, gsz = (nM - fm) < WGM ? (nM - fm) : WGM;
        u.pm = fm + ((wgid % nig) % gsz); u.pn = (wgid % nig) / gsz; u.e = 0; return true;
    }
};
struct MoeOrder {
    const LAS int* lte; int ntiles, nN, G, c;
    __device__ __forceinline__ void init(const int* te, int nN_, int G_, int c_, LAS int* lds_te, int tid) {
        ntiles = __builtin_amdgcn_readfirstlane(te[0]); nN = nN_; G = G_; c = c_; lte = lds_te;
        for (int i = tid; i <= ntiles; i += 512) lds_te[i] = te[i];
        __syncthreads();
    }
    __device__ __forceinline__ bool next(int i, Unit& u) const {
        int pm, pn;
        if (G == 256) { const int pmr = 256 / nN, x = c & 7, a = c >> 3; pm = i * pmr + x * (pmr >> 3) + a / nN; pn = a % nN; }
        else { const long L = (long)i * G + c; pm = (int)(L / nN); pn = (int)(L % nN); }
        if (pm >= ntiles) return false;
        u.pm = pm; u.pn = pn; u.e = __builtin_amdgcn_readfirstlane(lte[1 + pm]); return true;
    }
};

struct EpiKeep {
    static constexpr bool PERM = true; static constexpr int NST = 0;
    __device__ __forceinline__ void prefetch(const Unit& u, unsigned ldsa, int wid, int lane) const {}
    template <int AI> __device__ __forceinline__ void half(const f32x4 (&acc)[2][2][4][2], const Unit& u, int wr, int wc, int fr, int fq, const LAS unsigned char* bl) const {
#pragma unroll
        for (int bj = 0; bj < 2; ++bj)
#pragma unroll
            for (int m = 0; m < 4; ++m) asm volatile("" :: "v"(acc[AI][bj][m][0]), "v"(acc[AI][bj][m][1]));
    }
    __device__ __forceinline__ void operator()(const f32x4 (&acc)[2][2][4][2], const Unit& u, int wr, int wc, int fr, int fq) const {
#pragma unroll
        for (int ai = 0; ai < 2; ++ai)
#pragma unroll
            for (int bj = 0; bj < 2; ++bj)
#pragma unroll
                for (int m = 0; m < 4; ++m) asm volatile("" :: "v"(acc[ai][bj][m][0]), "v"(acc[ai][bj][m][1]));
    }
};
struct EpiBf16 {
    static constexpr bool PERM = true; static constexpr int NST = 8;
    bf16* O; int ldc; float sc;
    __device__ __forceinline__ void prefetch(const Unit& u, unsigned ldsa, int wid, int lane) const {}
    template <int AI> __device__ __forceinline__ void half(const f32x4 (&acc)[2][2][4][2], const Unit& u, int wr, int wc, int fr, int fq, const LAS unsigned char* bl) const {
        const int row0 = u.pm * BM + wr * 64 + fr, col0 = u.pn * BM + wc * 32 + 8 * fq;
        char* Ob = (char*)O; const unsigned ld2 = (unsigned)ldc * 2u; const unsigned off = (unsigned)row0 * ld2 + (unsigned)col0 * 2u;
#pragma unroll
        for (int m = 0; m < 4; ++m) { const unsigned ro = off + (unsigned)(AI * HALF + m * 16) * ld2;
#pragma unroll
            for (int bj = 0; bj < 2; ++bj) { const f32x4 v0 = acc[AI][bj][m][0] * sc, v1 = acc[AI][bj][m][1] * sc;
                u32x4 w; w.x = pk2(v0[0], v0[1]); w.y = pk2(v0[2], v0[3]); w.z = pk2(v1[0], v1[1]); w.w = pk2(v1[2], v1[3]);
                *(u32x4*)(Ob + ro + bj * HALF * 2) = w; } }
    }
    __device__ __forceinline__ void operator()(const f32x4 (&acc)[2][2][4][2], const Unit& u, int wr, int wc, int fr, int fq) const {
        const int row0 = u.pm * BM + wr * 64 + fr, col0 = u.pn * BM + wc * 32 + 8 * fq;
        char* Ob = (char*)O; const unsigned ld2 = (unsigned)ldc * 2u; unsigned off = (unsigned)row0 * ld2 + (unsigned)col0 * 2u;
#pragma unroll
        for (int ai = 0; ai < 2; ++ai)
#pragma unroll
            for (int m = 0; m < 4; ++m) { const unsigned ro = off + (unsigned)(ai * HALF + m * 16) * ld2;
#pragma unroll
                for (int bj = 0; bj < 2; ++bj) { const f32x4 v0 = acc[ai][bj][m][0] * sc, v1 = acc[ai][bj][m][1] * sc;
                    u32x4 w; w.x = pk2(v0[0], v0[1]); w.y = pk2(v0[2], v0[3]); w.z = pk2(v1[0], v1[1]); w.w = pk2(v1[2], v1[3]);
                    *(u32x4*)(Ob + ro + bj * HALF * 2) = w; } }
    }
};
struct EpiRes {
    static constexpr bool PERM = false;
    const bf16* base; bf16* out; const float* gate;
    __device__ __forceinline__ void operator()(const f32x4 (&acc)[2][2][4][2], const Unit& u, int wr, int wc, int fr, int fq) const {
        const int row0 = u.pm * BM + wr * 64 + fr, col0 = u.pn * BM + wc * 32 + 4 * fq;
        const int mrow = u.pm < 128 ? (u.pm >> 6) : 2;
        const float* gp = gate + (size_t)mrow * 6144 + col0;
        f32x4 gv[2][2];
#pragma unroll
        for (int bj = 0; bj < 2; ++bj)
#pragma unroll
            for (int n = 0; n < 2; ++n) gv[bj][n] = *(const f32x4*)(gp + bj * HALF + n * 16);
#pragma unroll
        for (int ai = 0; ai < 2; ++ai)
#pragma unroll
            for (int m = 0; m < 4; ++m) { const size_t off = (size_t)(row0 + ai * HALF + m * 16) * DM + col0;
#pragma unroll
                for (int bj = 0; bj < 2; ++bj)
#pragma unroll
                    for (int n = 0; n < 2; ++n) { const u32x2 bw = *(const u32x2*)(base + off + bj * HALF + n * 16);
                        const f32x4 bs = {__uint_as_float(bw.x << 16), __uint_as_float(bw.x & 0xffff0000u), __uint_as_float(bw.y << 16), __uint_as_float(bw.y & 0xffff0000u)};
                        const f32x4 r = bs + gv[bj][n] * acc[ai][bj][m][n];
                        u32x2 w; w.x = pk2(r[0], r[1]); w.y = pk2(r[2], r[3]); *(u32x2*)(out + off + bj * HALF + n * 16) = w; } }
    }
};
__device__ __forceinline__ float swiglu1(float g, float up) {
    g = fminf(g, 7.0f); up = fminf(fmaxf(up, -7.0f), 7.0f);
    const float sg = __builtin_amdgcn_rcpf(1.0f + __builtin_amdgcn_exp2f(-1.702f * LOG2E * g));
    return g * sg * (up + 1.0f);
}
struct EpiSwiGLU {
    static constexpr bool PERM = true;
    bf16* O; const float* b1;
    __device__ __forceinline__ void operator()(const f32x4 (&acc)[2][2][4][2], const Unit& u, int wr, int wc, int fr, int fq) const {
        const int row0 = u.pm * BM + wr * 64 + fr, colo = u.pn * HALF + wc * 32 + 8 * fq;
        const float* bg = b1 + (size_t)u.e * 2048 + colo;
        f32x4 bgv[2], buv[2];
#pragma unroll
        for (int n = 0; n < 2; ++n) { bgv[n] = *(const f32x4*)(bg + 4 * n); buv[n] = *(const f32x4*)(bg + 1024 + 4 * n); }
#pragma unroll
        for (int ai = 0; ai < 2; ++ai)
#pragma unroll
            for (int m = 0; m < 4; ++m) { bf16* rowp = O + (size_t)(row0 + ai * HALF + m * 16) * DM + colo;
                float o[8];
#pragma unroll
                for (int n = 0; n < 2; ++n) { const f32x4 g = acc[ai][0][m][n] + bgv[n], up = acc[ai][1][m][n] + buv[n];
#pragma unroll
                    for (int j = 0; j < 4; ++j) o[4 * n + j] = swiglu1(g[j], up[j]); }
                *(u32x4*)rowp = pack8(o); }
    }
};
struct EpiMoe2 {
    static constexpr bool PERM = true;
    bf16* O; const float* b2; const float* gate_s;
    __device__ __forceinline__ void operator()(const f32x4 (&acc)[2][2][4][2], const Unit& u, int wr, int wc, int fr, int fq) const {
        const int row0 = u.pm * BM + wr * 64 + fr, col0 = u.pn * BM + wc * 32 + 8 * fq;
        const float* bp = b2 + (size_t)u.e * 1024 + col0;
        f32x4 bv[2][2];
#pragma unroll
        for (int bj = 0; bj < 2; ++bj)
#pragma unroll
            for (int n = 0; n < 2; ++n) bv[bj][n] = *(const f32x4*)(bp + bj * HALF + 4 * n);
#pragma unroll
        for (int ai = 0; ai < 2; ++ai)
#pragma unroll
            for (int m = 0; m < 4; ++m) { const int row = row0 + ai * HALF + m * 16; const float gt = gate_s[row]; bf16* rowp = O + (size_t)row * DM + col0;
#pragma unroll
                for (int bj = 0; bj < 2; ++bj) { const f32x4 v0 = (acc[ai][bj][m][0] + bv[bj][0]) * gt, v1 = (acc[ai][bj][m][1] + bv[bj][1]) * gt;
                    u32x4 w; w.x = pk2(v0[0], v0[1]); w.y = pk2(v0[2], v0[3]); w.z = pk2(v1[0], v1[1]); w.w = pk2(v1[2], v1[3]);
                    *(u32x4*)(rowp + bj * HALF) = w; } }
    }
};


__device__ __forceinline__ unsigned pk4_fp8(float a, float b, float c, float d) { unsigned w = __float_as_uint(a);
    w = __builtin_amdgcn_cvt_pk_fp8_f32(a, b, w, false); w = __builtin_amdgcn_cvt_pk_fp8_f32(c, d, w, true); return w; }
__device__ __forceinline__ unsigned pk4_bf8(float a, float b, float c, float d) { unsigned w = __float_as_uint(a);
    w = __builtin_amdgcn_cvt_pk_bf8_f32(a, b, w, false); w = __builtin_amdgcn_cvt_pk_bf8_f32(c, d, w, true); return w; }
struct EpiSwiGLU8 {
    static constexpr bool PERM = true; static constexpr int NST = 2;
    unsigned char* O; const float* b1;
    __device__ __forceinline__ void prefetch(const Unit& u, unsigned ldsa, int wid, int lane) const {
        if (wid == 0) glds16((const void*)(b1 + (size_t)u.e * 2048 + u.pn * HALF), (unsigned)(lane < 32 ? lane * 16 : 4096 + (lane - 32) * 16), ldsa);
    }
    template <int AI> __device__ __forceinline__ void half(const f32x4 (&acc)[2][2][4][2], const Unit& u, int wr, int wc, int fr, int fq, const LAS unsigned char* bl) const {
        const int colo = u.pn * HALF + wc * 32 + 8 * fq, cl = wc * 32 + 8 * fq;
        f32x4 bgv[2], buv[2];
#pragma unroll
        for (int n = 0; n < 2; ++n) { bgv[n] = *(const LAS f32x4*)(bl + (cl + 4 * n) * 4); buv[n] = *(const LAS f32x4*)(bl + 512 + (cl + 4 * n) * 4) + 1.0f; }
        unsigned char* Ob = O + (size_t)(u.pm * BM) * DM; const unsigned off = (unsigned)(wr * 64 + fr + AI * HALF + (fq & 1) * 16) * DM + (unsigned)(colo - 8 * (fq & 1));
#pragma unroll
        for (int mp = 0; mp < 2; ++mp) { u32x2 w[2];
#pragma unroll
            for (int q = 0; q < 2; ++q) { const int m = 2 * mp + q; float o[8];
#pragma unroll
                for (int n = 0; n < 2; ++n) { const f32x4 g4 = acc[AI][0][m][n] * 0.03125f + bgv[n], u4 = acc[AI][1][m][n] * 0.03125f + buv[n];
#pragma unroll
                    for (int j = 0; j < 4; ++j) { const float g = fminf(g4[j], 7.0f), u1 = __builtin_amdgcn_fmed3f(u4[j], -6.0f, 8.0f);
                        const float r4 = __builtin_amdgcn_rcpf(0.25f + __builtin_amdgcn_exp2f(__builtin_fmaf(g, -1.702f * LOG2E, -2.0f)));
                        o[4 * n + j] = g * r4 * u1; } }
                w[q].x = pk4_fp8(o[0], o[1], o[2], o[3]); w[q].y = pk4_fp8(o[4], o[5], o[6], o[7]); }
            const auto sx = __builtin_amdgcn_permlane16_swap(w[0].x, w[1].x, false, false), sy = __builtin_amdgcn_permlane16_swap(w[0].y, w[1].y, false, false);
            u32x4 o4; o4.x = sx[0]; o4.y = sy[0]; o4.z = sx[1]; o4.w = sy[1];
            *(u32x4*)(Ob + off + (unsigned)(mp * 32) * DM) = o4; }
    }
    __device__ __forceinline__ void operator()(const f32x4 (&acc)[2][2][4][2], const Unit& u, int wr, int wc, int fr, int fq) const {
        const int row0 = u.pm * BM + wr * 64 + fr, colo = u.pn * HALF + wc * 32 + 8 * fq;
        const float* bg = b1 + (size_t)u.e * 2048 + colo;
        f32x4 bgv[2], buv[2];
#pragma unroll
        for (int n = 0; n < 2; ++n) { bgv[n] = *(const f32x4*)(bg + 4 * n); buv[n] = *(const f32x4*)(bg + 1024 + 4 * n); }
#pragma unroll
        for (int ai = 0; ai < 2; ++ai)
#pragma unroll
            for (int m = 0; m < 4; ++m) { unsigned char* rowp = O + (size_t)(row0 + ai * HALF + m * 16) * DM + colo;
                float o[8];
#pragma unroll
                for (int n = 0; n < 2; ++n) { const f32x4 g = acc[ai][0][m][n] * 0.03125f + bgv[n], up = acc[ai][1][m][n] * 0.03125f + buv[n];
#pragma unroll
                    for (int j = 0; j < 4; ++j) o[4 * n + j] = 4.0f * swiglu1(g[j], up[j]); }
                u32x2 w; w.x = pk4_fp8(o[0], o[1], o[2], o[3]); w.y = pk4_fp8(o[4], o[5], o[6], o[7]);
                *(u32x2*)rowp = w; }
    }
};
struct EpiMoe2F8 {
    static constexpr bool PERM = true; static constexpr int NST = 4;
    unsigned char* O; const float* b2; const float* gate_s;
    __device__ __forceinline__ void prefetch(const Unit& u, unsigned ldsa, int wid, int lane) const {
        if (wid == 0) glds16((const void*)(b2 + (size_t)u.e * 1024 + u.pn * BM), (unsigned)(lane * 16), ldsa);
        if (wid == 1) glds16((const void*)(gate_s + (size_t)u.pm * BM), (unsigned)(lane * 16), ldsa + 1024u);
    }
    template <int AI> __device__ __forceinline__ void half(const f32x4 (&acc)[2][2][4][2], const Unit& u, int wr, int wc, int fr, int fq, const LAS unsigned char* bl) const {
        const int col0 = u.pn * BM + wc * 32 + 8 * fq, cl = wc * 32 + 8 * fq;
        unsigned char* Ob = O + (size_t)(u.pm * BM) * DM; const unsigned off = (unsigned)(wr * 64 + fr + AI * HALF + (fq & 1) * 16) * DM + (unsigned)(col0 - 8 * (fq & 1));
#pragma unroll
        for (int bj = 0; bj < 2; ++bj) {
            const f32x4 b0 = *(const LAS f32x4*)(bl + (bj * HALF + cl) * 4) * 32.0f, b1 = *(const LAS f32x4*)(bl + (bj * HALF + cl + 4) * 4) * 32.0f;
#pragma unroll
            for (int mp = 0; mp < 2; ++mp) { u32x2 w[2];
#pragma unroll
                for (int q = 0; q < 2; ++q) { const int m = 2 * mp + q; const float gt = *(const LAS float*)(bl + 1024 + (AI * HALF + wr * 64 + m * 16 + fr) * 4);
                    const f32x4 v0 = (acc[AI][bj][m][0] * 0.25f + b0) * gt, v1 = (acc[AI][bj][m][1] * 0.25f + b1) * gt;
                    w[q].x = pk4_fp8(v0[0], v0[1], v0[2], v0[3]); w[q].y = pk4_fp8(v1[0], v1[1], v1[2], v1[3]); }
                const auto sx = __builtin_amdgcn_permlane16_swap(w[0].x, w[1].x, false, false), sy = __builtin_amdgcn_permlane16_swap(w[0].y, w[1].y, false, false);
                u32x4 o; o.x = sx[0]; o.y = sy[0]; o.z = sx[1]; o.w = sy[1];
                *(u32x4*)(Ob + off + (unsigned)(mp * 32) * DM + bj * HALF) = o; } }
    }
    __device__ __forceinline__ void operator()(const f32x4 (&acc)[2][2][4][2], const Unit& u, int wr, int wc, int fr, int fq) const {
        const int row0 = u.pm * BM + wr * 64 + fr, col0 = u.pn * BM + wc * 32 + 8 * fq;
        const float* bp = b2 + (size_t)u.e * 1024 + col0;
        f32x4 bv[2][2];
#pragma unroll
        for (int bj = 0; bj < 2; ++bj)
#pragma unroll
            for (int n = 0; n < 2; ++n) bv[bj][n] = *(const f32x4*)(bp + bj * HALF + 4 * n) * 32.0f;
#pragma unroll
        for (int ai = 0; ai < 2; ++ai)
#pragma unroll
            for (int m = 0; m < 4; ++m) { const int row = row0 + ai * HALF + m * 16; const float gt = gate_s[row]; unsigned char* rowp = O + (size_t)row * DM + col0;
#pragma unroll
                for (int bj = 0; bj < 2; ++bj) { const f32x4 v0 = (acc[ai][bj][m][0] * 0.25f + bv[bj][0]) * gt, v1 = (acc[ai][bj][m][1] * 0.25f + bv[bj][1]) * gt;
                    u32x2 w; w.x = pk4_fp8(v0[0], v0[1], v0[2], v0[3]); w.y = pk4_fp8(v1[0], v1[1], v1[2], v1[3]);
                    *(u32x2*)(rowp + bj * HALF) = w; } }
    }
};
template <class Epi, class Sched>
__device__ __forceinline__ void gemm_phase(LAS unsigned char* lds, const Gemm g, const Sched& S, const Epi& E, const int wid_in) {
    const int wid = __builtin_amdgcn_readfirstlane(wid_in);
    int lane = lane_id_v(); asm volatile("" : "+v"(lane));
    const int tid = wid * 64 + lane, wr = wid >> 2, wc = wid & 3, fr = lane & 15, fq = lane >> 4;
    const int K = g.K, nt = K / BK;
    unsigned voffA[2], voffB[2];
#pragma unroll
    for (int i = 0; i < 2; ++i) { int R, C; stage_rc(tid * 16 + i * 8192, R, C); const int Rb = Epi::PERM ? ((R & ~31) + perm32(R & 31)) : R;
        voffA[i] = (unsigned)(R * K + C) * 2u; voffB[i] = (unsigned)(Rb * K + C) * 2u; }
    const size_t kstep = (size_t)(BK * 2);
    const size_t hstep = (size_t)HALF * K * 2;
    const size_t tstep = 2 * hstep;
    const unsigned ldsb = (unsigned)(size_t)lds + (unsigned)wid * 1024u;
    const int aoff = lds_byte(wr * 64 + fr, fq * 8), boff = lds_byte(wc * 32 + fr, fq * 8);
#define PG8_SA(b, h) (((b) * 2 + (h)) * HTB)
#define PG8_SB(b, h) ((4 + (b) * 2 + (h)) * HTB)
#define PG8_STAGE(bufoff, gbase, voff) do { _Pragma("unroll") for (int _i = 0; _i < 2; ++_i) \
        glds16((const void*)(gbase), (voff)[_i], ldsb + (unsigned)(bufoff) + (unsigned)(_i * 8192)); } while (0)
#define PG8_LDA(dst, b, h) do { _Pragma("unroll") for (int m = 0; m < 4; ++m) _Pragma("unroll") for (int k = 0; k < 2; ++k) dst[m][k] = *(const LAS bf16x8*)(lds + PG8_SA(b, h) + aoff + m * 2048 + k * 1024); } while (0)
#define PG8_LDB(dst, b, h) do { _Pragma("unroll") for (int n = 0; n < 2; ++n) _Pragma("unroll") for (int k = 0; k < 2; ++k) dst[n][k] = *(const LAS bf16x8*)(lds + PG8_SB(b, h) + boff + n * 2048 + k * 1024); } while (0)
#define PG8_MMA(ai, bj, At, Bt) do { __builtin_amdgcn_s_setprio(1); _Pragma("unroll") for (int m = 0; m < 4; ++m) _Pragma("unroll") for (int n = 0; n < 2; ++n) _Pragma("unroll") for (int k = 0; k < 2; ++k) \
        acc[ai][bj][m][n] = __builtin_amdgcn_mfma_f32_16x16x32_bf16(Bt[n][k], At[m][k], acc[ai][bj][m][n], 0, 0, 0); __builtin_amdgcn_s_setprio(0); } while (0)
#define PG8_WAIT_V(n) asm volatile("s_waitcnt vmcnt(" #n ")" ::: "memory")
#define PG8_WAIT_L(n) asm volatile("s_waitcnt lgkmcnt(" #n ")" ::: "memory")
#define PG8_BAR __builtin_amdgcn_s_barrier()
#define PG8_SCHED __builtin_amdgcn_sched_barrier(0)
    Unit cur, nxt; int ui = 0;
    if (!S.next(0, cur)) return;
    cur.pm = __builtin_amdgcn_readfirstlane(cur.pm); cur.pn = __builtin_amdgcn_readfirstlane(cur.pn); cur.e = __builtin_amdgcn_readfirstlane(cur.e);
    f32x4 acc[2][2][4][2];
#pragma unroll
    for (int a = 0; a < 2; ++a)
#pragma unroll
        for (int b = 0; b < 2; ++b)
#pragma unroll
            for (int m = 0; m < 4; ++m)
#pragma unroll
                for (int n = 0; n < 2; ++n) acc[a][b][m][n] = (f32x4){0.f, 0.f, 0.f, 0.f};
    bf16x8 At[4][2], B0[2][2], B1[2][2];
    const char* cA = (const char*)g.A + (size_t)cur.pm * tstep; const char* cB = (const char*)g.Bt + (size_t)cur.e * g.bexp + (size_t)cur.pn * tstep;
    PG8_STAGE(PG8_SB(0, 0), cB, voffB); PG8_STAGE(PG8_SB(0, 1), cB + hstep, voffB); PG8_STAGE(PG8_SA(0, 0), cA, voffA); PG8_STAGE(PG8_SA(0, 1), cA + hstep, voffA);
    if (wr == 1) PG8_BAR;
    PG8_WAIT_V(2); PG8_BAR;
    PG8_STAGE(PG8_SB(1, 0), cB + kstep, voffB); PG8_STAGE(PG8_SA(1, 0), cA + kstep, voffA); PG8_STAGE(PG8_SB(1, 1), cB + hstep + kstep, voffB);
    PG8_WAIT_V(6); PG8_BAR;
    for (;;) {
        const bool has_next = S.next(ui + 1, nxt);
        nxt.pm = __builtin_amdgcn_readfirstlane(nxt.pm); nxt.pn = __builtin_amdgcn_readfirstlane(nxt.pn); nxt.e = __builtin_amdgcn_readfirstlane(nxt.e);
        const char* nA = has_next ? (const char*)g.A + (size_t)nxt.pm * tstep : cA; const char* nB = has_next ? (const char*)g.Bt + (size_t)nxt.e * g.bexp + (size_t)nxt.pn * tstep : cB;
#pragma nounroll
        for (int t = 0; t < nt; t += 2) {
            const bool last = (t == nt - 2);
            const char* a1 = cA + (size_t)(t + 1) * kstep;
            const char* a2 = last ? nA : cA + (size_t)(t + 2) * kstep; const char* b2 = last ? nB : cB + (size_t)(t + 2) * kstep;
            const char* a3 = a2 + kstep; const char* b3 = b2 + kstep;
            PG8_LDB(B0, 0, 0); PG8_LDB(B1, 0, 1); PG8_SCHED; PG8_LDA(At, 0, 0); PG8_STAGE(PG8_SA(1, 1), a1 + hstep, voffA);
            PG8_WAIT_V(8); PG8_WAIT_L(0); PG8_BAR; PG8_MMA(0, 0, At, B0); PG8_MMA(0, 1, At, B1); PG8_BAR; PG8_SCHED;
            PG8_LDA(At, 0, 1); PG8_STAGE(PG8_SB(0, 0), b2, voffB); PG8_STAGE(PG8_SB(0, 1), b2 + hstep, voffB); PG8_STAGE(PG8_SA(0, 0), a2, voffA);
            PG8_WAIT_V(8); PG8_WAIT_L(0); PG8_BAR; PG8_MMA(1, 0, At, B0); PG8_MMA(1, 1, At, B1); PG8_BAR; PG8_SCHED;
            PG8_LDB(B0, 1, 0); PG8_LDB(B1, 1, 1); PG8_SCHED; PG8_LDA(At, 1, 0); PG8_STAGE(PG8_SA(0, 1), a2 + hstep, voffA);
            PG8_WAIT_V(8); PG8_WAIT_L(0); PG8_BAR; PG8_MMA(0, 0, At, B0); PG8_MMA(0, 1, At, B1); PG8_BAR; PG8_SCHED;
            PG8_LDA(At, 1, 1); PG8_STAGE(PG8_SB(1, 0), b3, voffB); PG8_STAGE(PG8_SB(1, 1), b3 + hstep, voffB); PG8_STAGE(PG8_SA(1, 0), a3, voffA);
            PG8_WAIT_V(8); PG8_WAIT_L(0); PG8_BAR; PG8_MMA(1, 0, At, B0); PG8_MMA(1, 1, At, B1); PG8_BAR; PG8_SCHED;
        }
        if (wr == 0) PG8_BAR;
        { int ln2 = lane_id_v(); asm volatile("" : "+v"(ln2));
          E(acc, cur, wr, wc, ln2 & 15, ln2 >> 4); }
        if (!has_next) break;
#pragma unroll
        for (int a = 0; a < 2; ++a)
#pragma unroll
            for (int b = 0; b < 2; ++b)
#pragma unroll
                for (int m = 0; m < 4; ++m)
#pragma unroll
                    for (int n = 0; n < 2; ++n) acc[a][b][m][n] = (f32x4){0.f, 0.f, 0.f, 0.f};
        cur = nxt; cA = nA; cB = nB; ++ui;
        if (wr == 1) PG8_BAR;
    }
    PG8_WAIT_V(0);
    PG8_BAR;
#undef PG8_SA
#undef PG8_SB
#undef PG8_STAGE
#undef PG8_LDA
#undef PG8_LDB
#undef PG8_MMA
#undef PG8_MMAZ
#undef PG8_WAIT_V
#undef PG8_WAIT_L
#undef PG8_BAR
#undef PG8_SCHED
}
__device__ __forceinline__ f32x4 zero4() { f32x4 z; asm volatile("v_mov_b32 %0, 0\n\tv_mov_b32 %1, 0\n\tv_mov_b32 %2, 0\n\tv_mov_b32 %3, 0" : "=v"(z.x), "=v"(z.y), "=v"(z.z), "=v"(z.w)); return z; }
__device__ __forceinline__ void zero4_inplace(f32x4& v) {
    asm volatile("v_and_b32 %0, 0, %0\n\tv_and_b32 %1, 0, %1\n\tv_and_b32 %2, 0, %2\n\tv_and_b32 %3, 0, %3" : "+v"(v.x), "+v"(v.y), "+v"(v.z), "+v"(v.w));
}
template <class Epi, class Sched>
__device__ __forceinline__ void gemm_phase_f8(LAS unsigned char* lds, const Gemm g, const Sched& S, const Epi& E, const int wid_in) {
    const int wid = __builtin_amdgcn_readfirstlane(wid_in);
    int lane = lane_id_v(); asm volatile("" : "+v"(lane));
    const int tid = wid * 64 + lane, wr = wid >> 2, wc = wid & 3, fr = lane & 15, fq = lane >> 4;
    const int K = g.K, nt = K / BK;
    unsigned voffA, voffB;
    { int R, C; stage_rc(tid * 16, R, C); const int Rb = Epi::PERM ? ((R & ~31) + perm32(R & 31)) : R; voffA = (unsigned)(R * K + C) * 2u; voffB = (unsigned)(Rb * K + C) * 2u; }
    const size_t r64 = (size_t)64 * K * 2;
    const size_t kstep = (size_t)(BK * 2);
    const size_t hstep = (size_t)HALF * K * 2;
    const size_t tstep = 2 * hstep;
    const unsigned ldsb = (unsigned)(size_t)lds + (unsigned)wid * 1024u;
    const int aoff0 = lds_byte(wr * 64 + fr, fq * 16), boff0 = lds_byte(wc * 32 + fr, fq * 16);
#define PG8_SA(b, h) (((b) * 2 + (h)) * HTB)
#define PG8_SB(b, h) ((4 + (b) * 2 + (h)) * HTB)
#define PG8_STAGE(bufoff, gbase, voff) do { \
        glds16((const void*)(gbase), (voff), ldsb + (unsigned)(bufoff)); \
        glds16((const void*)((const char*)(gbase) + r64), (voff), ldsb + (unsigned)(bufoff) + 8192u); } while (0)
#define PG8_LDA(dst, b, h) do { _Pragma("unroll") for (int m = 0; m < 4; ++m) { const i32x4 lo_ = *(const LAS i32x4*)(lds + PG8_SA(b, h) + aoff0 + m * 2048), hi_ = *(const LAS i32x4*)(lds + PG8_SA(b, h) + aoff0 + 16 + m * 2048); dst[m] = __builtin_shufflevector(lo_, hi_, 0, 1, 2, 3, 4, 5, 6, 7); } } while (0)
#define PG8_LDB(dst, b, h) do { _Pragma("unroll") for (int n = 0; n < 2; ++n) { const i32x4 lo_ = *(const LAS i32x4*)(lds + PG8_SB(b, h) + boff0 + n * 2048), hi_ = *(const LAS i32x4*)(lds + PG8_SB(b, h) + boff0 + 16 + n * 2048); dst[n] = __builtin_shufflevector(lo_, hi_, 0, 1, 2, 3, 4, 5, 6, 7); } } while (0)
#define PG8_MMA(ai, bj, At, Bt) do { __builtin_amdgcn_s_setprio(1); _Pragma("unroll") for (int m = 0; m < 4; ++m) _Pragma("unroll") for (int n = 0; n < 2; ++n) \
        acc[ai][bj][m][n] = __builtin_amdgcn_mfma_scale_f32_16x16x128_f8f6f4(Bt[n], At[m], acc[ai][bj][m][n], 0, 0, 0, 0x7F7F7F7F, 0, 0x7F7F7F7F); __builtin_amdgcn_s_setprio(0); } while (0)
#define PG8_MMAZ(ai, bj, At, Bt) do { __builtin_amdgcn_s_setprio(1); _Pragma("unroll") for (int m = 0; m < 4; ++m) _Pragma("unroll") for (int n = 0; n < 2; ++n) \
        acc[ai][bj][m][n] = __builtin_amdgcn_mfma_scale_f32_16x16x128_f8f6f4(Bt[n], At[m], (f32x4){0.f, 0.f, 0.f, 0.f}, 0, 0, 0, 0x7F7F7F7F, 0, 0x7F7F7F7F); __builtin_amdgcn_s_setprio(0); } while (0)
#define PG8_WAIT_V(n) asm volatile("s_waitcnt vmcnt(" #n ")" ::: "memory")
#define PG8_WAIT_L(n) asm volatile("s_waitcnt lgkmcnt(" #n ")" ::: "memory")
#define PG8_BAR __builtin_amdgcn_s_barrier()
#define PG8_SCHED __builtin_amdgcn_sched_barrier(0)
#ifndef GEMM_FW
#define GEMM_FW 0
#endif
#ifndef GEMM_OVL
#define GEMM_OVL 2
#endif
#define PG8_WAITN(n) do { if constexpr ((n) == 8) PG8_WAIT_V(8); else if constexpr ((n) == 12) PG8_WAIT_V(12); else if constexpr ((n) == 16) PG8_WAIT_V(16); else if constexpr ((n) == 24) PG8_WAIT_V(24); else static_assert((n) == 8 || (n) == 12 || (n) == 16 || (n) == 24, "vmcnt"); } while (0)
#if GEMM_OVL == 1
    Unit cur, nxt; int ui = 0;
    if (!S.next(0, cur)) return;
    cur.pm = __builtin_amdgcn_readfirstlane(cur.pm); cur.pn = __builtin_amdgcn_readfirstlane(cur.pn); cur.e = __builtin_amdgcn_readfirstlane(cur.e);
    constexpr int NST = Epi::NST;
    LAS unsigned char* const blds = lds + STAGE_BYTES;
    const unsigned bldsa = (unsigned)(size_t)lds + (unsigned)STAGE_BYTES;
    f32x4 acc[2][2][4][2];
#pragma unroll
    for (int a = 0; a < 2; ++a)
#pragma unroll
        for (int b = 0; b < 2; ++b)
#pragma unroll
            for (int m = 0; m < 4; ++m)
#pragma unroll
                for (int n = 0; n < 2; ++n) acc[a][b][m][n] = zero4();
    i32x8 At[4], B0[2], B1[2];
    const char* cA = (const char*)g.A + (size_t)cur.pm * tstep; const char* cB = (const char*)g.Bt + (size_t)cur.e * g.bexp + (size_t)cur.pn * tstep;
    PG8_STAGE(PG8_SB(0, 0), cB, voffB); PG8_STAGE(PG8_SB(0, 1), cB + hstep, voffB); PG8_STAGE(PG8_SA(0, 0), cA, voffA); PG8_STAGE(PG8_SA(0, 1), cA + hstep, voffA);
    if (wr == 1) PG8_BAR;
    PG8_WAIT_V(2); PG8_BAR;
    PG8_STAGE(PG8_SB(1, 0), cB + kstep, voffB); PG8_STAGE(PG8_SA(1, 0), cA + kstep, voffA); PG8_STAGE(PG8_SB(1, 1), cB + hstep + kstep, voffB);
    PG8_WAIT_V(6); PG8_BAR;
    for (;;) {
        const bool has_next = S.next(ui + 1, nxt);
        nxt.pm = __builtin_amdgcn_readfirstlane(nxt.pm); nxt.pn = __builtin_amdgcn_readfirstlane(nxt.pn); nxt.e = __builtin_amdgcn_readfirstlane(nxt.e);
        const char* nA = has_next ? (const char*)g.A + (size_t)nxt.pm * tstep : cA; const char* nB = has_next ? (const char*)g.Bt + (size_t)nxt.e * g.bexp + (size_t)nxt.pn * tstep : cB;
#define PG8_ITER(FIRST, LAST, T, FW) do { \
            const char* a1 = cA + (size_t)((T) + 1) * kstep; \
            const char* a2 = (LAST) ? nA : cA + (size_t)((T) + 2) * kstep; const char* b2 = (LAST) ? nB : cB + (size_t)((T) + 2) * kstep; \
            const char* a3 = a2 + kstep; const char* b3 = b2 + kstep; \
            if (LAST) { int ln2 = lane_id_v(); asm volatile("" : "+v"(ln2)); E.prefetch(cur, bldsa + (unsigned)(ui & 1) * 2048u, wid, ln2); } \
            PG8_LDB(B0, 0, 0); PG8_LDB(B1, 0, 1); PG8_SCHED; PG8_LDA(At, 0, 0); PG8_STAGE(PG8_SA(1, 1), a1 + hstep, voffA); \
            if (FW) PG8_WAITN(8 + 2 * NST); else PG8_WAIT_V(8); \
            PG8_WAIT_L(0); PG8_BAR; PG8_MMA(0, 0, At, B0); PG8_MMA(0, 1, At, B1); PG8_BAR; PG8_SCHED; \
            PG8_LDA(At, 0, 1); PG8_STAGE(PG8_SB(0, 0), b2, voffB); PG8_STAGE(PG8_SB(0, 1), b2 + hstep, voffB); PG8_STAGE(PG8_SA(0, 0), a2, voffA); \
            if (FW) PG8_WAITN(8 + 2 * NST); else PG8_WAIT_V(8); \
            PG8_WAIT_L(0); PG8_BAR; PG8_MMA(1, 0, At, B0); PG8_MMA(1, 1, At, B1); PG8_BAR; PG8_SCHED; \
            PG8_LDB(B0, 1, 0); PG8_LDB(B1, 1, 1); PG8_SCHED; PG8_LDA(At, 1, 0); PG8_STAGE(PG8_SA(0, 1), a2 + hstep, voffA); \
            PG8_WAIT_V(8); PG8_WAIT_L(0); PG8_BAR; PG8_MMA(0, 0, At, B0); PG8_MMA(0, 1, At, B1); PG8_BAR; PG8_SCHED; \
            PG8_LDA(At, 1, 1); PG8_STAGE(PG8_SB(1, 0), b3, voffB); PG8_STAGE(PG8_SB(1, 1), b3 + hstep, voffB); PG8_STAGE(PG8_SA(1, 0), a3, voffA); PG8_WAIT_V(8); \
            PG8_WAIT_L(0); PG8_BAR; PG8_MMA(1, 0, At, B0); PG8_MMA(1, 1, At, B1); PG8_BAR; PG8_SCHED; \
            if (LAST) { \
                { int ln2 = lane_id_v(); asm volatile("" : "+v"(ln2)); E.template half<0>(acc, cur, wr, wc, ln2 & 15, ln2 >> 4, blds + (ui & 1) * 2048); } \
                PG8_SCHED; \
                { int ln2 = lane_id_v(); asm volatile("" : "+v"(ln2)); E.template half<1>(acc, cur, wr, wc, ln2 & 15, ln2 >> 4, blds + (ui & 1) * 2048); } \
                PG8_SCHED; \
                _Pragma("unroll") for (int a = 0; a < 2; ++a) _Pragma("unroll") for (int b = 0; b < 2; ++b) _Pragma("unroll") for (int m = 0; m < 4; ++m) _Pragma("unroll") for (int n = 0; n < 2; ++n) zero4_inplace(acc[a][b][m][n]); \
                PG8_SCHED; } } while (0)
#pragma nounroll
        for (int t = 0; t < nt - 2; t += 2) { const bool fw = (t == 0) && (ui > 0); PG8_ITER(false, false, t, fw); }
        PG8_ITER(false, true, nt - 2, false);
#undef PG8_ITER
        if (!has_next) break;
        cur = nxt; cA = nA; cB = nB; ++ui;
    }
    if (wr == 0) PG8_BAR;
    PG8_WAIT_V(0);
    PG8_BAR;
#else
#ifndef GEMM_STAG
#define GEMM_STAG 0
#endif
    if (GEMM_STAG > 0 && (S.c & 4)) { for (int q = 0; q < GEMM_STAG; ++q) __builtin_amdgcn_s_sleep(100); }
    Unit cur, nxt; int ui = 0;
    if (!S.next(0, cur)) return;
    cur.pm = __builtin_amdgcn_readfirstlane(cur.pm); cur.pn = __builtin_amdgcn_readfirstlane(cur.pn); cur.e = __builtin_amdgcn_readfirstlane(cur.e);
    f32x4 acc[2][2][4][2];
#pragma unroll
    for (int a = 0; a < 2; ++a)
#pragma unroll
        for (int b = 0; b < 2; ++b)
#pragma unroll
            for (int m = 0; m < 4; ++m)
#pragma unroll
                for (int n = 0; n < 2; ++n) acc[a][b][m][n] = zero4();
    i32x8 At[4], B0[2], B1[2];
    const char* cA = (const char*)g.A + (size_t)cur.pm * tstep; const char* cB = (const char*)g.Bt + (size_t)cur.e * g.bexp + (size_t)cur.pn * tstep;
    PG8_STAGE(PG8_SB(0, 0), cB, voffB); PG8_STAGE(PG8_SB(0, 1), cB + hstep, voffB); PG8_STAGE(PG8_SA(0, 0), cA, voffA); PG8_STAGE(PG8_SA(0, 1), cA + hstep, voffA);
    if (wr == 1) PG8_BAR;
    PG8_WAIT_V(2); PG8_BAR;
    PG8_STAGE(PG8_SB(1, 0), cB + kstep, voffB); PG8_STAGE(PG8_SA(1, 0), cA + kstep, voffA); PG8_STAGE(PG8_SB(1, 1), cB + hstep + kstep, voffB);
    PG8_WAIT_V(6); PG8_BAR;
    for (;;) {
        const bool has_next = S.next(ui + 1, nxt);
        nxt.pm = __builtin_amdgcn_readfirstlane(nxt.pm); nxt.pn = __builtin_amdgcn_readfirstlane(nxt.pn); nxt.e = __builtin_amdgcn_readfirstlane(nxt.e);
        const char* nA = has_next ? (const char*)g.A + (size_t)nxt.pm * tstep : cA; const char* nB = has_next ? (const char*)g.Bt + (size_t)nxt.e * g.bexp + (size_t)nxt.pn * tstep : cB;
#pragma nounroll
        for (int t = 0; t < nt; t += 2) {
            const bool last = (t == nt - 2);
#if GEMM_OVL == 2
            if (last) { int ln2 = lane_id_v(); asm volatile("" : "+v"(ln2)); E.prefetch(cur, (unsigned)(size_t)lds + (unsigned)STAGE_BYTES + (unsigned)(ui & 1) * 2048u, wid, ln2); }
#endif
            const char* a1 = cA + (size_t)(t + 1) * kstep;
            const char* a2 = last ? nA : cA + (size_t)(t + 2) * kstep; const char* b2 = last ? nB : cB + (size_t)(t + 2) * kstep;
            const char* a3 = a2 + kstep; const char* b3 = b2 + kstep;
            const bool fw = (GEMM_FW != 0) && (t == 0) && (ui > 0);
            PG8_LDB(B0, 0, 0); PG8_LDB(B1, 0, 1); PG8_SCHED; PG8_LDA(At, 0, 0); PG8_STAGE(PG8_SA(1, 1), a1 + hstep, voffA);
            if (fw) PG8_WAITN(8 + 2 * Epi::NST); else PG8_WAIT_V(8);
            PG8_WAIT_L(0); PG8_BAR; PG8_MMA(0, 0, At, B0); PG8_MMA(0, 1, At, B1); PG8_BAR; PG8_SCHED;
            PG8_LDA(At, 0, 1); PG8_STAGE(PG8_SB(0, 0), b2, voffB); PG8_STAGE(PG8_SB(0, 1), b2 + hstep, voffB); PG8_STAGE(PG8_SA(0, 0), a2, voffA);
            if (fw) PG8_WAITN(8 + 2 * Epi::NST); else PG8_WAIT_V(8);
            PG8_WAIT_L(0); PG8_BAR; PG8_MMA(1, 0, At, B0); PG8_MMA(1, 1, At, B1); PG8_BAR; PG8_SCHED;
            PG8_LDB(B0, 1, 0); PG8_LDB(B1, 1, 1); PG8_SCHED; PG8_LDA(At, 1, 0); PG8_STAGE(PG8_SA(0, 1), a2 + hstep, voffA);
            PG8_WAIT_V(8); PG8_WAIT_L(0); PG8_BAR; PG8_MMA(0, 0, At, B0); PG8_MMA(0, 1, At, B1); PG8_BAR; PG8_SCHED;
            PG8_LDA(At, 1, 1); PG8_STAGE(PG8_SB(1, 0), b3, voffB); PG8_STAGE(PG8_SB(1, 1), b3 + hstep, voffB); PG8_STAGE(PG8_SA(1, 0), a3, voffA);
            PG8_WAIT_V(8); PG8_WAIT_L(0); PG8_BAR; PG8_MMA(1, 0, At, B0); PG8_MMA(1, 1, At, B1); PG8_BAR; PG8_SCHED;
        }
        if (wr == 0) PG8_BAR;
        { int ln2 = lane_id_v(); asm volatile("" : "+v"(ln2));
#if GEMM_OVL == 2
          E.template half<0>(acc, cur, wr, wc, ln2 & 15, ln2 >> 4, lds + STAGE_BYTES + (ui & 1) * 2048); E.template half<1>(acc, cur, wr, wc, ln2 & 15, ln2 >> 4, lds + STAGE_BYTES + (ui & 1) * 2048); }
#else
          E(acc, cur, wr, wc, ln2 & 15, ln2 >> 4); }
#endif
        if (!has_next) break;
#pragma unroll
        for (int a = 0; a < 2; ++a)
#pragma unroll
            for (int b = 0; b < 2; ++b)
#pragma unroll
                for (int m = 0; m < 4; ++m)
#pragma unroll
                    for (int n = 0; n < 2; ++n) acc[a][b][m][n] = zero4();
        cur = nxt; cA = nA; cB = nB; ++ui;
        if (wr == 1) PG8_BAR;
    }
    PG8_WAIT_V(0);
    PG8_BAR;
#endif
#undef PG8_WAITN
#undef PG8_SA
#undef PG8_SB
#undef PG8_STAGE
#undef PG8_LDA
#undef PG8_LDB
#undef PG8_MMA
#undef PG8_MMAZ
#undef PG8_WAIT_V
#undef PG8_WAIT_L
#undef PG8_BAR
#undef PG8_SCHED
}
}
#ifndef ATT_PRIO
#define ATT_PRIO 0
#endif
template <int NCB> __device__ __forceinline__ int v_st(int k, int c) { const int kk = (k & ~0xC) | ((k & 4) << 1) | ((k & 8) >> 1); return ((kk >> 3) * NCB + (c >> 5)) * 512 + ((kk & 7) * 32 + (c & 31)) * 2; }
__device__ __forceinline__ int v_rd_base(int lane) { return ((lane & 3) << 3) | (((lane >> 2) & 3) << 6) | (((lane >> 4) & 1) << 5) | (((lane >> 5) & 1) << 8); }
template <int OFF> __device__ __forceinline__ s16x4 tr_read(int vb) {
    s16x4 r; asm volatile("ds_read_b64_tr_b16 %0, %1 offset:%2" : "=&v"(r) : "v"(vb), "i"(OFF) : "memory"); return r;
}
#define VRO(ks, half) (((2 * (ks) + (half)) * NCB + D0) * 512)
#define PKV(L, H) (bf16x8){L[0], L[1], L[2], L[3], H[0], H[1], H[2], H[3]}
template <int NCB, int D0, int KS0, int NKS> __device__ __forceinline__ void pv_grp(f32x16& od, int vb, const bf16x8 (&pa)[NKS]) {
    static_assert(NKS == 2 || NKS == 4, "NKS");
    const s16x4 l0 = tr_read<VRO(KS0, 0)>(vb), h0 = tr_read<VRO(KS0, 1)>(vb), l1 = tr_read<VRO(KS0 + 1, 0)>(vb), h1 = tr_read<VRO(KS0 + 1, 1)>(vb);
    if constexpr (NKS == 4) {
        const s16x4 l2 = tr_read<VRO(KS0 + 2, 0)>(vb), h2 = tr_read<VRO(KS0 + 2, 1)>(vb), l3 = tr_read<VRO(KS0 + 3, 0)>(vb), h3 = tr_read<VRO(KS0 + 3, 1)>(vb);
        asm volatile("s_waitcnt lgkmcnt(0)" ::: "memory"); SBAR();
        od = __builtin_amdgcn_mfma_f32_32x32x16_bf16(pa[0], PKV(l0, h0), od, 0, 0, 0);
        od = __builtin_amdgcn_mfma_f32_32x32x16_bf16(pa[1], PKV(l1, h1), od, 0, 0, 0);
        od = __builtin_amdgcn_mfma_f32_32x32x16_bf16(pa[2], PKV(l2, h2), od, 0, 0, 0);
        od = __builtin_amdgcn_mfma_f32_32x32x16_bf16(pa[3], PKV(l3, h3), od, 0, 0, 0);
    } else {
        asm volatile("s_waitcnt lgkmcnt(0)" ::: "memory"); SBAR();
        od = __builtin_amdgcn_mfma_f32_32x32x16_bf16(pa[0], PKV(l0, h0), od, 0, 0, 0);
        od = __builtin_amdgcn_mfma_f32_32x32x16_bf16(pa[1], PKV(l1, h1), od, 0, 0, 0);
    }
}
#undef VRO
#undef PKV
struct AttnNA { int krow0, rq, r0, cq, c0; const float* rpb; };

template <int DQK, int DV, bool NA, int NB32, int HF>
__device__ __forceinline__ void attn_step(const char* Ks, int vb, const bf16x8 (&qr)[DQK / 16], f32x16 (&o)[DV / 32], float& m_reg, float& l_reg, float* al_l,
                                          float C, float thr, bool win_tile, int rowpart, int c0, const float* rpb, int r32, int hi) {
    constexpr int NCB = DV / 32, NQ = DQK / 16, KRS = DQK * 2;
    f32x16 p[NB32];
#pragma unroll
    for (int j = 0; j < NB32; ++j) p[j] = (f32x16){0};
#pragma unroll
    for (int d0 = 0; d0 < NQ; ++d0) { const int cb = (d0 * 16 + hi * 8) * 2;
#pragma unroll
        for (int j = 0; j < NB32; ++j) { const bf16x8 kf = *(const bf16x8*)(Ks + (32 * (NB32 * HF + j) + r32) * KRS + (cb ^ ((r32 & 7) << 4)));
            p[j] = __builtin_amdgcn_mfma_f32_32x32x16_bf16(kf, qr[d0], p[j], 0, 0, 0); }
        if constexpr (NQ > 8) { if ((d0 & 3) == 3) SBAR(); } }
    if constexpr (NA) {
        if (win_tile) {
#pragma unroll
            for (int j = 0; j < NB32; ++j)
#pragma unroll
                for (int r = 0; r < 16; ++r) { const int kc = 32 * (NB32 * HF + j) + crow(r, hi); const bool v0 = (unsigned)(kc - c0) < 16u;
                    const float b0 = rpb[v0 ? rowpart + kc : 0]; p[j][r] = v0 ? p[j][r] + b0 : -1e30f; }
        }
    }
    float pmax = p[0][0];
#pragma unroll
    for (int j = 0; j < NB32; ++j)
#pragma unroll
        for (int r = 0; r < 16; ++r) pmax = fmaxf(pmax, p[j][r]);
    { auto rr = __builtin_amdgcn_permlane32_swap(__float_as_uint(pmax), __float_as_uint(pmax), false, false); pmax = fmaxf(__uint_as_float(rr[0]), __uint_as_float(rr[1])); }
    float mn, alpha;
    if (__all(pmax - m_reg <= thr)) { mn = m_reg; alpha = 1.f; }
    else { mn = fmaxf(m_reg, pmax); alpha = __builtin_amdgcn_exp2f((m_reg - mn) * C); m_reg = mn; }
    const float mnC = -mn * C;
    float ps = 0.f;
#pragma unroll
    for (int j = 0; j < NB32; ++j)
#pragma unroll
        for (int r = 0; r < 16; ++r) { p[j][r] = __builtin_amdgcn_exp2f(fmaf(p[j][r], C, mnC)); ps += p[j][r]; }
    { auto rr = __builtin_amdgcn_permlane32_swap(__float_as_uint(ps), __float_as_uint(ps), false, false); ps = __uint_as_float(rr[0]) + __uint_as_float(rr[1]); }
    l_reg = l_reg * alpha + ps;
    if (__any(alpha < 1.f)) { if (hi == 0) al_l[r32] = alpha; asm volatile("s_waitcnt lgkmcnt(0)" ::: "memory");
#pragma unroll
        for (int r = 0; r < 16; ++r) { const float a_ = al_l[crow(r, hi)];
#pragma unroll
            for (int d = 0; d < NCB; ++d) o[d][r] *= a_; } }
    bf16x8 pa[2 * NB32];
#define PK4(P, BASE, OUT) do { unsigned a0 = pk2(P[BASE + 0], P[BASE + 1]), a1 = pk2(P[BASE + 2], P[BASE + 3]);   \
    unsigned b0_ = pk2(P[BASE + 4], P[BASE + 5]), b1_ = pk2(P[BASE + 6], P[BASE + 7]);                              \
    auto r0_ = __builtin_amdgcn_permlane32_swap(a0, b0_, false, false); auto r1_ = __builtin_amdgcn_permlane32_swap(a1, b1_, false, false); \
    u32x4 w_ = {r0_[0], r1_[0], r0_[1], r1_[1]}; OUT = *reinterpret_cast<bf16x8*>(&w_); } while (0)
#pragma unroll
    for (int j = 0; j < NB32; ++j) { PK4(p[j], 0, pa[2 * j]); PK4(p[j], 8, pa[2 * j + 1]); }
#undef PK4
    pv_grp<NCB, 0, 2 * NB32 * HF, 2 * NB32>(o[0], vb, pa);
    pv_grp<NCB, 1, 2 * NB32 * HF, 2 * NB32>(o[1], vb, pa);
    if constexpr (NCB == 4) { pv_grp<NCB, 2, 2 * NB32 * HF, 2 * NB32>(o[2], vb, pa); pv_grp<NCB, 3, 2 * NB32 * HF, 2 * NB32>(o[3], vb, pa); }
}

template <int DQK, int DV, bool NA, int NB32>
__device__ __forceinline__ void attn_unit(const bf16* __restrict__ Qb, const bf16* __restrict__ Kh, const bf16* __restrict__ Vh, int n1, int base1, int base2, int ntiles,
                                          bf16* __restrict__ Ob, char* lds, float C, float thr, const AttnNA na, const int wid_in) {
    const int wid = __builtin_amdgcn_readfirstlane(wid_in);
    constexpr int NCB = DV / 32, NQ = DQK / 16, KCH = DQK / 64, VCH = DV / 64, KTB = 64 * DQK * 2, VTB = 64 * DV * 2, KRS = DQK * 2;
    int lane = lane_id_v(); asm volatile("" : "+v"(lane));
    const int tid = wid * 64 + lane, r32 = lane & 31, hi = lane >> 5;
    char* K_lds = lds; char* V_lds = lds + 2 * KTB;
    float* wsf = (float*)(lds + 2 * KTB + 2 * VTB) + wid * 64; float* li_l = wsf; float* al_l = wsf + 32;
    float m_reg = -1e30f, l_reg = 0.f; f32x16 o[NCB];
#pragma unroll
    for (int d = 0; d < NCB; ++d) o[d] = (f32x16){0};
    bf16x8 qr[NQ];
    { const char* Qc = (const char*)Qb; const unsigned qoff = (unsigned)((wid * 32 + r32) * DQK + hi * 8) * 2u;
#pragma unroll
      for (int d0 = 0; d0 < NQ; ++d0) qr[d0] = *(const bf16x8*)(Qc + qoff + d0 * 32); }
    const int vb0 = (int)(uintptr_t)V_lds + v_rd_base(lane);
    bf16x8 kstA[KCH], vstA[VCH], kstB[KCH], vstB[VCH];
    unsigned koff[KCH], voff[VCH];
#pragma unroll
    for (int i = 0; i < KCH; ++i) { const int id = tid + i * 512; koff[i] = (unsigned)((id / (DQK / 8)) * DQK + (id % (DQK / 8)) * 8) * 2u; }
#pragma unroll
    for (int i = 0; i < VCH; ++i) { const int id = tid + i * 512; voff[i] = (unsigned)((id / (DV / 8)) * DV + (id % (DV / 8)) * 8) * 2u; }
#define ATT_LOAD(KS, VS, t) do { const int _t = (t); const int key0 = __builtin_amdgcn_readfirstlane(_t < n1 ? base1 + _t * 64 : base2 + (_t - n1) * 64); \
    const char* kt_ = (const char*)Kh + (size_t)key0 * (DQK * 2); const char* vt_ = (const char*)Vh + (size_t)key0 * (DV * 2); \
    _Pragma("unroll") for (int i = 0; i < KCH; ++i) KS[i] = *(const bf16x8*)(kt_ + koff[i]); \
    _Pragma("unroll") for (int i = 0; i < VCH; ++i) VS[i] = *(const bf16x8*)(vt_ + voff[i]); } while (0)
#define ATT_WRITE(KS, VS, b) do { \
    _Pragma("unroll") for (int i = 0; i < KCH; ++i) { const int id = tid + i * 512, kr_ = id / (DQK / 8), kc_ = (id % (DQK / 8)) * 16; *(bf16x8*)(K_lds + (b) * KTB + kr_ * KRS + (kc_ ^ ((kr_ & 7) << 4))) = KS[i]; } \
    _Pragma("unroll") for (int i = 0; i < VCH; ++i) { const int id = tid + i * 512; *(bf16x8*)(V_lds + (b) * VTB + v_st<NCB>(id / (DV / 8), (id % (DV / 8)) * 8)) = VS[i]; } } while (0)
#define ATT_BODY(t_, bsel_) do { const int tq_ = (t_); \
        bool act = true; bool win_tile = false; int rowpart = 0; \
        if constexpr (NA) { win_tile = tq_ < n1; act = !win_tile || ((unsigned)(na.krow0 + tq_ - na.r0) < 8u); rowpart = (na.krow0 + tq_ - na.rq + 7) * 31 + 15 - na.cq; } \
        if (act) { \
            const char* Ks = K_lds + (bsel_) * KTB; const int vb = vb0 + (bsel_) * VTB; \
            attn_step<DQK, DV, NA, NB32, 0>(Ks, vb, qr, o, m_reg, l_reg, al_l, C, thr, win_tile, rowpart, na.c0, na.rpb, r32, hi); \
            if constexpr (NB32 == 1) attn_step<DQK, DV, NA, NB32, 1>(Ks, vb, qr, o, m_reg, l_reg, al_l, C, thr, win_tile, rowpart, na.c0, na.rpb, r32, hi); \
        } } while (0)
    ATT_LOAD(kstA, vstA, 0);
    if (ntiles > 1) ATT_LOAD(kstB, vstB, 1);
    for (int t = 0; t < ntiles; t += 2) {
        ATT_WRITE(kstA, vstA, 0);
        __syncthreads();
        if (t + 2 < ntiles) ATT_LOAD(kstA, vstA, t + 2);
        ATT_BODY(t, 0);
        if (t + 1 < ntiles) {
            ATT_WRITE(kstB, vstB, 1);
            __syncthreads();
            if (t + 3 < ntiles) ATT_LOAD(kstB, vstB, t + 3);
            ATT_BODY(t + 1, 1);
        }
    }
#undef ATT_BODY
#undef ATT_LOAD
#undef ATT_WRITE
    if (hi == 0) li_l[r32] = l_reg;
    asm volatile("s_waitcnt lgkmcnt(0)" ::: "memory");
    bf16* Ow = Ob + (size_t)(wid * 32) * DM;
#pragma unroll
    for (int r = 0; r < 16; ++r) { const int orow = crow(r, hi); const float rl = __builtin_amdgcn_rcpf(li_l[orow]);
#pragma unroll
        for (int d0 = 0; d0 < NCB; ++d0) Ow[(size_t)orow * DM + d0 * 32 + r32] = (bf16)f2bf(o[d0][r] * rl); }
    __syncthreads();
}

constexpr int TSTR = 272, TBYTES = 128 * TSTR;
__device__ __forceinline__ int toff(int r, int cb) { return r * TSTR + cb; }
__device__ __forceinline__ void mm128(const char* At, const char* Bt, f32x16& c0, f32x16& c1, int mb, int nb0, int r32, int hi) {
#pragma unroll
    for (int kk = 0; kk < 8; ++kk) { const int cb = (kk * 16 + hi * 8) * 2;
        const bf16x8 a = *(const bf16x8*)(At + toff(mb * 32 + r32, cb));
        const bf16x8 b0 = *(const bf16x8*)(Bt + toff(nb0 * 32 + r32, cb));
        const bf16x8 b1 = *(const bf16x8*)(Bt + toff(nb0 * 32 + 32 + r32, cb));
        c0 = __builtin_amdgcn_mfma_f32_32x32x16_bf16(a, b0, c0, 0, 0, 0);
        c1 = __builtin_amdgcn_mfma_f32_32x32x16_bf16(a, b1, c1, 0, 0, 0); }
}
__device__ __forceinline__ void stage_nat(const bf16* src, char* T, int tid) {
#pragma unroll
    for (int i = 0; i < 4; ++i) { const int id = tid + i * 512, row = id >> 4, c8 = id & 15; *(u32x4*)(T + toff(row, c8 * 16)) = *(const u32x4*)(src + (size_t)row * 128 + c8 * 8); }
}
__device__ __forceinline__ int ret_chunk_pos(int c) { return c < 128 ? c * 128 : SEQ + (c - 128) * 128; }

#ifndef ATT_DBG_2XK
#define ATT_DBG_2XK 0
#endif
#ifndef ATT_DBG_SYNC
#define ATT_DBG_SYNC 0
#endif
#ifndef ATT_DBG_REGSTAGE
#define ATT_DBG_REGSTAGE 0
#endif
#define VRO(ks, half) (((2 * (ks) + (half)) * NCB + D0) * 512)
#define PKV(L, H) (bf16x8){L[0], L[1], L[2], L[3], H[0], H[1], H[2], H[3]}
template <int NCB, int D0, int KS0, int NKS> __device__ __forceinline__ void pvT_grp(f32x16& od, int vb, const bf16x8 (&pb)[NKS]) {
    static_assert(NKS == 2 || NKS == 4, "NKS");
    const s16x4 l0 = tr_read<VRO(KS0, 0)>(vb), h0 = tr_read<VRO(KS0, 1)>(vb), l1 = tr_read<VRO(KS0 + 1, 0)>(vb), h1 = tr_read<VRO(KS0 + 1, 1)>(vb);
    if constexpr (NKS == 4) {
        const s16x4 l2 = tr_read<VRO(KS0 + 2, 0)>(vb), h2 = tr_read<VRO(KS0 + 2, 1)>(vb), l3 = tr_read<VRO(KS0 + 3, 0)>(vb), h3 = tr_read<VRO(KS0 + 3, 1)>(vb);
        asm volatile("s_waitcnt lgkmcnt(0)" ::: "memory"); SBAR();
        od = __builtin_amdgcn_mfma_f32_32x32x16_bf16(PKV(l0, h0), pb[0], od, 0, 0, 0);
        od = __builtin_amdgcn_mfma_f32_32x32x16_bf16(PKV(l1, h1), pb[1], od, 0, 0, 0);
        od = __builtin_amdgcn_mfma_f32_32x32x16_bf16(PKV(l2, h2), pb[2], od, 0, 0, 0);
        od = __builtin_amdgcn_mfma_f32_32x32x16_bf16(PKV(l3, h3), pb[3], od, 0, 0, 0);
    } else {
        asm volatile("s_waitcnt lgkmcnt(0)" ::: "memory"); SBAR();
        od = __builtin_amdgcn_mfma_f32_32x32x16_bf16(PKV(l0, h0), pb[0], od, 0, 0, 0);
        od = __builtin_amdgcn_mfma_f32_32x32x16_bf16(PKV(l1, h1), pb[1], od, 0, 0, 0);
    }
}
#undef VRO
#undef PKV
template <int NCB, int D0, int KS0, int NKS> __device__ __forceinline__ void pvT_rd(s16x4 (&f)[2 * NKS], int vb) {
#define VRO(ks, half) (((2 * (ks) + (half)) * NCB + D0) * 512)
    f[0] = tr_read<VRO(KS0, 0)>(vb); f[1] = tr_read<VRO(KS0, 1)>(vb); f[2] = tr_read<VRO(KS0 + 1, 0)>(vb); f[3] = tr_read<VRO(KS0 + 1, 1)>(vb);
    if constexpr (NKS == 4) { f[4] = tr_read<VRO(KS0 + 2, 0)>(vb); f[5] = tr_read<VRO(KS0 + 2, 1)>(vb); f[6] = tr_read<VRO(KS0 + 3, 0)>(vb); f[7] = tr_read<VRO(KS0 + 3, 1)>(vb); }
#undef VRO
}
template <int NKS> __device__ __forceinline__ void pvT_mm(f32x16& od, const s16x4 (&f)[2 * NKS], const bf16x8 (&pb)[NKS]) {
#define PKV(L, H) (bf16x8){L[0], L[1], L[2], L[3], H[0], H[1], H[2], H[3]}
    od = __builtin_amdgcn_mfma_f32_32x32x16_bf16(PKV(f[0], f[1]), pb[0], od, 0, 0, 0);
    od = __builtin_amdgcn_mfma_f32_32x32x16_bf16(PKV(f[2], f[3]), pb[1], od, 0, 0, 0);
    if constexpr (NKS == 4) { od = __builtin_amdgcn_mfma_f32_32x32x16_bf16(PKV(f[4], f[5]), pb[2], od, 0, 0, 0); od = __builtin_amdgcn_mfma_f32_32x32x16_bf16(PKV(f[6], f[7]), pb[3], od, 0, 0, 0); }
#undef PKV
}
template <int NCB, int KS0, int NKS> __device__ __forceinline__ void pvT_all(f32x16 (&o)[NCB], int vb, const bf16x8 (&pb)[NKS]) {
    static_assert((NCB == 2 || NCB == 4) && (NKS == 2 || NKS == 4), "pvT_all");
    s16x4 fa[2 * NKS], fb[2 * NKS];
    pvT_rd<NCB, 0, KS0, NKS>(fa, vb);
    pvT_rd<NCB, 1, KS0, NKS>(fb, vb);
    if constexpr (NKS == 4) asm volatile("s_waitcnt lgkmcnt(8)" ::: "memory"); else asm volatile("s_waitcnt lgkmcnt(4)" ::: "memory");
    SBAR(); pvT_mm<NKS>(o[0], fa, pb); SBAR();
    if constexpr (NCB == 4) {
        pvT_rd<NCB, 2, KS0, NKS>(fa, vb);
        if constexpr (NKS == 4) asm volatile("s_waitcnt lgkmcnt(8)" ::: "memory"); else asm volatile("s_waitcnt lgkmcnt(4)" ::: "memory");
        SBAR(); pvT_mm<NKS>(o[1], fb, pb); SBAR();
        pvT_rd<NCB, 3, KS0, NKS>(fb, vb);
        if constexpr (NKS == 4) asm volatile("s_waitcnt lgkmcnt(8)" ::: "memory"); else asm volatile("s_waitcnt lgkmcnt(4)" ::: "memory");
        SBAR(); pvT_mm<NKS>(o[2], fa, pb); SBAR();
        asm volatile("s_waitcnt lgkmcnt(0)" ::: "memory");
        SBAR(); pvT_mm<NKS>(o[3], fb, pb);
    } else {
        asm volatile("s_waitcnt lgkmcnt(0)" ::: "memory");
        SBAR(); pvT_mm<NKS>(o[1], fb, pb);
    }
}
#ifndef PV_PIPE
#define PV_PIPE 0
#endif
#if PV_PIPE
#define PVT_CALL(KS0_, NKS_) pvT_all<NCB, KS0_, NKS_>(o, vb, pa)
#else
#define PVT_CALL(KS0_, NKS_) do { pvT_grp<NCB, 0, KS0_, NKS_>(o[0], vb, pa); pvT_grp<NCB, 1, KS0_, NKS_>(o[1], vb, pa); \
    if constexpr (NCB == 4) { pvT_grp<NCB, 2, KS0_, NKS_>(o[2], vb, pa); pvT_grp<NCB, 3, KS0_, NKS_>(o[3], vb, pa); } } while (0)
#endif
template <int DQK, int DV, int NB32, bool LONES, int RING = 3, bool PING = false, bool PRESC = false>
__device__ __forceinline__ void attn_dense2(const bf16* __restrict__ Qb, const bf16* __restrict__ Kh, const bf16* __restrict__ Vh, int key_base, int ntiles,
                                            bf16* __restrict__ Ob, char* lds, float C, float MC, const int wid_in) {
    constexpr int NCB = DV / 32, NQ = DQK / 16, KCH = DQK / 64, VCH = DV / 64, KTB = 64 * DQK * 2, VTB = 64 * DV * 2, KRS = DQK * 2, SLOT = KTB + VTB;
    static_assert(RING * SLOT + 2048 <= RING_BYTES && (!PING || (RING == 4 && NB32 == 2)), "attention ring");
    const int wid = __builtin_amdgcn_readfirstlane(wid_in);
    int lane = lane_id_v(); asm volatile("" : "+v"(lane));
    const int r32 = lane & 31, hi = lane >> 5;
    float* wsf = (float*)(lds + RING * SLOT) + wid * 64; float* li_l = wsf;
    f32x16 o[NCB];
#pragma unroll
    for (int d = 0; d < NCB; ++d) o[d] = (f32x16){0};
    f32x16 ol = (f32x16){0}; float l_part = 0.f;
    bf16x8 qr[NQ];
    { const char* Qc = (const char*)Qb; const unsigned qoff = (unsigned)((wid * 32 + r32) * DQK + hi * 8) * 2u;
#pragma unroll
      for (int d0 = 0; d0 < NQ; ++d0) qr[d0] = *(const bf16x8*)(Qc + qoff + d0 * 32); }
    unsigned ksrc[KCH], vsrc[VCH];
#pragma unroll
    for (int i = 0; i < KCH; ++i) { const int j = (i * 8 + wid) * 64 + lane, row = j / (DQK / 8), cp = j % (DQK / 8), c = cp ^ (row & 7); ksrc[i] = (unsigned)(row * KRS + c * 16); }
#pragma unroll
    for (int i = 0; i < VCH; ++i) { const int j = (i * 8 + wid) * 64 + lane, st = j >> 5, q = j & 31, kk = (st / NCB) * 8 + (q >> 2), cc = (st % NCB) * 32 + (q & 3) * 8;
        vsrc[i] = (unsigned)(kk * DV * 2 + cc * 2); }
    const unsigned ldsb = (unsigned)(uintptr_t)lds;
#if ATT_DBG_REGSTAGE
#define AD_DMA(t) do { const int t_ = (t); char* sp_ = lds + (t_ % RING) * SLOT; const size_t k0_ = (size_t)(key_base + t_ * 64); \
    _Pragma("unroll") for (int i = 0; i < KCH; ++i) *(u32x4*)(sp_ + (i * 8 + wid) * 1024 + lane * 16) = *(const u32x4*)((const char*)Kh + k0_ * KRS + ksrc[i]); \
    _Pragma("unroll") for (int i = 0; i < VCH; ++i) *(u32x4*)(sp_ + KTB + (i * 8 + wid) * 1024 + lane * 16) = *(const u32x4*)((const char*)Vh + k0_ * (DV * 2) + vsrc[i]); } while (0)
#else
#define AD_DMA(t) do { const int t_ = (t); const unsigned sb_ = ldsb + (unsigned)(t_ % RING) * SLOT; const size_t k0_ = (size_t)(key_base + t_ * 64); \
    _Pragma("unroll") for (int i = 0; i < KCH; ++i) pg8::glds16((const char*)Kh + k0_ * KRS, ksrc[i], sb_ + (unsigned)((i * 8 + wid) * 1024)); \
    _Pragma("unroll") for (int i = 0; i < VCH; ++i) pg8::glds16((const char*)Vh + k0_ * (DV * 2), vsrc[i], sb_ + KTB + (unsigned)((i * 8 + wid) * 1024)); } while (0)
#endif
    const int vbl = (int)ldsb + KTB + v_rd_base(lane);
    bf16x8 ones8;
    { u32x4 ow_; asm volatile("v_mov_b32 %0, 0x3f803f80\n\tv_mov_b32 %1, 0x3f803f80\n\tv_mov_b32 %2, 0x3f803f80\n\tv_mov_b32 %3, 0x3f803f80" : "=v"(ow_.x), "=v"(ow_.y), "=v"(ow_.z), "=v"(ow_.w)); ones8 = *reinterpret_cast<bf16x8*>(&ow_); }
#define AD_QK(P, Ks, KB) do { _Pragma("unroll") for (int d0 = 0; d0 < NQ; ++d0) { const int cb = (d0 * 16 + hi * 8) * 2; \
        const bf16x8 kf = *(const bf16x8*)((Ks) + (32 * (KB) + r32) * KRS + (cb ^ ((r32 & 7) << 4))); \
        if (ATT_DBG_2XK && DQK == 64) { const bf16x8 kf2 = *(const volatile bf16x8*)((Ks) + (32 * (KB) + r32) * KRS + ((cb ^ 16) ^ ((r32 & 7) << 4))); asm volatile("" :: "v"(kf2)); } \
        P = __builtin_amdgcn_mfma_f32_32x32x16_bf16(kf, qr[d0], P, 0, 0, 0); if constexpr (NQ > 8) { if ((d0 & 3) == 3) SBAR(); } } } while (0)
#define AD_PK4(P, BASE, OUT) do { u32x4 w_ = {pk2(P[BASE + 0], P[BASE + 1]), pk2(P[BASE + 2], P[BASE + 3]), pk2(P[BASE + 4], P[BASE + 5]), pk2(P[BASE + 6], P[BASE + 7])}; \
    OUT = *reinterpret_cast<bf16x8*>(&w_); } while (0)
#define AD_SM(P, PA0, PA1) do { _Pragma("unroll") for (int r = 0; r < 16; ++r) { P[r] = PRESC ? __builtin_amdgcn_exp2f(P[r]) : __builtin_amdgcn_exp2f(fmaf(P[r], C, -MC)); if constexpr (!LONES) l_part += P[r]; } \
        AD_PK4(P, 0, PA0); AD_PK4(P, 8, PA1); } while (0)
    AD_DMA(0); if (ntiles > 1) AD_DMA(1);
    asm volatile("s_waitcnt vmcnt(0)" ::: "memory"); __syncthreads();
    if (ntiles > 2) AD_DMA(2);
    f32x16 negm;
#pragma unroll
    for (int r = 0; r < 16; ++r) negm[r] = PRESC ? -MC : 0.f;
    f32x16 sA = negm, sB = negm;
    { const char* Ks0 = lds; AD_QK(sA, Ks0, 0); if constexpr (NB32 == 2) AD_QK(sB, Ks0, 1); }
    if (PING && wid >= 4) {
        bf16x8 pa[4];
        for (int t = 0; t < ntiles; ++t) {
            const int pslot = (t + RING - 1) % RING, nslot = (t + 1) % RING; const bool more = t + 1 < ntiles;
            if (t > 0) { asm volatile("s_waitcnt vmcnt(0)" ::: "memory"); __syncthreads(); if (t + 2 < ntiles) AD_DMA(t + 2); }
            if (t > 0) { const int vb = vbl + pslot * SLOT;
                PVT_CALL(0, 4);
                if constexpr (LONES) {
#pragma unroll
                    for (int ks = 0; ks < 4; ++ks) ol = __builtin_amdgcn_mfma_f32_32x32x16_bf16(ones8, pa[ks], ol, 0, 0, 0); } }
            const char* Kn = lds + nslot * SLOT;
            f32x16 nA = negm, nB = negm;
            if (more) { AD_QK(nA, Kn, 0); AD_QK(nB, Kn, 1); }
            AD_SM(sA, pa[0], pa[1]); AD_SM(sB, pa[2], pa[3]);
            sA = nA; sB = nB;
        }
        { const int vb = vbl + ((ntiles - 1) % RING) * SLOT;
          PVT_CALL(0, 4);
          if constexpr (LONES) {
#pragma unroll
              for (int ks = 0; ks < 4; ++ks) ol = __builtin_amdgcn_mfma_f32_32x32x16_bf16(ones8, pa[ks], ol, 0, 0, 0); } }
    } else
    for (int t = 0; t < ntiles; ++t) {
        const int slot = t % RING, nslot = (t + 1) % RING; const bool more = t + 1 < ntiles;
        if (t > 0) { asm volatile("s_waitcnt vmcnt(0)" ::: "memory"); __syncthreads(); if (t + 2 < ntiles) AD_DMA(t + 2); }
        const char* Ks = lds + slot * SLOT; const char* Kn = lds + nslot * SLOT; const int vb = vbl + slot * SLOT;
        if constexpr (NB32 == 2) {
            f32x16 nA = negm, nB = negm;
            if (more) { AD_QK(nA, Kn, 0); AD_QK(nB, Kn, 1); }
            bf16x8 pa[4];
            AD_SM(sA, pa[0], pa[1]); AD_SM(sB, pa[2], pa[3]);
            PVT_CALL(0, 4);
            if constexpr (LONES) {
#pragma unroll
                for (int ks = 0; ks < 4; ++ks) ol = __builtin_amdgcn_mfma_f32_32x32x16_bf16(ones8, pa[ks], ol, 0, 0, 0); }
            sA = nA; sB = nB;
#if ATT_DBG_SYNC
            asm volatile("s_waitcnt vmcnt(0) lgkmcnt(0)" ::: "memory"); __syncthreads();
#endif
        } else {
            { f32x16 n1 = negm; AD_QK(n1, Ks, 1);
              bf16x8 pa[2]; AD_SM(sA, pa[0], pa[1]);
              PVT_CALL(0, 2);
              if constexpr (LONES) { ol = __builtin_amdgcn_mfma_f32_32x32x16_bf16(ones8, pa[0], ol, 0, 0, 0); ol = __builtin_amdgcn_mfma_f32_32x32x16_bf16(ones8, pa[1], ol, 0, 0, 0); }
              sB = n1; }
            { f32x16 n0 = negm; if (more) AD_QK(n0, Kn, 0);
              bf16x8 pa[2]; AD_SM(sB, pa[0], pa[1]);
              PVT_CALL(2, 2);
              if constexpr (LONES) { ol = __builtin_amdgcn_mfma_f32_32x32x16_bf16(ones8, pa[0], ol, 0, 0, 0); ol = __builtin_amdgcn_mfma_f32_32x32x16_bf16(ones8, pa[1], ol, 0, 0, 0); }
              sA = n0; }
        }
    }
#undef AD_DMA
#undef AD_QK
#undef AD_PK4
#undef AD_SM
    float rl;
    if constexpr (LONES) rl = __builtin_amdgcn_rcpf(ol[0]);
    else { auto rr = __builtin_amdgcn_permlane32_swap(__float_as_uint(l_part), __float_as_uint(l_part), false, false); rl = __builtin_amdgcn_rcpf(__uint_as_float(rr[0]) + __uint_as_float(rr[1])); }
    bf16* Ow = Ob + (size_t)(wid * 32 + r32) * DM + 8 * hi;
#pragma unroll
    for (int d0 = 0; d0 < NCB; ++d0)
#pragma unroll
        for (int q = 0; q < 2; ++q) { u32x2 wa, wb;
            wa.x = pk2(o[d0][8 * q] * rl, o[d0][8 * q + 1] * rl); wa.y = pk2(o[d0][8 * q + 2] * rl, o[d0][8 * q + 3] * rl);
            wb.x = pk2(o[d0][8 * q + 4] * rl, o[d0][8 * q + 5] * rl); wb.y = pk2(o[d0][8 * q + 6] * rl, o[d0][8 * q + 7] * rl);
            const auto sx = __builtin_amdgcn_permlane32_swap(wa.x, wb.x, false, false), sy = __builtin_amdgcn_permlane32_swap(wa.y, wb.y, false, false);
            u32x4 w4; w4.x = sx[0]; w4.y = sy[0]; w4.z = sx[1]; w4.w = sy[1];
            *(u32x4*)(Ow + d0 * 32 + 16 * q) = w4; }
    __syncthreads();
}

__device__ __forceinline__ void attn_gqa128(const unsigned char* __restrict__ Qb, const unsigned char* __restrict__ Kh, const unsigned char* __restrict__ VTh, int key_base, int ntiles64,
                                            bf16* __restrict__ Ob, char* lds, float MC, const int wid_in) {
    constexpr int NCB = 2, KTB = 4096, VTB = 4096, KRS = 64, SLOTB = 2 * KTB + 2 * VTB, RING = 4;
    static_assert(RING * SLOTB <= RING_BYTES, "gqa ring");
    const int wid = __builtin_amdgcn_readfirstlane(wid_in);
    int lane = lane_id_v(); asm volatile("" : "+v"(lane));
    const int r32 = lane & 31, hi = lane >> 5;
    f32x16 o[NCB]; o[0] = (f32x16){0}; o[1] = (f32x16){0};
    f32x16 ol = (f32x16){0};
    i32x8 q8;
    { const char* Qc = (const char*)Qb; const unsigned qoff = (unsigned)((wid * 32 + r32) * 64 + hi * 32);
      const i32x4 lo_ = *(const i32x4*)(Qc + qoff), hi_ = *(const i32x4*)(Qc + qoff + 16); q8 = __builtin_shufflevector(lo_, hi_, 0, 1, 2, 3, 4, 5, 6, 7); }
    unsigned ksrc, vsrc;
    { const int j = wid * 64 + lane, sub = j >> 8, jj = j & 255, row = jj >> 2, cp = jj & 3, c = cp ^ ((row >> 2) & 3);
      ksrc = (unsigned)((sub * 64 + row) * KRS + c * 16); vsrc = (unsigned)(row * SP + sub * 64 + c * 16); }
    const unsigned ldsb = (unsigned)(uintptr_t)lds;
#define G_DMA(T) do { const int T_ = (T); const unsigned sb_ = ldsb + (unsigned)(T_ % RING) * SLOTB + (unsigned)wid * 1024u; const size_t k0_ = (size_t)(key_base + T_ * 128); \
    pg8::glds16((const char*)Kh + k0_ * KRS, ksrc, sb_); pg8::glds16((const char*)VTh + k0_, vsrc, sb_ + 2 * KTB); } while (0)
    i32x8 ones8;
    { i32x4 ow_; asm volatile("v_mov_b32 %0, 0x38383838\n\tv_mov_b32 %1, 0x38383838\n\tv_mov_b32 %2, 0x38383838\n\tv_mov_b32 %3, 0x38383838" : "=v"(ow_.x), "=v"(ow_.y), "=v"(ow_.z), "=v"(ow_.w)); ones8 = __builtin_shufflevector(ow_, ow_, 0, 1, 2, 3, 4, 5, 6, 7); }
    f32x16 negm;
#pragma unroll
    for (int r = 0; r < 16; ++r) negm[r] = 8.0f - MC;
#define G_FRAG(OUT, Ts, BLK) do { const int row_ = 32 * (BLK) + r32, sw_ = (row_ >> 2) & 3; const char* rp_ = (Ts) + row_ * 64; \
        const i32x4 lo_ = *(const i32x4*)(rp_ + (((2 * hi) ^ sw_) << 4)), hi_ = *(const i32x4*)(rp_ + (((2 * hi + 1) ^ sw_) << 4)); \
        OUT = __builtin_shufflevector(lo_, hi_, 0, 1, 2, 3, 4, 5, 6, 7); } while (0)
#define G_QK(P, Ks, KB) do { i32x8 kf_; G_FRAG(kf_, Ks, KB); P = __builtin_amdgcn_mfma_scale_f32_32x32x64_f8f6f4(kf_, q8, negm, 0, 0, 0, 0x7F7F7F7F, 0, 0x7C7C7C7C); } while (0)
#define G_SM(PA, PB, P8) do { _Pragma("unroll") for (int r = 0; r < 16; ++r) { PA[r] = __builtin_amdgcn_exp2f(PA[r]); PB[r] = __builtin_amdgcn_exp2f(PB[r]); } \
        P8 = (i32x8){(int)pg8::pk4_bf8(PA[0], PA[1], PA[2], PA[3]), (int)pg8::pk4_bf8(PA[4], PA[5], PA[6], PA[7]), (int)pg8::pk4_bf8(PA[8], PA[9], PA[10], PA[11]), (int)pg8::pk4_bf8(PA[12], PA[13], PA[14], PA[15]), \
                      (int)pg8::pk4_bf8(PB[0], PB[1], PB[2], PB[3]), (int)pg8::pk4_bf8(PB[4], PB[5], PB[6], PB[7]), (int)pg8::pk4_bf8(PB[8], PB[9], PB[10], PB[11]), (int)pg8::pk4_bf8(PB[12], PB[13], PB[14], PB[15])}; } while (0)
#define G_PV(Vs) do { i32x8 v0_, v1_; G_FRAG(v0_, Vs, 0); G_FRAG(v1_, Vs, 1); if (ATT_PRIO == 2) __builtin_amdgcn_s_setprio(1); \
        o[0] = __builtin_amdgcn_mfma_scale_f32_32x32x64_f8f6f4(v0_, p8, o[0], 0, 1, 0, 0x7F7F7F7F, 0, 0x7F7F7F7F); \
        o[1] = __builtin_amdgcn_mfma_scale_f32_32x32x64_f8f6f4(v1_, p8, o[1], 0, 1, 0, 0x7F7F7F7F, 0, 0x7F7F7F7F); \
        ol = __builtin_amdgcn_mfma_scale_f32_32x32x64_f8f6f4(ones8, p8, ol, 0, 1, 0, 0x7F7F7F7F, 0, 0x7F7F7F7F); if (ATT_PRIO == 2) __builtin_amdgcn_s_setprio(0); } while (0)
#define G_KA(s) (lds + (((s) >> 1) % RING) * SLOTB + ((s) & 1) * KTB)
#define G_VA(s) (lds + (((s) >> 1) % RING) * SLOTB + 2 * KTB + ((s) & 1) * VTB)
    const int NT = ntiles64 >> 1;
    G_DMA(0); if (NT > 1) G_DMA(1);
    asm volatile("s_waitcnt vmcnt(0)" ::: "memory"); __syncthreads();
    if (NT > 2) G_DMA(2);
    f32x16 sA, sB;
    { const char* K0 = lds; G_QK(sA, K0, 0); G_QK(sB, K0, 1); }
    if (wid >= 4) {
        if (ATT_PRIO == 1) __builtin_amdgcn_s_setprio(1);
        i32x8 p8 = ones8;
        for (int T = 0; T < NT; ++T) {
            if (T > 0) { asm volatile("s_waitcnt vmcnt(0)" ::: "memory"); __syncthreads(); if (T + 2 < NT) G_DMA(T + 2); }
#pragma unroll
            for (int sub = 0; sub < 2; ++sub) { const int s = 2 * T + sub;
                if (s > 0) { const char* Vp = G_VA(s - 1); G_PV(Vp); }
                f32x16 nA = negm, nB = negm;
                if (s + 1 < ntiles64) { const char* Kn = G_KA(s + 1); G_QK(nA, Kn, 0); G_QK(nB, Kn, 1); }
                G_SM(sA, sB, p8);
                sA = nA; sB = nB; }
        }
        { const char* Vp = G_VA(ntiles64 - 1); G_PV(Vp); }
        if (ATT_PRIO == 1) __builtin_amdgcn_s_setprio(0);
    } else {
        for (int T = 0; T < NT; ++T) {
            if (T > 0) { asm volatile("s_waitcnt vmcnt(0)" ::: "memory"); __syncthreads(); if (T + 2 < NT) G_DMA(T + 2); }
#pragma unroll
            for (int sub = 0; sub < 2; ++sub) { const int s = 2 * T + sub;
                f32x16 nA = negm, nB = negm;
                if (s + 1 < ntiles64) { const char* Kn = G_KA(s + 1); G_QK(nA, Kn, 0); G_QK(nB, Kn, 1); }
                i32x8 p8; G_SM(sA, sB, p8);
                { const char* Vc = G_VA(s); G_PV(Vc); }
                sA = nA; sB = nB; }
        }
    }
#undef G_DMA
#undef G_FRAG
#undef G_QK
#undef G_SM
#undef G_PV
#undef G_KA
#undef G_VA
    const float rl = __builtin_amdgcn_rcpf(ol[0]);
    bf16* Ow = Ob + (size_t)(wid * 32 + r32) * DM + 8 * hi;
#pragma unroll
    for (int d0 = 0; d0 < NCB; ++d0)
#pragma unroll
        for (int q = 0; q < 2; ++q) { u32x2 wa, wb;
            wa.x = pk2(o[d0][8 * q] * rl, o[d0][8 * q + 1] * rl); wa.y = pk2(o[d0][8 * q + 2] * rl, o[d0][8 * q + 3] * rl);
            wb.x = pk2(o[d0][8 * q + 4] * rl, o[d0][8 * q + 5] * rl); wb.y = pk2(o[d0][8 * q + 6] * rl, o[d0][8 * q + 7] * rl);
            const auto sx = __builtin_amdgcn_permlane32_swap(wa.x, wb.x, false, false), sy = __builtin_amdgcn_permlane32_swap(wa.y, wb.y, false, false);
            u32x4 w4; w4.x = sx[0]; w4.y = sy[0]; w4.z = sx[1]; w4.w = sy[1];
            *(u32x4*)(Ow + d0 * 32 + 16 * q) = w4; }
    __syncthreads();
}

__device__ __forceinline__ void attn_mla8(const unsigned char* __restrict__ Qb, const unsigned char* __restrict__ Kh, const unsigned char* __restrict__ VTh, int key_base, int ntiles,
                                          bf16* __restrict__ Ob, char* lds, float MC, const int wid_in) {
    constexpr int NCB = 4, KTB = 64 * 192, VTB = 128 * 64, KRS = 192, SLOT = KTB + VTB, RING = 4;
    static_assert(RING * SLOT <= RING_BYTES, "mla8 ring");
    const int wid = __builtin_amdgcn_readfirstlane(wid_in);
    int lane = lane_id_v(); asm volatile("" : "+v"(lane));
    const int r32 = lane & 31, hi = lane >> 5;
    f32x16 o[NCB];
#pragma unroll
    for (int d = 0; d < NCB; ++d) o[d] = (f32x16){0};
    f32x16 ol = (f32x16){0};
    i32x8 ones8;
    { i32x4 ow_; asm volatile("v_mov_b32 %0, 0x38383838\n\tv_mov_b32 %1, 0x38383838\n\tv_mov_b32 %2, 0x38383838\n\tv_mov_b32 %3, 0x38383838" : "=v"(ow_.x), "=v"(ow_.y), "=v"(ow_.z), "=v"(ow_.w)); ones8 = __builtin_shufflevector(ow_, ow_, 0, 1, 2, 3, 4, 5, 6, 7); }
    i32x8 q8[3];
    { const char* Qc = (const char*)Qb; const unsigned qoff = (unsigned)((wid * 32 + r32) * 192 + hi * 32);
#pragma unroll
      for (int st = 0; st < 3; ++st) { const i32x4 lo_ = *(const i32x4*)(Qc + qoff + st * 64), hi_ = *(const i32x4*)(Qc + qoff + st * 64 + 16); q8[st] = __builtin_shufflevector(lo_, hi_, 0, 1, 2, 3, 4, 5, 6, 7); } }
    unsigned ksrc[2], vsrc;
#pragma unroll
    for (int i = 0; i < 2; ++i) { const int j = (i * 8 + wid) * 64 + lane, row = j / 12, cp = j % 12, c = cp ^ ((row >> 2) & 3); ksrc[i] = (unsigned)(row * KRS + c * 16); }
    { const int j = wid * 64 + lane, v = j >> 2, cp = j & 3, c = cp ^ ((v >> 2) & 3); vsrc = (unsigned)(v * SP + c * 16); }
    const unsigned ldsb = (unsigned)(uintptr_t)lds;
#define M_DMA(t) do { const int t_ = (t); const unsigned sb_ = ldsb + (unsigned)(t_ % RING) * SLOT; const size_t k0_ = (size_t)(key_base + t_ * 64); \
    pg8::glds16((const char*)Kh + k0_ * KRS, ksrc[0], sb_ + (unsigned)(wid * 1024)); \
    if (wid < 4) pg8::glds16((const char*)Kh + k0_ * KRS, ksrc[1], sb_ + (unsigned)((8 + wid) * 1024)); \
    pg8::glds16((const char*)VTh + k0_, vsrc, sb_ + KTB + (unsigned)(wid * 1024)); } while (0)
    const int sw0 = (r32 >> 2) & 3; const unsigned xa = (unsigned)(((2 * hi) ^ sw0) << 4), xb = (unsigned)(((2 * hi + 1) ^ sw0) << 4);
    const unsigned kofA = (unsigned)(r32 * KRS) + xa, kofB = (unsigned)(r32 * KRS) + xb, vofA = (unsigned)(r32 * 64) + xa, vofB = (unsigned)(r32 * 64) + xb;
    f32x16 negm;
#pragma unroll
    for (int r = 0; r < 16; ++r) negm[r] = 8.0f - MC;
#define M_QK(P, Ks, KB) do { const char* rp_ = (Ks) + (KB) * (32 * KRS); \
        _Pragma("unroll") for (int st = 0; st < 3; ++st) { \
            const i32x4 lo_ = *(const i32x4*)(rp_ + st * 64 + kofA), hi_ = *(const i32x4*)(rp_ + st * 64 + kofB); \
            const i32x8 kf_ = __builtin_shufflevector(lo_, hi_, 0, 1, 2, 3, 4, 5, 6, 7); \
            P = __builtin_amdgcn_mfma_scale_f32_32x32x64_f8f6f4(kf_, q8[st], P, 0, 0, 0, 0x7F7F7F7F, 0, 0x7B7B7B7B); } } while (0)
#define M_SM(P, W0, W1, W2, W3) do { _Pragma("unroll") for (int r = 0; r < 16; ++r) { P[r] = __builtin_amdgcn_exp2f(P[r]); } \
        W0 = (int)pg8::pk4_bf8(P[0], P[1], P[2], P[3]); W1 = (int)pg8::pk4_bf8(P[4], P[5], P[6], P[7]); W2 = (int)pg8::pk4_bf8(P[8], P[9], P[10], P[11]); W3 = (int)pg8::pk4_bf8(P[12], P[13], P[14], P[15]); } while (0)
    M_DMA(0); if (ntiles > 1) M_DMA(1);
    asm volatile("s_waitcnt vmcnt(0)" ::: "memory"); __syncthreads();
    if (ntiles > 2) M_DMA(2);
    f32x16 sA = negm;
    { const char* Ks0 = lds; M_QK(sA, Ks0, 0); }
#define M_PV(Vs_) do { if (ATT_PRIO == 2) __builtin_amdgcn_s_setprio(1); _Pragma("unroll") for (int d0 = 0; d0 < NCB; ++d0) { const char* rp_ = (Vs_) + d0 * 2048; \
            const i32x4 lo_ = *(const i32x4*)(rp_ + vofA), hi_ = *(const i32x4*)(rp_ + vofB); \
            const i32x8 vf_ = __builtin_shufflevector(lo_, hi_, 0, 1, 2, 3, 4, 5, 6, 7); \
            o[d0] = __builtin_amdgcn_mfma_scale_f32_32x32x64_f8f6f4(vf_, p8, o[d0], 0, 1, 0, 0x7F7F7F7F, 0, 0x7F7F7F7F); } \
        ol = __builtin_amdgcn_mfma_scale_f32_32x32x64_f8f6f4(ones8, p8, ol, 0, 1, 0, 0x7F7F7F7F, 0, 0x7F7F7F7F); if (ATT_PRIO == 2) __builtin_amdgcn_s_setprio(0); } while (0)
    if (ATT_PRIO == 1 && wid >= 4) __builtin_amdgcn_s_setprio(1);
    if (wid >= 4) {
        i32x8 p8 = q8[0];
        for (int t = 0; t < ntiles; ++t) {
            const int slot = t % RING, nslot = (t + 1) % RING; const bool more = t + 1 < ntiles;
            if (t > 0) { asm volatile("s_waitcnt vmcnt(0)" ::: "memory"); __syncthreads(); if (t + 2 < ntiles) M_DMA(t + 2); }
            const char* Ks = lds + slot * SLOT; const char* Kn = lds + nslot * SLOT;
            if (t > 0) { const char* Vp = lds + ((t - 1) % RING) * SLOT + KTB; M_PV(Vp); }
            f32x16 n1 = negm; M_QK(n1, Ks, 1);
            M_SM(sA, p8[0], p8[1], p8[2], p8[3]);
            f32x16 n0 = negm; if (more) M_QK(n0, Kn, 0);
            M_SM(n1, p8[4], p8[5], p8[6], p8[7]);
            sA = n0;
        }
        { const char* Vp = lds + ((ntiles - 1) % RING) * SLOT + KTB; M_PV(Vp); }
    } else {
        for (int t = 0; t < ntiles; ++t) {
            const int slot = t % RING, nslot = (t + 1) % RING; const bool more = t + 1 < ntiles;
            if (t > 0) { asm volatile("s_waitcnt vmcnt(0)" ::: "memory"); __syncthreads(); if (t + 2 < ntiles) M_DMA(t + 2); }
            const char* Ks = lds + slot * SLOT; const char* Kn = lds + nslot * SLOT; const char* Vs = Ks + KTB;
            i32x8 p8;
            f32x16 n1 = negm; M_QK(n1, Ks, 1);
            M_SM(sA, p8[0], p8[1], p8[2], p8[3]);
            f32x16 n0 = negm; if (more) M_QK(n0, Kn, 0);
            M_SM(n1, p8[4], p8[5], p8[6], p8[7]);
            M_PV(Vs);
            sA = n0;
        }
    }
#undef M_PV
    if (ATT_PRIO == 1 && wid >= 4) __builtin_amdgcn_s_setprio(0);
#undef M_DMA
#undef M_QK
#undef M_SM
    const float rl = __builtin_amdgcn_rcpf(ol[0]);
    bf16* Ow = Ob + (size_t)(wid * 32 + r32) * DM + 8 * hi;
#pragma unroll
    for (int d0 = 0; d0 < NCB; ++d0)
#pragma unroll
        for (int q = 0; q < 2; ++q) { u32x2 wa, wb;
            wa.x = pk2(o[d0][8 * q] * rl, o[d0][8 * q + 1] * rl); wa.y = pk2(o[d0][8 * q + 2] * rl, o[d0][8 * q + 3] * rl);
            wb.x = pk2(o[d0][8 * q + 4] * rl, o[d0][8 * q + 5] * rl); wb.y = pk2(o[d0][8 * q + 6] * rl, o[d0][8 * q + 7] * rl);
            const auto sx = __builtin_amdgcn_permlane32_swap(wa.x, wb.x, false, false), sy = __builtin_amdgcn_permlane32_swap(wa.y, wb.y, false, false);
            u32x4 w4; w4.x = sx[0]; w4.y = sy[0]; w4.z = sx[1]; w4.w = sy[1];
            *(u32x4*)(Ow + d0 * 32 + 16 * q) = w4; }
    __syncthreads();
}

__device__ __forceinline__ void attn_mla8x(const unsigned char* __restrict__ Qb, const unsigned char* __restrict__ Kh, const unsigned char* __restrict__ VTh, int key_base, int ntiles64,
                                           bf16* __restrict__ Ob, char* lds, float MC, const int wid_in) {
    constexpr int NCB = 4, KTB = 64 * 192, VTB = 128 * 64, KRS = 192, SLOT = 2 * KTB + 2 * VTB, RING = 3;
    static_assert(RING * SLOT <= RING_BYTES, "mla8x ring");
    const int wid = __builtin_amdgcn_readfirstlane(wid_in);
    int lane = lane_id_v(); asm volatile("" : "+v"(lane));
    const int r32 = lane & 31, hi = lane >> 5;
    f32x16 o[NCB];
#pragma unroll
    for (int d = 0; d < NCB; ++d) o[d] = (f32x16){0};
    f32x16 ol = (f32x16){0};
    i32x8 ones8;
    { i32x4 ow_; asm volatile("v_mov_b32 %0, 0x38383838\n\tv_mov_b32 %1, 0x38383838\n\tv_mov_b32 %2, 0x38383838\n\tv_mov_b32 %3, 0x38383838" : "=v"(ow_.x), "=v"(ow_.y), "=v"(ow_.z), "=v"(ow_.w)); ones8 = __builtin_shufflevector(ow_, ow_, 0, 1, 2, 3, 4, 5, 6, 7); }
    i32x8 q8[3];
    { const char* Qc = (const char*)Qb; const unsigned qoff = (unsigned)((wid * 32 + r32) * 192 + hi * 32);
#pragma unroll
      for (int st = 0; st < 3; ++st) { const i32x4 lo_ = *(const i32x4*)(Qc + qoff + st * 64), hi_ = *(const i32x4*)(Qc + qoff + st * 64 + 16); q8[st] = __builtin_shufflevector(lo_, hi_, 0, 1, 2, 3, 4, 5, 6, 7); } }
    unsigned ksrc[3], vsrc;
#pragma unroll
    for (int i = 0; i < 3; ++i) { const int j = (i * 8 + wid) * 64 + lane, row = j / 12, cp = j % 12, c = cp ^ ((row >> 2) & 3); ksrc[i] = (unsigned)(row * KRS + c * 16); }
    { const int j = wid * 64 + lane, v = j >> 2, cp = j & 3, c = cp ^ ((v >> 2) & 3); vsrc = (unsigned)(v * SP + c * 16); }
    const unsigned ldsb = (unsigned)(uintptr_t)lds;
#define X_DMA(T) do { const int T_ = (T); const unsigned sb_ = ldsb + (unsigned)(T_ % RING) * SLOT; const size_t k0_ = (size_t)(key_base + T_ * 128); \
    pg8::glds16((const char*)Kh + k0_ * KRS, ksrc[0], sb_ + (unsigned)(wid * 1024)); \
    pg8::glds16((const char*)Kh + k0_ * KRS, ksrc[1], sb_ + (unsigned)((8 + wid) * 1024)); \
    pg8::glds16((const char*)Kh + k0_ * KRS, ksrc[2], sb_ + (unsigned)((16 + wid) * 1024)); \
    pg8::glds16((const char*)VTh + k0_, vsrc, sb_ + 2 * KTB + (unsigned)(wid * 1024)); \
    pg8::glds16((const char*)VTh + k0_ + 64, vsrc, sb_ + 2 * KTB + VTB + (unsigned)(wid * 1024)); } while (0)
    f32x16 negm;
#pragma unroll
    for (int r = 0; r < 16; ++r) negm[r] = 8.0f - MC;
#define X_QK(P, Ks, KB) do { const int row_ = 32 * (KB) + r32, sw_ = (row_ >> 2) & 3; const char* rp_ = (Ks) + row_ * KRS; \
        _Pragma("unroll") for (int st = 0; st < 3; ++st) { const int c0_ = 4 * st + 2 * hi; \
            const i32x4 lo_ = *(const i32x4*)(rp_ + ((c0_ ^ sw_) << 4)), hi_ = *(const i32x4*)(rp_ + (((c0_ + 1) ^ sw_) << 4)); \
            const i32x8 kf_ = __builtin_shufflevector(lo_, hi_, 0, 1, 2, 3, 4, 5, 6, 7); \
            P = __builtin_amdgcn_mfma_scale_f32_32x32x64_f8f6f4(kf_, q8[st], P, 0, 0, 0, 0x7F7F7F7F, 0, 0x7B7B7B7B); } } while (0)
#define X_SM(P, W, B) do { _Pragma("unroll") for (int r = 0; r < 16; ++r) { P[r] = __builtin_amdgcn_exp2f(P[r]); } \
        W[B] = (int)pg8::pk4_bf8(P[0], P[1], P[2], P[3]); W[B + 1] = (int)pg8::pk4_bf8(P[4], P[5], P[6], P[7]); W[B + 2] = (int)pg8::pk4_bf8(P[8], P[9], P[10], P[11]); W[B + 3] = (int)pg8::pk4_bf8(P[12], P[13], P[14], P[15]); } while (0)
#define X_PV(Vs_, PW) do { _Pragma("unroll") for (int d0 = 0; d0 < NCB; ++d0) { const int row_ = 32 * d0 + r32, sw_ = (row_ >> 2) & 3; const char* rp_ = (Vs_) + row_ * 64; \
            const i32x4 lo_ = *(const i32x4*)(rp_ + (((2 * hi) ^ sw_) << 4)), hi_ = *(const i32x4*)(rp_ + (((2 * hi + 1) ^ sw_) << 4)); \
            const i32x8 vf_ = __builtin_shufflevector(lo_, hi_, 0, 1, 2, 3, 4, 5, 6, 7); \
            o[d0] = __builtin_amdgcn_mfma_scale_f32_32x32x64_f8f6f4(vf_, PW, o[d0], 0, 1, 0, 0x7F7F7F7F, 0, 0x7F7F7F7F); } \
        ol = __builtin_amdgcn_mfma_scale_f32_32x32x64_f8f6f4(ones8, PW, ol, 0, 1, 0, 0x7F7F7F7F, 0, 0x7F7F7F7F); } while (0)
#define X_KA(s) (lds + (((s) >> 1) % RING) * SLOT + ((s) & 1) * KTB)
#define X_VA(s) (lds + (((s) >> 1) % RING) * SLOT + 2 * KTB + ((s) & 1) * VTB)
    const int NT = ntiles64 >> 1;
    X_DMA(0); if (NT > 1) X_DMA(1);
    asm volatile("s_waitcnt vmcnt(0)" ::: "memory"); __syncthreads();
    if (NT > 2) X_DMA(2);
    f32x16 sA = negm;
    { const char* K0 = lds; X_QK(sA, K0, 0); }
    if (wid >= 4) {
        for (int T = 0; T < NT; ++T) {
            if (T > 0) { asm volatile("s_waitcnt vmcnt(0)" ::: "memory"); __syncthreads(); if (T + 2 < NT) X_DMA(T + 2); }
            i32x8 pa, pb;
            { const int s = 2 * T; const char* Ks = X_KA(s); const char* Kn = X_KA(s + 1);
              f32x16 n1 = negm; X_QK(n1, Ks, 1);
              X_SM(sA, pa, 0);
              f32x16 n0 = negm; X_QK(n0, Kn, 0);
              X_SM(n1, pa, 4);
              sA = n0; }
            { const int s = 2 * T + 1; const char* Ks = X_KA(s); const char* Vp = X_VA(s - 1); const char* Vs = X_VA(s);
              X_PV(Vp, pa);
              f32x16 n1 = negm; X_QK(n1, Ks, 1);
              X_SM(sA, pb, 0);
              f32x16 n0 = negm; if (s + 1 < ntiles64) { const char* Kn = X_KA(s + 1); X_QK(n0, Kn, 0); }
              X_SM(n1, pb, 4);
              X_PV(Vs, pb);
              sA = n0; }
        }
    } else {
        for (int T = 0; T < NT; ++T) {
            if (T > 0) { asm volatile("s_waitcnt vmcnt(0)" ::: "memory"); __syncthreads(); if (T + 2 < NT) X_DMA(T + 2); }
#pragma unroll
            for (int sub = 0; sub < 2; ++sub) { const int s = 2 * T + sub; const char* Ks = X_KA(s); const char* Vs = X_VA(s);
                i32x8 p8;
                f32x16 n1 = negm; X_QK(n1, Ks, 1);
                X_SM(sA, p8, 0);
                f32x16 n0 = negm; if (s + 1 < ntiles64) { const char* Kn = X_KA(s + 1); X_QK(n0, Kn, 0); }
                X_SM(n1, p8, 4);
                X_PV(Vs, p8);
                sA = n0; }
        }
    }
#undef X_DMA
#undef X_QK
#undef X_SM
#undef X_PV
#undef X_KA
#undef X_VA
    const float rl = __builtin_amdgcn_rcpf(ol[0]);
    bf16* Ow = Ob + (size_t)(wid * 32 + r32) * DM + 8 * hi;
#pragma unroll
    for (int d0 = 0; d0 < NCB; ++d0)
#pragma unroll
        for (int q = 0; q < 2; ++q) { u32x2 wa, wb;
            wa.x = pk2(o[d0][8 * q] * rl, o[d0][8 * q + 1] * rl); wa.y = pk2(o[d0][8 * q + 2] * rl, o[d0][8 * q + 3] * rl);
            wb.x = pk2(o[d0][8 * q + 4] * rl, o[d0][8 * q + 5] * rl); wb.y = pk2(o[d0][8 * q + 6] * rl, o[d0][8 * q + 7] * rl);
            const auto sx = __builtin_amdgcn_permlane32_swap(wa.x, wb.x, false, false), sy = __builtin_amdgcn_permlane32_swap(wa.y, wb.y, false, false);
            u32x4 w4; w4.x = sx[0]; w4.y = sy[0]; w4.z = sx[1]; w4.w = sy[1];
            *(u32x4*)(Ow + d0 * 32 + 16 * q) = w4; }
    __syncthreads();
}
struct Args { const float* in[31]; float* out; unsigned char* ws; int ph_lo, ph_hi; };
enum { I_X = 0, I_C, I_CTX, I_CCTX, I_N1G, I_N2G, I_WMOD, I_BMOD, I_WINE, I_WOUTE, I_AQN, I_AKN, I_BQN, I_BKN, I_RPB, I_WINO, I_WOUTO, I_RDEC, I_RGN, I_CQNG, I_CKVNG, I_WUQ, I_WUKV, I_MQN, I_MKN,
       I_WR, I_BR, I_W1, I_B1, I_W2, I_B2 };

struct Ctx { int tid, lane, wave, gw, NGW, G, bid; char* lds; char* atb; };
__device__ __forceinline__ unsigned long long rfl64(unsigned long long v) { return ((unsigned long long)(unsigned)__builtin_amdgcn_readfirstlane((int)(v >> 32)) << 32) | (unsigned)__builtin_amdgcn_readfirstlane((int)v); }
#define GAS __attribute__((address_space(1)))
#define AIN(c, i) ((const float*)(const GAS float*)rfl64(*(const unsigned long long*)((c).atb + 8 * (i))))
#define AOUT(c) ((float*)(GAS float*)rfl64(*(const unsigned long long*)((c).atb + 8 * 31)))
#define AWS(c) ((unsigned char*)(GAS unsigned char*)rfl64(*(const unsigned long long*)((c).atb + 8 * 32)))
__device__ __forceinline__ u32x4 zero4u() { u32x4 z; asm volatile("v_mov_b32 %0, 0\n\tv_mov_b32 %1, 0\n\tv_mov_b32 %2, 0\n\tv_mov_b32 %3, 0" : "=v"(z.x), "=v"(z.y), "=v"(z.z), "=v"(z.w)); return z; }

__device__ __forceinline__ void tr_tile(const float* src, int ldn, bf16* dst, int ldk, float* scr, int lane) {
#pragma unroll 1
    for (int h2 = 0; h2 < 2; ++h2) { float tv[16];
#pragma unroll
      for (int i = 0; i < 16; ++i) tv[i] = src[(size_t)(2 * (16 * h2 + i) + (lane >> 5)) * ldn + (lane & 31)];
#pragma unroll
      for (int i = 0; i < 16; ++i) scr[(2 * (16 * h2 + i) + (lane >> 5)) * 33 + (lane & 31)] = tv[i]; }
    LDS_WAIT(); asm volatile("" ::: "memory");
    const int c = lane & 7;
#pragma unroll
    for (int j = 0; j < 4; ++j) { const int n = (lane >> 3) + 8 * j; const float* s = scr + (8 * c) * 33 + n;
        u32x4 o; o.x = pk2(s[0 * 33], s[1 * 33]); o.y = pk2(s[2 * 33], s[3 * 33]); o.z = pk2(s[4 * 33], s[5 * 33]); o.w = pk2(s[6 * 33], s[7 * 33]);
        *(u32x4*)(dst + (size_t)n * ldk + 8 * c) = o; }
    LDS_WAIT(); asm volatile("" ::: "memory");
}
__device__ __forceinline__ void tr_tile_f8(const float* src, int ldn, unsigned char* dst, int ldk, float sc, float* scr, int lane) {
#pragma unroll 1
    for (int h2 = 0; h2 < 2; ++h2) { float tv[16];
#pragma unroll
      for (int i = 0; i < 16; ++i) tv[i] = src[(size_t)(2 * (16 * h2 + i) + (lane >> 5)) * ldn + (lane & 31)];
#pragma unroll
      for (int i = 0; i < 16; ++i) scr[(2 * (16 * h2 + i) + (lane >> 5)) * 33 + (lane & 31)] = tv[i]; }
    LDS_WAIT(); asm volatile("" ::: "memory");
    const int c = lane & 7;
#pragma unroll
    for (int j = 0; j < 4; ++j) { const int n = (lane >> 3) + 8 * j; const float* s = scr + (8 * c) * 33 + n;
        u32x2 o; o.x = pg8::pk4_fp8(s[0 * 33] * sc, s[1 * 33] * sc, s[2 * 33] * sc, s[3 * 33] * sc); o.y = pg8::pk4_fp8(s[4 * 33] * sc, s[5 * 33] * sc, s[6 * 33] * sc, s[7 * 33] * sc);
        *(u32x2*)(dst + (size_t)n * ldk + 8 * c) = o; }
    LDS_WAIT(); asm volatile("" ::: "memory");
}
__device__ __forceinline__ void tr_tile64_f8(const float* src, int ldn, unsigned char* dst, int ldk, float sc, float* scr, int lane) {
#pragma unroll 1
    for (int h2 = 0; h2 < 2; ++h2) { f32x4 t[8];
#pragma unroll
        for (int i = 0; i < 8; ++i) t[i] = *(const f32x4*)(src + (size_t)(4 * (8 * h2 + i) + (lane >> 4)) * ldn + (lane & 15) * 4);
#pragma unroll
        for (int i = 0; i < 8; ++i) { float* sp = scr + (4 * (8 * h2 + i) + (lane >> 4)) * 65 + (lane & 15) * 4; sp[0] = t[i].x; sp[1] = t[i].y; sp[2] = t[i].z; sp[3] = t[i].w; } }
    LDS_WAIT(); asm volatile("" ::: "memory");
    const int c = lane & 7;
#pragma unroll
    for (int j = 0; j < 8; ++j) { const int n = (lane >> 3) + 8 * j; const float* s = scr + (8 * c) * 65 + n;
        u32x2 o; o.x = pg8::pk4_fp8(s[0 * 65] * sc, s[1 * 65] * sc, s[2 * 65] * sc, s[3 * 65] * sc); o.y = pg8::pk4_fp8(s[4 * 65] * sc, s[5 * 65] * sc, s[6 * 65] * sc, s[7 * 65] * sc);
        *(u32x2*)(dst + (size_t)n * ldk + 8 * c) = o; }
    LDS_WAIT(); asm volatile("" ::: "memory");
}
__device__ __forceinline__ void tr64_load(const float* src, int ldn, f32x4 (&t)[16], int lane) {
#pragma unroll
    for (int i = 0; i < 16; ++i) t[i] = *(const f32x4*)(src + (size_t)(4 * i + (lane >> 4)) * ldn + (lane & 15) * 4);
}
__device__ __forceinline__ void tr64_store_f8(const f32x4 (&t)[16], unsigned char* dst, int ldk, float sc, float* scr, int lane) {
#pragma unroll
    for (int i = 0; i < 16; ++i) { float* sp = scr + (4 * i + (lane >> 4)) * 65 + (lane & 15) * 4; sp[0] = t[i].x; sp[1] = t[i].y; sp[2] = t[i].z; sp[3] = t[i].w; }
    LDS_WAIT(); asm volatile("" ::: "memory");
    const int c = lane & 7;
#pragma unroll
    for (int j = 0; j < 8; ++j) { const int n = (lane >> 3) + 8 * j; const float* s = scr + (8 * c) * 65 + n;
        u32x2 o; o.x = pg8::pk4_fp8(s[0 * 65] * sc, s[1 * 65] * sc, s[2 * 65] * sc, s[3 * 65] * sc); o.y = pg8::pk4_fp8(s[4 * 65] * sc, s[5 * 65] * sc, s[6 * 65] * sc, s[7 * 65] * sc);
        *(u32x2*)(dst + (size_t)n * ldk + 8 * c) = o; }
    LDS_WAIT(); asm volatile("" ::: "memory");
}
__device__ __forceinline__ float silu_f(float x) { return x / (1.0f + __expf(-x)); }

__device__ __forceinline__ void phase_prologue(const Ctx& cx) {
    unsigned char* ws = AWS(cx);
    {
        float* sil = (float*)cx.lds;
        float* red = sil + 3 * 1024;
        float* MOD = (float*)(ws + WS_MOD);
        const float* cv = AIN(cx, I_C); const float* cc = AIN(cx, I_CCTX);
        for (int i = cx.tid; i < 3 * 1024; i += 512) sil[i] = silu_f(i < 2048 ? cv[i] : cc[i - 2048]);
        __syncthreads();
        for (int it = cx.bid; it < 4 * 96; it += cx.G) {
            const int l = it / 96, cg = it % 96, col = cg * 64 + cx.lane;
            const float* w = AIN(cx, I_WMOD) + ((size_t)l * 1024 + cx.wave * 128) * 6144 + col;
            const float* sw = sil + cx.wave * 128;
            float s0 = 0.f, s1 = 0.f, s2 = 0.f;
#pragma unroll 1
            for (int k0 = 0; k0 < 128; k0 += 32) { float wv[32];
#pragma unroll
                for (int k = 0; k < 32; ++k) wv[k] = w[(size_t)(k0 + k) * 6144];
#pragma unroll
                for (int k = 0; k < 32; ++k) { s0 += sw[k0 + k] * wv[k]; s1 += sw[1024 + k0 + k] * wv[k]; s2 += sw[2048 + k0 + k] * wv[k]; } }
            red[(cx.wave * 3 + 0) * 64 + cx.lane] = s0; red[(cx.wave * 3 + 1) * 64 + cx.lane] = s1; red[(cx.wave * 3 + 2) * 64 + cx.lane] = s2;
            __syncthreads();
            if (cx.tid < 192) { const int r = cx.tid >> 6, ln = cx.tid & 63; float s = 0.f;
#pragma unroll
                for (int w8 = 0; w8 < 8; ++w8) s += red[(w8 * 3 + r) * 64 + ln];
                MOD[((size_t)l * 3 + r) * 6144 + cg * 64 + ln] = s + AIN(cx, I_BMOD)[(size_t)l * 6144 + cg * 64 + ln]; }
            __syncthreads();
        }
    }
    float* scr = (float*)(cx.lds + cx.wave * 16640);
    constexpr int IT_W1 = 128 * 512, IT_W2 = 128 * 256;
    constexpr int S_WINE = 16 * 72, S_WOUT = 512, S_WINO = 16 * 78, S_UQ = 4 * 24, S_UKV = 2 * 32;
    constexpr int IT_SMALL = 2 * (S_WINE + S_WOUT + S_WINO + S_WOUT + S_UQ + S_UKV);
    {
        auto item = [&](int it, const float*& src, int& ldn, unsigned char*& dst) {
            if (it < IT_W1) { const int mat = it >> 9, r = it & 511, kb = r >> 5, nb = r & 31, n0 = nb * 64;
                const int orow = n0 < 1024 ? (n0 >> 7) * 256 + (n0 & 127) : ((n0 - 1024) >> 7) * 256 + 128 + (n0 & 127);
                src = AIN(cx, I_W1) + (size_t)mat * 1024 * 2048 + (size_t)kb * 64 * 2048 + n0; ldn = 2048; dst = (unsigned char*)(ws + WS_W1) + (size_t)mat * 2048 * 1024 + (size_t)orow * 1024 + kb * 64; }
            else { const int r = it - IT_W1, mat = r >> 8, q = r & 255, kb = q >> 4, nb = q & 15;
                src = AIN(cx, I_W2) + (size_t)mat * 1024 * 1024 + (size_t)kb * 64 * 1024 + nb * 64; ldn = 1024; dst = (unsigned char*)(ws + WS_W2) + (size_t)mat * 1024 * 1024 + (size_t)nb * 64 * 1024 + kb * 64; } };
        auto tile_of = [&](int sq) -> int { const int pr = cx.gw + (sq >> 1) * cx.NGW, half = sq & 1;
            if (pr >= (IT_W1 + IT_W2) / 2) return -1;
            if (pr < IT_W1 / 2) { const int mat = pr >> 8, q = pr & 255, kbp = q >> 5, nb = q & 31; return mat * 512 + (2 * kbp + half) * 32 + nb; }
            const int p2 = pr - IT_W1 / 2, mat = p2 >> 7, q = p2 & 127, kbp = q >> 4, nb = q & 15; return IT_W1 + mat * 256 + (2 * kbp + half) * 16 + nb; };
        int sq = 0, it = tile_of(0);
        if (it >= 0) {
            const float* src; int ldn; unsigned char* dst; f32x4 t[16], tn[16];
            item(it, src, ldn, dst); tr64_load(src, ldn, t, cx.lane);
            for (;;) {
                const int nit = tile_of(sq + 1); const float* nsrc = src; int nldn = ldn; unsigned char* ndst = dst;
                if (nit >= 0) { item(nit, nsrc, nldn, ndst); tr64_load(nsrc, nldn, tn, cx.lane); }
                tr64_store_f8(t, dst, 1024, 32.0f, scr, cx.lane);
                if (nit < 0) break;
#pragma unroll
                for (int i = 0; i < 16; ++i) t[i] = tn[i];
                src = nsrc; ldn = nldn; dst = ndst; ++sq;
            }
        }
    }
    for (int it = cx.gw; it < IT_SMALL; it += cx.NGW) {
        int r = it;
        const int i = r >= IT_SMALL / 2 ? 1 : 0; if (i) r -= IT_SMALL / 2;
        if (r < S_WINE) { const int kb = r / 72, nb = r % 72;
            tr_tile_f8(AIN(cx, I_WINE) + (size_t)i * 1024 * EIN + (size_t)kb * 64 * EIN + nb * 32, EIN, (unsigned char*)(ws + WS_WINE) + (size_t)i * EIN * 1024 + (size_t)nb * 32 * 1024 + kb * 64, 1024, 32.0f, scr, cx.lane); continue; }
        r -= S_WINE;
        if (r < S_WOUT) { const int kb = r >> 5, nb = r & 31;
            tr_tile(AIN(cx, I_WOUTE) + (size_t)i * 1024 * 1024 + (size_t)kb * 64 * 1024 + nb * 32, 1024, (bf16*)(ws + WS_WOUTE) + (size_t)i * 1024 * 1024 + (size_t)nb * 32 * 1024 + kb * 64, 1024, scr, cx.lane); continue; }
        r -= S_WOUT;
        if (r < S_WINO) { const int kb = r / 78, nb = r % 78;
            tr_tile_f8(AIN(cx, I_WINO) + (size_t)i * 1024 * OIN + (size_t)kb * 64 * OIN + nb * 32, OIN, (unsigned char*)(ws + WS_WINO) + (size_t)i * OINP * 1024 + (size_t)nb * 32 * 1024 + kb * 64, 1024, 32.0f, scr, cx.lane); continue; }
        r -= S_WINO;
        if (r < S_WOUT) { const int kb = r >> 5, nb = r & 31;
            tr_tile(AIN(cx, I_WOUTO) + (size_t)i * 1024 * 1024 + (size_t)kb * 64 * 1024 + nb * 32, 1024, (bf16*)(ws + WS_WOUTO) + (size_t)i * 1024 * 1024 + (size_t)nb * 32 * 1024 + kb * 64, 1024, scr, cx.lane); continue; }
        r -= S_WOUT;
        if (r < S_UQ) { const int kb = r / 24, nb = r % 24;
            tr_tile(AIN(cx, I_WUQ) + (size_t)i * 256 * 768 + (size_t)kb * 64 * 768 + nb * 32, 768, (bf16*)(ws + WS_WUQ) + (size_t)i * 768 * 256 + (size_t)nb * 32 * 256 + kb * 64, 256, scr, cx.lane); continue; }
        r -= S_UQ;
        { const int kb = r >> 5, nb = r & 31;
            tr_tile(AIN(cx, I_WUKV) + (size_t)i * 128 * 1024 + (size_t)kb * 64 * 1024 + nb * 32, 1024, (bf16*)(ws + WS_WUKV) + (size_t)i * 1024 * 256 + (size_t)nb * 32 * 256 + kb * 64, 256, scr, cx.lane); }
    }
    const int gt = cx.bid * 512 + cx.tid, NT_ = cx.G * 512;
    for (int idx = gt; idx < 2 * 64 * 64; idx += NT_) { const int i = idx / (64 * 64), q = idx % (64 * 64);
        *(u32x4*)((unsigned char*)(ws + WS_WINO) + (size_t)i * OINP * 1024 + (size_t)OIN * 1024 + (size_t)q * 16) = (u32x4){0u, 0u, 0u, 0u}; }
    for (int idx = gt; idx < 2 * 1024 * 16; idx += NT_) { const int i = idx / (1024 * 16), q = idx % (1024 * 16), row = q >> 4, c8 = q & 15;
        *(u32x4*)((bf16*)(ws + WS_WUKV) + (size_t)i * 1024 * 256 + (size_t)row * 256 + 128 + c8 * 8) = (u32x4){0u, 0u, 0u, 0u}; }
}

__device__ __forceinline__ void modulate_row(const f32x4 (&x)[4], const float* g, const float* shift, const float* scale, int lane, f32x4 (&y)[4]) {
    float ss = 0.f;
#pragma unroll
    for (int j = 0; j < 4; ++j) ss += (x[j].x * x[j].x + x[j].y * x[j].y) + (x[j].z * x[j].z + x[j].w * x[j].w);
    const float rs = rsqrtf(wave_sum(ss, lane) * (1.0f / DM) + EPS);
#pragma unroll
    for (int j = 0; j < 4; ++j) { const int o = 4 * lane + 256 * j; const f32x4 gv = *(const f32x4*)(g + o), sh = *(const f32x4*)(shift + o), sc = *(const f32x4*)(scale + o);
        y[j] = (x[j] * rs) * gv * (sc + 1.0f) + sh; }
}
__device__ __forceinline__ void modulate_row_c(const f32x4 (&x)[4], const f32x4 (&gv)[4], const f32x4 (&sh)[4], const f32x4 (&sc)[4], int lane, f32x4 (&y)[4]) {
    float ss = 0.f;
#pragma unroll
    for (int j = 0; j < 4; ++j) ss += (x[j].x * x[j].x + x[j].y * x[j].y) + (x[j].z * x[j].z + x[j].w * x[j].w);
    const float rs = rsqrtf(wave_sum(ss, lane) * (1.0f / DM) + EPS);
#pragma unroll
    for (int j = 0; j < 4; ++j) y[j] = (x[j] * rs) * gv[j] * (sc[j] + 1.0f) + sh[j];
}
__device__ __forceinline__ void store_row_bf16(bf16* dst, const f32x4 (&y)[4], int lane) {
#pragma unroll
    for (int j = 0; j < 4; ++j) { u32x2 w; w.x = pk2(y[j].x, y[j].y); w.y = pk2(y[j].z, y[j].w); *(u32x2*)(dst + 4 * lane + 256 * j) = w; }
}
__device__ __forceinline__ void store_row_fp8(unsigned char* dst, const f32x4 (&y)[4], int lane) {
#pragma unroll
    for (int j = 0; j < 4; ++j) *(unsigned*)(dst + 4 * lane + 256 * j) = pg8::pk4_fp8(y[j].x, y[j].y, y[j].z, y[j].w);
}
__device__ __forceinline__ int mrow_of(int tok) { return tok < NL ? (tok >> 14) : 2; }
__device__ __forceinline__ void load_row_bf16(const bf16* src, f32x4 (&x)[4], int lane) {
#pragma unroll
    for (int j = 0; j < 4; ++j) { const u32x2 w = *(const u32x2*)(src + 4 * lane + 256 * j);
        x[j] = (f32x4){__uint_as_float(w.x << 16), __uint_as_float(w.x & 0xffff0000u), __uint_as_float(w.y << 16), __uint_as_float(w.y & 0xffff0000u)}; }
}

__device__ __forceinline__ void phase_init(const Ctx& cx) {
    bf16* X0 = (bf16*)(AWS(cx) + WS_X0); bf16* ACT = (bf16*)(AWS(cx) + WS_ACT); const float* MOD = (const float*)(AWS(cx) + WS_MOD);
    f32x4 xn[4];
#define IN_LOAD(X, T) do { const float* src_ = (T) < NL ? AIN(cx, I_X) + (size_t)(T) * DM : AIN(cx, I_CTX) + (size_t)((T) - NL) * DM; \
        _Pragma("unroll") for (int j = 0; j < 4; ++j) X[j] = *(const f32x4*)(src_ + 4 * cx.lane + 256 * j); } while (0)
    if (cx.gw < DEPTH * 3 * 32) {
        const int l_ = cx.gw / 96, mrw_ = (cx.gw / 32) % 3, e_ = cx.gw & 31; float sm_ = 0.f;
        const float* sh_ = MOD + ((size_t)l_ * 3 + mrw_) * 6144 + 3 * 1024; const float* wr_ = AIN(cx, I_WR) + (size_t)l_ * 1024 * 32 + e_;
        for (int k = cx.lane; k < 1024; k += 64) sm_ += sh_[k] * wr_[(size_t)k * 32];
        sm_ = wave_sum(sm_, cx.lane);
        if (cx.lane == 0) ((float*)(AWS(cx) + WS_RB2))[cx.gw] = sm_; }
    for (int idx = cx.gw * 64 + cx.lane; idx < 12 * 32 * 1024; idx += cx.NGW * 64) {
        const int k = idx & 1023, e = (idx >> 10) & 31, lm = idx >> 15, l_ = lm / 3, mrw_ = lm % 3;
        const float w = AIN(cx, I_WR)[((size_t)l_ * 1024 + k) * 32 + e] * AIN(cx, I_N2G)[l_ * 1024 + k] * (1.0f + MOD[((size_t)l_ * 3 + mrw_) * 6144 + 4 * 1024 + k]);
        const unsigned short hh = f2bf(w), ll = f2bf(w - bf2f(hh));
        unsigned char* img = AWS(cx) + WS_RW + (size_t)lm * RW_IMG + e * 2064 + k * 2;
        *(unsigned short*)img = hh; *(unsigned short*)(img + 66048) = ll; }
    f32x4 ig[4], ish[4], isc[4]; int cur_mr = -1;
#pragma unroll
    for (int j = 0; j < 4; ++j) ig[j] = *(const f32x4*)(AIN(cx, I_N1G) + 4 * cx.lane + 256 * j);
    if (cx.gw < NTOK) IN_LOAD(xn, cx.gw);
    for (int tok = cx.gw; tok < NTOK; tok += cx.NGW) {
        f32x4 x[4], y[4];
#pragma unroll
        for (int j = 0; j < 4; ++j) x[j] = xn[j];
        if (tok + cx.NGW < NTOK) IN_LOAD(xn, tok + cx.NGW);
        store_row_bf16(X0 + (size_t)tok * DM, x, cx.lane);
        const int mrw = mrow_of(tok);
        if (mrw != cur_mr) { cur_mr = mrw; const float* mr = MOD + (size_t)mrw * 6144;
#pragma unroll
            for (int j = 0; j < 4; ++j) { ish[j] = *(const f32x4*)(mr + 4 * cx.lane + 256 * j); isc[j] = *(const f32x4*)(mr + 1024 + 4 * cx.lane + 256 * j); } }
        modulate_row_c(x, ig, ish, isc, cx.lane, y);
        store_row_fp8((unsigned char*)ACT + (size_t)tok * DM, y, cx.lane);
    }
}

__device__ __forceinline__ void tok_decode(int tok, int& b, int& pos, bool& lat) {
    if (tok < NL) { b = tok >> 14; pos = tok & (SEQ - 1); lat = true; } else { const int t2 = tok - NL; b = t2 >> 8; pos = SEQ + (t2 & 255); lat = false; }
}
__device__ __forceinline__ void rope8(float (&v)[8], int pi0, int nf, float grow, float gcol) {
#pragma unroll
    for (int p = 0; p < 4; ++p) { const int pi = pi0 + p; const int f = pi < nf ? pi : pi - nf; const float pv = pi < nf ? grow : gcol;
        const float inv = __builtin_amdgcn_exp2f(-(float)f * (L2T / (float)nf)); const float rev = pv * inv * 0.15915494309189535f;
        const float sn = __builtin_amdgcn_sinf(rev), cs = __builtin_amdgcn_cosf(rev);
        const float x1 = v[2 * p], x2 = v[2 * p + 1]; v[2 * p] = x1 * cs - x2 * sn; v[2 * p + 1] = x1 * sn + x2 * cs; }
}

__device__ __forceinline__ void phase_postproj_even(const Ctx& cx, int li) {
    unsigned char* ws = AWS(cx); const bf16* RAW = (const bf16*)(ws + WS_RAW);
    const float* aq = AIN(cx, I_AQN) + li * 64; const float* ak = AIN(cx, I_AKN) + li * 64; const float* bq = AIN(cx, I_BQN) + li * 64; const float* bk = AIN(cx, I_BKN) + li * 64;
    u32x4 cw[5], nw[5];
#define PE_LOAD(W, T) do { const bf16* row_ = RAW + (size_t)(T) * RAWLD; _Pragma("unroll") for (int it = 0; it < 5; ++it) { const int ch_ = it * 64 + cx.lane; \
        W[it] = (u32x4){0u, 0u, 0u, 0u}; if (ch_ < 288) W[it] = *(const u32x4*)(row_ + ch_ * 8); } } while (0)
    float gv[4][8]; bool hasg[4];
#pragma unroll
    for (int it = 0; it < 4; ++it) { const int ch = it * 64 + cx.lane, hh = ch >> 3, d0 = (ch & 7) * 8;
        const float* gp = hh < 8 ? aq : hh < 10 ? ak : hh < 12 ? nullptr : hh < 20 ? bq : hh < 28 ? bk : nullptr; hasg[it] = gp != nullptr;
#pragma unroll
        for (int e = 0; e < 8; ++e) gv[it][e] = gp ? gp[d0 + e] : 1.0f; }
    if (cx.gw < NTOK) PE_LOAD(cw, cx.gw);
    for (int tok = cx.gw; tok < NTOK; tok += cx.NGW) {
        int b, pos; bool lat; tok_decode(tok, b, pos, lat);
        const float grow = (float)(pos >> 6), gcol = (float)(pos & 63);
        const bool hn = tok + cx.NGW < NTOK;
        if (hn) PE_LOAD(nw, tok + cx.NGW);
#pragma unroll
        for (int it = 0; it < 5; ++it) {
            const int ch = it * 64 + cx.lane; const bool on = ch < 288;
            const u32x4 w = cw[it];
            float v[8]; unpack8(w, v);
            float ss = 0.f;
#pragma unroll
            for (int e = 0; e < 8; ++e) ss += v[e] * v[e];
            ss = sum8(ss);
            const float rs = rsqrtf(ss * (1.0f / 64.0f) + EPS);
            const int hh = ch >> 3, d0 = (ch & 7) * 8;
            int seg, h;
            if (hh < 8) { seg = 0; h = hh; } else if (hh < 10) { seg = 1; h = hh - 8; } else if (hh < 12) { seg = 2; h = hh - 10; } else if (hh < 20) { seg = 3; h = hh - 12; } else if (hh < 28) { seg = 4; h = hh - 20; } else { seg = 5; h = hh - 28; }
            if (it < 4 && hasg[it < 4 ? it : 0]) {
#pragma unroll
                for (int e = 0; e < 8; ++e) v[e] = v[e] * rs * gv[it < 4 ? it : 0][e]; }
            if (seg <= 1 && lat) rope8(v, d0 >> 1, 16, grow, gcol);
            if (seg == 0) {
#pragma unroll
                for (int e = 0; e < 8; ++e) v[e] *= 8.0f * 0.125f * LOG2E; }
            bf16* dst;
            if (seg <= 1) {
                unsigned char* d8 = seg == 0 ? (unsigned char*)(ws + WS_QA) + ((size_t)(b * 8 + h) * SP + pos) * 64 : (unsigned char*)(ws + WS_KA) + ((size_t)(b * 2 + h) * SP + pos) * 64;
                u32x2 w8; w8.x = pg8::pk4_fp8(v[0], v[1], v[2], v[3]); w8.y = pg8::pk4_fp8(v[4], v[5], v[6], v[7]);
                if (on) *(u32x2*)(d8 + d0) = w8;
                continue; }
            if (seg == 0) dst = (bf16*)(ws + WS_QA) + ((size_t)(b * 8 + h) * SP + pos) * 64;
            else if (seg == 1) dst = (bf16*)(ws + WS_KA) + ((size_t)(b * 2 + h) * SP + pos) * 64;
            else if (seg == 2) dst = (bf16*)(ws + WS_VA) + ((size_t)(b * 2 + h) * SP + pos) * 64;
            else if (seg == 3) dst = (bf16*)(ws + WS_QB) + ((size_t)(b * 8 + h) * SP + pos) * 64;
            else if (seg == 4) dst = (bf16*)(ws + WS_KB) + ((size_t)(b * 8 + h) * SP + pos) * 64;
            else dst = (bf16*)(ws + WS_VB) + ((size_t)(b * 8 + h) * SP + pos) * 64;
            if (on && seg != 2) *(u32x4*)(dst + d0) = pack8(v);
        }
        if (hn) {
#pragma unroll
            for (int it = 0; it < 5; ++it) cw[it] = nw[it]; }
    }
#undef PE_LOAD
}

__device__ __forceinline__ void phase_postproj_odd(const Ctx& cx, int li) {
    unsigned char* ws = AWS(cx); const bf16* RAW = (const bf16*)(ws + WS_RAW);
    const float* cqg = AIN(cx, I_CQNG) + li * 256; const float* ckg = AIN(cx, I_CKVNG) + li * 128;
    u32x4 cw[4], nw[4];
#define PO_LOAD(W, T) do { const bf16* row_ = RAW + (size_t)(T) * RAWLD; _Pragma("unroll") for (int it = 0; it < 3; ++it) W[it] = *(const u32x4*)(row_ + (it * 64 + cx.lane) * 8); \
        W[3] = (u32x4){0u, 0u, 0u, 0u}; if (cx.lane < 48) W[3] = *(const u32x4*)(row_ + (256 + cx.lane) * 8); } while (0)
    float gqk[8];
#pragma unroll
    for (int e = 0; e < 8; ++e) gqk[e] = cx.lane < 32 ? cqg[cx.lane * 8 + e] : cx.lane < 48 ? ckg[(cx.lane - 32) * 8 + e] : 0.f;
    if (cx.gw < NTOK) PO_LOAD(cw, cx.gw);
    for (int tok = cx.gw; tok < NTOK; tok += cx.NGW) {
        int b, pos; bool lat; tok_decode(tok, b, pos, lat);
        const float grow = (float)(pos >> 6), gcol = (float)(pos & 63);
        const bool hn = tok + cx.NGW < NTOK;
        if (hn) PO_LOAD(nw, tok + cx.NGW);
#pragma unroll
        for (int it = 0; it < 3; ++it) {
            u32x4 w = cw[it];
            float v[8]; unpack8(w, v);
            const int h = cx.lane >> 4, d0 = (cx.lane & 15) * 8;
            if (it == 0) {
#pragma unroll
                for (int e = 0; e < 8; ++e) v[e] *= 0.08838834764831845f; }
            if (it < 2 && lat) rope8(v, d0 >> 1, 32, grow, gcol);
            bf16* dst = (bf16*)(ws + (it == 0 ? WS_RQ : it == 1 ? WS_RK : WS_RV)) + ((size_t)(b * 4 + h) * SP + pos) * 128 + d0;
            *(u32x4*)dst = pack8(v);
        }
        {
            const u32x4 w = cw[3];
            float v[8]; unpack8(w, v);
            float ss = 0.f;
#pragma unroll
            for (int e = 0; e < 8; ++e) ss += v[e] * v[e];
            ss = sum16(ss);
            const float ss16 = ss; { auto r = __builtin_amdgcn_permlane16_swap(__float_as_uint(ss), __float_as_uint(ss), false, false); ss = __uint_as_float(r[0]) + __uint_as_float(r[1]); }
            if (cx.lane < 32) { const float rs = rsqrtf(ss * (1.0f / 256.0f) + EPS); const int d0 = cx.lane * 8;
#pragma unroll
                for (int e = 0; e < 8; ++e) v[e] = v[e] * rs * gqk[e];
                *(u32x4*)((bf16*)(ws + WS_CQN) + (size_t)tok * 256 + d0) = pack8(v);
            } else if (cx.lane < 48) { const float rs = rsqrtf(ss16 * (1.0f / 128.0f) + EPS); const int d0 = (cx.lane - 32) * 8;
#pragma unroll
                for (int e = 0; e < 8; ++e) v[e] = v[e] * rs * gqk[e];
                *(u32x4*)((bf16*)(ws + WS_CKVN) + (size_t)tok * 256 + d0) = pack8(v);
            } else { *(u32x4*)((bf16*)(ws + WS_CKVN) + (size_t)tok * 256 + 128 + (cx.lane - 48) * 8) = zero4u(); }
        }
        if (hn) {
#pragma unroll
            for (int it = 0; it < 4; ++it) cw[it] = nw[it]; }
    }
#undef PO_LOAD
}

__device__ __forceinline__ void phase_mla_prep(const Ctx& cx, int li) {
    unsigned char* ws = AWS(cx); const bf16* RAW = (const bf16*)(ws + WS_RAW); const bf16* QMR = (const bf16*)(ws + WS_QMR); const bf16* KVR = (const bf16*)(ws + WS_KVR);
    const float* qg = AIN(cx, I_MQN) + li * 192; const float* kg = AIN(cx, I_MKN) + li * 192;
    const int li32 = cx.lane & 31, g2 = cx.lane >> 5; const bool on = li32 < 24; const int d0 = li32 * 8;
    u32x4 cq[2], ck[2], nq[2], nk[2];
#define MP_LOAD(Q, K, T) do { _Pragma("unroll") for (int j = 0; j < 2; ++j) { const int h_ = 2 * j + g2; Q[j] = (u32x4){0u, 0u, 0u, 0u}; K[j] = (u32x4){0u, 0u, 0u, 0u}; \
        if (on) Q[j] = *(const u32x4*)(QMR + (size_t)(T) * 768 + h_ * 192 + d0); \
        if (li32 < 16) K[j] = *(const u32x4*)(KVR + (size_t)(T) * 1024 + h_ * 256 + d0); else if (on) K[j] = *(const u32x4*)(RAW + (size_t)(T) * RAWLD + 2432 + (d0 - 128)); } } while (0)
    float qgv[8], kgv[8];
#pragma unroll
    for (int e = 0; e < 8; ++e) { qgv[e] = on ? qg[d0 + e] : 0.f; kgv[e] = on ? kg[d0 + e] : 0.f; }
    if (cx.gw < NTOK) MP_LOAD(cq, ck, cx.gw);
    for (int tok = cx.gw; tok < NTOK; tok += cx.NGW) {
        int b, pos; bool lat; tok_decode(tok, b, pos, lat);
        const float grow = (float)(pos >> 6), gcol = (float)(pos & 63);
        const bool hn = tok + cx.NGW < NTOK;
        if (hn) MP_LOAD(nq, nk, tok + cx.NGW);
#pragma unroll
        for (int j = 0; j < 2; ++j) {
            const int h = 2 * j + g2;
            { const u32x4 w = cq[j];
              float v[8]; unpack8(w, v); float ss = 0.f;
#pragma unroll
              for (int e = 0; e < 8; ++e) ss += v[e] * v[e];
              ss = sum32(ss);
              const float rs = rsqrtf(ss * (1.0f / 192.0f) + EPS);
              if (on) {
#pragma unroll
                  for (int e = 0; e < 8; ++e) v[e] = v[e] * rs * qgv[e];
                  if (li32 >= 16 && lat) rope8(v, (d0 - 128) >> 1, 16, grow, gcol);
#pragma unroll
                  for (int e = 0; e < 8; ++e) v[e] *= 16.0f * 0.07216878364870322f * LOG2E;
                  { u32x2 w8; w8.x = pg8::pk4_fp8(v[0], v[1], v[2], v[3]); w8.y = pg8::pk4_fp8(v[4], v[5], v[6], v[7]); *(u32x2*)((unsigned char*)(ws + WS_QM) + ((size_t)(b * 4 + h) * SP + pos) * 192 + d0) = w8; } } }
            { const u32x4 w = ck[j];
              float v[8]; unpack8(w, v); float ss = 0.f;
#pragma unroll
              for (int e = 0; e < 8; ++e) ss += v[e] * v[e];
              ss = sum32(ss);
              const float rs = rsqrtf(ss * (1.0f / 192.0f) + EPS);
              if (on) {
#pragma unroll
                  for (int e = 0; e < 8; ++e) v[e] = v[e] * rs * kgv[e];
                  if (li32 >= 16 && lat) rope8(v, (d0 - 128) >> 1, 16, grow, gcol);
                  { u32x2 w8; w8.x = pg8::pk4_fp8(v[0], v[1], v[2], v[3]); w8.y = pg8::pk4_fp8(v[4], v[5], v[6], v[7]); *(u32x2*)((unsigned char*)(ws + WS_KM) + ((size_t)(b * 4 + h) * SP + pos) * 192 + d0) = w8; } } }
        }
        if (hn) { cq[0] = nq[0]; cq[1] = nq[1]; ck[0] = nk[0]; ck[1] = nk[1]; }
    }
#undef MP_LOAD
}


template <int DV_>
__device__ __forceinline__ void phase_vtrans(const Ctx& cx, const bf16* src, int ld, int col0, int hstride, int nh, unsigned char* dst) {
    constexpr int TS = 80;
    unsigned char* T = (unsigned char*)cx.lds;
    const int nunits = NBATCH * (SP / 64) * nh;
    constexpr int CPR = DV_ / 8;
    constexpr int NLD = (64 * CPR) / 512;
    u32x4 cw[NLD], nw[NLD];
#define VT_LOAD(W, U) do { const int h_ = (U) % nh, g_ = ((U) / nh) % (SP / 64), b_ = (U) / (nh * (SP / 64)); const int p0_ = g_ * 64; \
        const size_t t0_ = p0_ < SEQ ? (size_t)b_ * SEQ + p0_ : (size_t)NL + b_ * CTXL + (p0_ - SEQ); \
        _Pragma("unroll") for (int i = 0; i < NLD; ++i) { const int id = cx.tid + i * 512, k = id / CPR, vc = (id % CPR) * 8; \
            W[i] = *(const u32x4*)(src + (t0_ + k) * (size_t)ld + col0 + h_ * hstride + vc); } } while (0)
    if (cx.bid < nunits) VT_LOAD(cw, cx.bid);
    for (int u = cx.bid; u < nunits; u += cx.G) {
        const int h = u % nh, g = (u / nh) % (SP / 64), b = u / (nh * (SP / 64));
        const int pos0 = g * 64;
        const bool hn = u + cx.G < nunits;
        if (hn) VT_LOAD(nw, u + cx.G);
#pragma unroll
        for (int i = 0; i < NLD; ++i) { const int id = cx.tid + i * 512, k = id / CPR, vc = (id % CPR) * 8;
            const u32x4 w = cw[i];
            float v[8]; unpack8(w, v);
            const int kk = k & 31, hi = (kk >> 2) & 1, r = (kk & 3) + 4 * (kk >> 3), byte = hi * 32 + 16 * (k >> 5) + r;
            const unsigned lo = pg8::pk4_fp8(v[0], v[1], v[2], v[3]), hi4 = pg8::pk4_fp8(v[4], v[5], v[6], v[7]);
#pragma unroll
            for (int e = 0; e < 4; ++e) { T[(vc + e) * TS + byte] = (unsigned char)(lo >> (8 * e)); T[(vc + 4 + e) * TS + byte] = (unsigned char)(hi4 >> (8 * e)); } }
        __syncthreads();
        if (cx.tid < DV_ * 4) { const int v = cx.tid >> 2, c = cx.tid & 3;
            *(u32x4*)(dst + ((size_t)(b * nh + h) * DV_ + v) * SP + pos0 + c * 16) = *(const u32x4*)(T + v * TS + c * 16); }
        __syncthreads();
        if (hn) {
#pragma unroll
            for (int i = 0; i < NLD; ++i) cw[i] = nw[i]; }
    }
#undef VT_LOAD
}
__device__ __forceinline__ float log2_sigmoid(float x) { return -__builtin_amdgcn_logf(1.0f + __builtin_amdgcn_exp2f(-x * LOG2E)); }
__device__ __forceinline__ void phase_ret_kv(const Ctx& cx, int li) {
    unsigned char* ws = AWS(cx); char* T0 = cx.lds; char* T1 = cx.lds + TBYTES; char* T2 = cx.lds + 2 * TBYTES;
    const int r32 = cx.lane & 31, hi = cx.lane >> 5, mb = cx.wave & 3, nb0 = 2 * (cx.wave >> 2);
    float l2tab[8];
#pragma unroll
    for (int i = 0; i < 8; ++i) l2tab[i] = log2_sigmoid(AIN(cx, I_RDEC)[li * 8 + i]);
    u32x4 ck[4], cv[4], nk[4], nv[4];
#define RK_LOAD(KW, VW, U) do { const int c_ = (U) % NCHUNK, bh_ = (U) / NCHUNK; const size_t base_ = ((size_t)bh_ * SP + ret_chunk_pos(c_)) * 128; \
        const bf16* Kc_ = (const bf16*)(ws + WS_RK) + base_; const bf16* Vc_ = (const bf16*)(ws + WS_RV) + base_; \
        _Pragma("unroll") for (int i = 0; i < 4; ++i) { const int id = cx.tid + i * 512, s = id >> 4, d0 = (id & 15) * 8; \
            KW[i] = *(const u32x4*)(Kc_ + (size_t)s * 128 + d0); VW[i] = *(const u32x4*)(Vc_ + (size_t)s * 128 + d0); } } while (0)
    if (cx.bid < 8 * NCHUNK) RK_LOAD(ck, cv, cx.bid);
    for (int u = cx.bid; u < 8 * NCHUNK; u += cx.G) {
        const int c = u % NCHUNK, bh = u / NCHUNK, h = bh & 3;
        const float l2f = h == 0 ? l2tab[0] : h == 1 ? l2tab[1] : h == 2 ? l2tab[2] : l2tab[3], l2b = h == 0 ? l2tab[4] : h == 1 ? l2tab[5] : h == 2 ? l2tab[6] : l2tab[7];
        const bool hn = u + cx.G < 8 * NCHUNK;
        if (hn) RK_LOAD(nk, nv, u + cx.G);
#pragma unroll
        for (int i = 0; i < 4; ++i) { const int id = cx.tid + i * 512, s = id >> 4, d0 = (id & 15) * 8;
            const u32x4 kw = ck[i], vw = cv[i];
            float kv[8]; unpack8(kw, kv);
            const float df = exp2f(l2f * (float)(127 - s)), db = exp2f(l2b * (float)s);
            const unsigned short* vs = (const unsigned short*)&vw;
#pragma unroll
            for (int e = 0; e < 8; ++e) { *(bf16*)(T0 + toff(d0 + e, s * 2)) = vs[e]; *(bf16*)(T1 + toff(d0 + e, s * 2)) = (bf16)f2bf(kv[e] * df); *(bf16*)(T2 + toff(d0 + e, s * 2)) = (bf16)f2bf(kv[e] * db); } }
        __syncthreads();
#pragma unroll
        for (int dir = 0; dir < 2; ++dir) {
            f32x16 c0 = (f32x16){0}, c1 = (f32x16){0};
            mm128(T0, dir ? T2 : T1, c0, c1, mb, nb0, r32, hi);
            float* dst = (float*)(ws + WS_KVP) + ((size_t)(dir * 8 + bh) * NCHUNK + c) * 16384;
#pragma unroll
            for (int r = 0; r < 16; ++r) { const int v = mb * 32 + crow(r, hi); dst[v * 128 + nb0 * 32 + r32] = c0[r]; dst[v * 128 + nb0 * 32 + 32 + r32] = c1[r]; }
        }
        __syncthreads();
        if (hn) {
#pragma unroll
            for (int i = 0; i < 4; ++i) { ck[i] = nk[i]; cv[i] = nv[i]; } }
    }
#undef RK_LOAD
}
__device__ __forceinline__ void phase_ret_scan(const Ctx& cx, int li) {
    unsigned char* ws = AWS(cx); const float* KVP = (const float*)(ws + WS_KVP); bf16* STP = (bf16*)(ws + WS_STP);
    for (int idx = cx.bid * 512 + cx.tid; idx < 16 * 8192; idx += cx.G * 512) {
        const int seq = idx >> 13, el = (idx & 8191) * 2, dir = seq >> 3, h = seq & 3;
        const float cd = __builtin_amdgcn_exp2f(128.0f * log2_sigmoid(AIN(cx, I_RDEC)[li * 8 + dir * 4 + h]));
        float s0 = 0.f, s1 = 0.f; const size_t sb = (size_t)seq * NCHUNK * 16384 + el;
#pragma unroll 1
        for (int g = 0; g < 5; ++g) {
            f32x2 kv[26];
#pragma unroll
            for (int j = 0; j < 26; ++j) { const int s = g * 26 + j, c = dir == 0 ? (s < 2 ? 128 + s : s - 2) : 129 - s; kv[j] = *(const f32x2*)(KVP + sb + (size_t)c * 16384); }
#pragma unroll
            for (int j = 0; j < 26; ++j) { const int s = g * 26 + j, c = dir == 0 ? (s < 2 ? 128 + s : s - 2) : 129 - s;
                *(unsigned*)(STP + sb + (size_t)c * 16384) = pk2(s0, s1); s0 = s0 * cd + kv[j].x; s1 = s1 * cd + kv[j].y; }
        }
    }
}
__device__ __forceinline__ void phase_ret_out(const Ctx& cx, int li, int nchunk  ) {
    unsigned char* ws = AWS(cx); char* T0 = cx.lds; char* T1 = cx.lds + TBYTES; char* T2 = cx.lds + 2 * TBYTES; char* T3 = cx.lds + 3 * TBYTES;
    static_assert(4 * TBYTES <= MISC_OFF, "retention tiles");
    float* red = (float*)(cx.lds + MISC_OFF + 1024);
    const int mb = cx.wave & 3, wv = cx.wave >> 2, nb0 = 2 * wv;
    const bf16* RAW = (const bf16*)(ws + WS_RAW); bf16* OCAT = (bf16*)(ws + WS_OCAT);
    float l2tab[8];
#pragma unroll
    for (int i = 0; i < 8; ++i) l2tab[i] = log2_sigmoid(AIN(cx, I_RDEC)[li * 8 + i]);
    for (int u = cx.bid; u < 8 * nchunk; u += cx.G) {
        int lane_l = cx.lane; asm volatile("" : "+v"(lane_l));
        const int r32 = lane_l & 31, hi = lane_l >> 5;
        const int c = u % nchunk, bh = u / nchunk, h = bh & 3, b = bh >> 2;
        const float l2f = h == 0 ? l2tab[0] : h == 1 ? l2tab[1] : h == 2 ? l2tab[2] : l2tab[3], l2b = h == 0 ? l2tab[4] : h == 1 ? l2tab[5] : h == 2 ? l2tab[6] : l2tab[7];
        const int p0 = ret_chunk_pos(c);
        const size_t base = ((size_t)bh * SP + p0) * 128;
        stage_nat((const bf16*)(ws + WS_RQ) + base, T0, cx.tid);
        stage_nat((const bf16*)(ws + WS_RK) + base, T1, cx.tid);
        stage_nat((const bf16*)(ws + WS_STP) + ((size_t)(0 * 8 + bh) * NCHUNK + c) * 16384, T3, cx.tid);
        u32x4 sbw[4];
        { const bf16* sb_ = (const bf16*)(ws + WS_STP) + ((size_t)(1 * 8 + bh) * NCHUNK + c) * 16384;
#pragma unroll
          for (int i = 0; i < 4; ++i) { const int id = cx.tid + i * 512, row = id >> 4, c8 = id & 15; sbw[i] = *(const u32x4*)(sb_ + (size_t)row * 128 + c8 * 8); } }
        { const bf16* Vc = (const bf16*)(ws + WS_RV) + base;
#pragma unroll
          for (int i = 0; i < 4; ++i) { const int id = cx.tid + i * 512, s = id >> 4, d0 = (id & 15) * 8; const u32x4 vw = *(const u32x4*)(Vc + (size_t)s * 128 + d0);
              const unsigned short* vs = (const unsigned short*)&vw;
#pragma unroll
              for (int e = 0; e < 8; ++e) *(bf16*)(T2 + toff(d0 + e, s * 2)) = vs[e]; } }
        __syncthreads();
        f32x16 s0 = (f32x16){0}, s1 = (f32x16){0}, y0 = (f32x16){0}, y1 = (f32x16){0};
        mm128(T0, T1, s0, s1, mb, nb0, r32, hi);
        mm128(T0, T3, y0, y1, mb, nb0, r32, hi);
#pragma unroll
        for (int r = 0; r < 16; ++r) { const int t = mb * 32 + crow(r, hi); const float qd = exp2f(l2f * (float)(t + 1)); y0[r] *= qd; y1[r] *= qd; }
        __syncthreads();
#pragma unroll
        for (int r = 0; r < 16; ++r) { const int t = mb * 32 + crow(r, hi);
            { const int s = nb0 * 32 + r32, n = t - s; const float d = exp2f(n >= 0 ? l2f * (float)n : -l2b * (float)n); *(bf16*)(T1 + toff(t, s * 2)) = (bf16)f2bf(s0[r] * d); }
            { const int s = nb0 * 32 + 32 + r32, n = t - s; const float d = exp2f(n >= 0 ? l2f * (float)n : -l2b * (float)n); *(bf16*)(T1 + toff(t, s * 2)) = (bf16)f2bf(s1[r] * d); } }
#pragma unroll
        for (int i = 0; i < 4; ++i) { const int id = cx.tid + i * 512, row = id >> 4, c8 = id & 15; *(u32x4*)(T3 + toff(row, c8 * 16)) = sbw[i]; }
        __syncthreads();
        mm128(T1, T2, y0, y1, mb, nb0, r32, hi);
        { f32x16 z0 = (f32x16){0}, z1 = (f32x16){0};
          mm128(T0, T3, z0, z1, mb, nb0, r32, hi);
#pragma unroll
          for (int r = 0; r < 16; ++r) { const int t = mb * 32 + crow(r, hi); const float qd = exp2f(l2b * (float)(128 - t)); y0[r] += qd * z0[r]; y1[r] += qd * z1[r]; } }
        const int tok0 = __builtin_amdgcn_readfirstlane(p0 < SEQ ? b * SEQ + p0 : NL + b * CTXL + (p0 - SEQ));
        const char* grb = (const char*)(RAW + (size_t)tok0 * RAWLD + 1536 + h * 128); char* orb = (char*)(OCAT + (size_t)tok0 * DM + h * 128);
        unsigned short gtv[32];
#pragma unroll
        for (int r = 0; r < 16; ++r) { const int t = mb * 32 + crow(r, hi); const unsigned go = (unsigned)(t * RAWLD + nb0 * 32 + r32) * 2u;
            gtv[2 * r] = *(const unsigned short*)(grb + go); gtv[2 * r + 1] = *(const unsigned short*)(grb + go + 64); }
        const float* gng = AIN(cx, I_RGN) + li * 512 + h * 128;
        const float g0 = gng[nb0 * 32 + r32], g1 = gng[nb0 * 32 + 32 + r32];
#pragma unroll
        for (int r = 0; r < 16; ++r) { float sm = y0[r] + y1[r], sq = y0[r] * y0[r] + y1[r] * y1[r];
            sm = sum32(sm); sq = sum32(sq);
            if (r32 == 0) { const int t = mb * 32 + crow(r, hi); red[(t * 2 + wv) * 2] = sm; red[(t * 2 + wv) * 2 + 1] = sq; } }
        __syncthreads();
#pragma unroll
        for (int r = 0; r < 16; ++r) { const int t = mb * 32 + crow(r, hi);
            const float sm = red[(t * 2) * 2] + red[(t * 2 + 1) * 2], sq = red[(t * 2) * 2 + 1] + red[(t * 2 + 1) * 2 + 1];
            const float mu = sm * (1.0f / 128.0f), var = fmaxf(sq * (1.0f / 128.0f) - mu * mu, 0.f), rs = rsqrtf(var + GN_EPS);
            const unsigned oo = (unsigned)(t * DM + nb0 * 32 + r32) * 2u;
            { const float gt = bf2f(gtv[2 * r]); *(bf16*)(orb + oo) = (bf16)f2bf((y0[r] - mu) * rs * g0 * silu_f(gt)); }
            { const float gt = bf2f(gtv[2 * r + 1]); *(bf16*)(orb + oo + 64) = (bf16)f2bf((y1[r] - mu) * rs * g1 * silu_f(gt)); }
            if ((r & 3) == 3) asm volatile("" ::: "memory"); }
        __syncthreads();
    }
}

__device__ __forceinline__ void phase_wout_ctx(const Ctx& cx, const bf16* W, const float* gate) {
    unsigned char* ws = AWS(cx);
    const bf16* A = (const bf16*)(ws + WS_OCAT); const bf16* X0 = (const bf16*)(ws + WS_X0); bf16* X1 = (bf16*)(ws + WS_X1);
    const int fr = cx.lane & 15, fq = cx.lane >> 4;
    for (int blk = cx.bid; blk < 256; blk += cx.G) {
        const int r0 = NL + (blk >> 4) * 32 + (cx.wave >> 2) * 16, c0 = (blk & 15) * 64 + (cx.wave & 3) * 16;
        const bf16* ap = A + (size_t)(r0 + fr) * DM + fq * 8; const bf16* wp = W + (size_t)(c0 + fr) * DM + fq * 8;
        f32x4 acc = {0.f, 0.f, 0.f, 0.f};
#pragma unroll
        for (int k0 = 0; k0 < 1024; k0 += 256) { bf16x8 a[8], w[8];
#pragma unroll
            for (int i = 0; i < 8; ++i) { a[i] = *(const bf16x8*)(ap + k0 + i * 32); w[i] = *(const bf16x8*)(wp + k0 + i * 32); }
#pragma unroll
            for (int i = 0; i < 8; ++i) acc = __builtin_amdgcn_mfma_f32_16x16x32_bf16(w[i], a[i], acc, 0, 0, 0); }
        const size_t off = (size_t)(r0 + fr) * DM + c0 + 4 * fq;
        const u32x2 bw = *(const u32x2*)(X0 + off); const f32x4 gv = *(const f32x4*)(gate + 2 * 6144 + c0 + 4 * fq);
        const f32x4 bs = {__uint_as_float(bw.x << 16), __uint_as_float(bw.x & 0xffff0000u), __uint_as_float(bw.y << 16), __uint_as_float(bw.y & 0xffff0000u)};
        const f32x4 r = bs + gv * acc;
        u32x2 wv; wv.x = pk2(r[0], r[1]); wv.y = pk2(r[2], r[3]); *(u32x2*)(X1 + off) = wv;
    }
}

__device__ __forceinline__ void router_finish(float (&acc)[32], int lane, int my_e, float bias, int tok, int* hist, int* TOPE, float* TOPG, int* TOPR) {
#pragma unroll
    for (int i = 0; i < 16; ++i) { auto r = __builtin_amdgcn_permlane32_swap(__float_as_uint(acc[i]), __float_as_uint(acc[i + 16]), false, false); acc[i] = __uint_as_float(r[0]) + __uint_as_float(r[1]); }
#pragma unroll
    for (int i = 0; i < 8; ++i) { auto r = __builtin_amdgcn_permlane16_swap(__float_as_uint(acc[i]), __float_as_uint(acc[i + 8]), false, false); acc[i] = __uint_as_float(r[0]) + __uint_as_float(r[1]); }
    { const bool up = (lane & 8) != 0;
#pragma unroll
      for (int i = 0; i < 4; ++i) { const float t1 = acc[i] + dppf<0x128>(acc[i]), t2 = acc[i + 4] + dppf<0x128>(acc[i + 4]); acc[i] = up ? t2 : t1; } }
    { const bool up = (lane & 4) != 0;
#pragma unroll
      for (int i = 0; i < 2; ++i) { const float t1 = acc[i] + dppf<0x141>(acc[i]), t2 = acc[i + 2] + dppf<0x141>(acc[i + 2]); acc[i] = up ? t2 : t1; } }
    { const bool up = (lane & 2) != 0;
      const float t1 = acc[0] + dppf<0x4E>(acc[0]), t2 = acc[1] + dppf<0x4E>(acc[1]); acc[0] = up ? t2 : t1; }
    float v = acc[0] + dppf<0xB1>(acc[0]) + bias;
    float tv[4]; int te[4];
#pragma unroll
    for (int k = 0; k < 4; ++k) {
        float m = fmaxf(v, dppf<0xB1>(v)); m = fmaxf(m, dppf<0x4E>(m)); m = fmaxf(m, dppf<0x141>(m)); m = fmaxf(m, dppf<0x140>(m));
        { auto r = __builtin_amdgcn_permlane16_swap(__float_as_uint(m), __float_as_uint(m), false, false); m = fmaxf(__uint_as_float(r[0]), __uint_as_float(r[1])); }
        { auto r = __builtin_amdgcn_permlane32_swap(__float_as_uint(m), __float_as_uint(m), false, false); m = fmaxf(__uint_as_float(r[0]), __uint_as_float(r[1])); }
        const unsigned long long bm = __ballot(v == m);
        const int be = (int)(__builtin_ctzll(bm) >> 1);
        tv[k] = m; te[k] = be; if (my_e == be) v = -INFINITY; }
    if (lane == 0) {
        const float e1 = __expf(tv[1] - tv[0]), e2 = __expf(tv[2] - tv[0]), e3 = __expf(tv[3] - tv[0]); const float inv = 1.0f / (1.0f + e1 + e2 + e3);
        const float gs[4] = {inv, e1 * inv, e2 * inv, e3 * inv};
#pragma unroll
        for (int k = 0; k < 4; ++k) { const int rk = atomicAdd(&hist[te[k]], 1); TOPE[tok * 4 + k] = te[k]; TOPG[tok * 4 + k] = gs[k]; TOPR[tok * 4 + k] = rk; }
    }
}
__device__ __forceinline__ void router_top4(float v, int lane, int my_e, int tok, int* hist, int* TOPE, float* TOPG, int* TOPR) {
    float tv[4]; int te[4];
#pragma unroll
    for (int k = 0; k < 4; ++k) {
        float m = fmaxf(v, dppf<0xB1>(v)); m = fmaxf(m, dppf<0x4E>(m)); m = fmaxf(m, dppf<0x141>(m)); m = fmaxf(m, dppf<0x140>(m));
        { auto r = __builtin_amdgcn_permlane16_swap(__float_as_uint(m), __float_as_uint(m), false, false); m = fmaxf(__uint_as_float(r[0]), __uint_as_float(r[1])); }
        { auto r = __builtin_amdgcn_permlane32_swap(__float_as_uint(m), __float_as_uint(m), false, false); m = fmaxf(__uint_as_float(r[0]), __uint_as_float(r[1])); }
        const unsigned long long bm = __ballot(v == m);
        const int be = (int)(__builtin_ctzll(bm) >> 1);
        tv[k] = m; te[k] = be; if (my_e == be) v = -INFINITY; }
    {
        const float e1 = __expf(tv[1] - tv[0]), e2 = __expf(tv[2] - tv[0]), e3 = __expf(tv[3] - tv[0]); const float inv = 1.0f / (1.0f + e1 + e2 + e3);
        if (lane < 4) { const float g = lane == 0 ? inv : lane == 1 ? e1 * inv : lane == 2 ? e2 * inv : e3 * inv; const int e = lane == 0 ? te[0] : lane == 1 ? te[1] : lane == 2 ? te[2] : te[3];
            const int rk = atomicAdd(&hist[e], 1); TOPE[tok * 4 + lane] = e; TOPG[tok * 4 + lane] = g; TOPR[tok * 4 + lane] = rk; }
    }
}
#ifndef ROUTER_MFMA
#define ROUTER_MFMA 1
#endif
#if ROUTER_MFMA
__device__ __forceinline__ void phase_router(const Ctx& cx, int l, int n) {
    unsigned char* ws = AWS(cx); const bf16* X1 = (const bf16*)(ws + WS_X1); bf16* ACT = (bf16*)(ws + WS_ACT); const float* MOD = (const float*)(ws + WS_MOD) + (size_t)l * 3 * 6144;
    int* hist = (int*)(cx.lds + SCR_OFF + 4096);
    const float* wr = AIN(cx, I_WR) + (size_t)l * 1024 * 32; const float* br = AIN(cx, I_BR) + l * 32;
    float* LG = (float*)(ws + WS_LG); const float* RB2 = (const float*)(ws + WS_RB2) + l * 96;
    if (cx.tid < 32) hist[cx.tid] = 0;
    const int tpb = (n + cx.G - 1) / cx.G, t0 = cx.bid * tpb, t1 = (t0 + tpb < n) ? t0 + tpb : n;
    const int lane = cx.lane, fr = lane & 15, fq = lane >> 4;
    if (t1 > t0) {
        const int mr_lo = mrow_of(t0), mr_hi = mrow_of(t1 - 1);
        for (int mrw = mr_lo; mrw <= mr_hi; ++mrw) {
            const int lo_b = mrw == 0 ? 0 : (mrw == 1 ? SEQ : NL), hi_b = mrw == 0 ? SEQ : (mrw == 1 ? NL : NTOK);
            const int s0 = t0 > lo_b ? t0 : lo_b, s1 = t1 < hi_b ? t1 : hi_b;
            if (s1 <= s0) continue;
            __syncthreads();
            { const unsigned char* img = ws + WS_RW + (size_t)(l * 3 + mrw) * RW_IMG;
              for (int pc = cx.wave; pc < 129; pc += 8) pg8::glds16((const void*)img, (unsigned)(pc * 1024 + lane * 16), (unsigned)(uintptr_t)cx.lds + (unsigned)(pc * 1024));
              asm volatile("s_waitcnt vmcnt(0)" ::: "memory"); }
            __syncthreads();
            f32x4 bias0, bias1;
#pragma unroll
            for (int i = 0; i < 4; ++i) { bias0[i] = RB2[mrw * 32 + 4 * fq + i] + br[4 * fq + i]; bias1[i] = RB2[mrw * 32 + 16 + 4 * fq + i] + br[16 + 4 * fq + i]; }
            const int ng = (s1 - s0 + 15) >> 4;
            for (int gi = cx.wave; gi < ng; gi += 8) {
                const int tk = s0 + gi * 16 + fr, tkc = tk < s1 ? tk : s1 - 1;
                const bf16* ap = X1 + (size_t)tkc * DM + fq * 8;
                f32x4 acc0 = {0.f, 0.f, 0.f, 0.f}, acc1 = {0.f, 0.f, 0.f, 0.f}, gr = {0.f, 0.f, 0.f, 0.f};
                const char* bq = cx.lds + fr * 2064 + fq * 16;
                bf16x8 a[8], an[8];
#pragma unroll
                for (int i = 0; i < 8; ++i) a[i] = *(const bf16x8*)(ap + i * 32);
#pragma unroll 1
                for (int k0 = 0; k0 < 1024; k0 += 256) {
                    if (k0 + 256 < 1024) {
#pragma unroll
                        for (int i = 0; i < 8; ++i) an[i] = *(const bf16x8*)(ap + k0 + 256 + i * 32); }
#pragma unroll
                    for (int i = 0; i < 8; ++i) { const char* bp = bq + ((k0 >> 5) + i) * 64;
                        const bf16x8 bh0 = *(const bf16x8*)bp, bh1 = *(const bf16x8*)(bp + 33024), bl0 = *(const bf16x8*)(bp + 66048), bl1 = *(const bf16x8*)(bp + 66048 + 33024);
                        acc0 = __builtin_amdgcn_mfma_f32_16x16x32_bf16(bh0, a[i], acc0, 0, 0, 0); acc1 = __builtin_amdgcn_mfma_f32_16x16x32_bf16(bh1, a[i], acc1, 0, 0, 0);
                        acc0 = __builtin_amdgcn_mfma_f32_16x16x32_bf16(bl0, a[i], acc0, 0, 0, 0); acc1 = __builtin_amdgcn_mfma_f32_16x16x32_bf16(bl1, a[i], acc1, 0, 0, 0);
                        gr = __builtin_amdgcn_mfma_f32_16x16x32_bf16(a[i], a[i], gr, 0, 0, 0); }
#pragma unroll
                    for (int i = 0; i < 8; ++i) a[i] = an[i]; }
                const int q = fr & 3; float d = q == 0 ? gr[0] : q == 1 ? gr[1] : q == 2 ? gr[2] : gr[3]; d = (fr >> 2) == fq ? d : 0.f;
                { auto r = __builtin_amdgcn_permlane16_swap(__float_as_uint(d), __float_as_uint(d), false, false); d = __uint_as_float(r[0]) + __uint_as_float(r[1]); }
                { auto r = __builtin_amdgcn_permlane32_swap(__float_as_uint(d), __float_as_uint(d), false, false); d = __uint_as_float(r[0]) + __uint_as_float(r[1]); }
                const float rs = rsqrtf(d * (1.0f / DM) + EPS);
                if (tk < s1) { *(f32x4*)(LG + (size_t)tk * 32 + 4 * fq) = acc0 * rs + bias0; *(f32x4*)(LG + (size_t)tk * 32 + 16 + 4 * fq) = acc1 * rs + bias1; }
            }
        }
    }
    __syncthreads();
    int* TOPE = (int*)(ws + WS_TOPE); float* TOPG = (float*)(ws + WS_TOPG); int* TOPR = (int*)(ws + WS_TOPR);
    const int my_e = lane >> 1;
    u32x2 pra[4], prb[4];
    float pva = 0.f, pvb = 0.f;
#define RT_LG(T) __uint_as_float(__hip_atomic_load((const unsigned*)(LG + (size_t)(T) * 32 + my_e), __ATOMIC_RELAXED, __HIP_MEMORY_SCOPE_AGENT))
    { const int tk = t0 + 2 * cx.wave;
      if (tk < t1) { const int tkb = tk + 1 < t1 ? tk + 1 : tk; pva = RT_LG(tk); pvb = RT_LG(tkb);
#pragma unroll
          for (int j = 0; j < 4; ++j) { pra[j] = *(const u32x2*)(X1 + (size_t)tk * DM + 4 * lane + 256 * j); prb[j] = *(const u32x2*)(X1 + (size_t)tkb * DM + 4 * lane + 256 * j); } } }
    f32x4 rg[4], rsh[4], rsc[4]; int cur_mr = -1;
#pragma unroll
    for (int j = 0; j < 4; ++j) rg[j] = *(const f32x4*)(AIN(cx, I_N2G) + l * 1024 + 4 * lane + 256 * j);
    for (int tok = t0 + 2 * cx.wave; tok < t1; tok += 16) {
        const bool has2 = tok + 1 < t1; const int tokb = has2 ? tok + 1 : tok;
        const float va = pva, vb = pvb;
        { f32x4 x[4], xb[4], ya[4], yb[4];
#pragma unroll
          for (int j = 0; j < 4; ++j) { const u32x2 w = pra[j], w2 = prb[j];
              x[j] = (f32x4){__uint_as_float(w.x << 16), __uint_as_float(w.x & 0xffff0000u), __uint_as_float(w.y << 16), __uint_as_float(w.y & 0xffff0000u)};
              xb[j] = (f32x4){__uint_as_float(w2.x << 16), __uint_as_float(w2.x & 0xffff0000u), __uint_as_float(w2.y << 16), __uint_as_float(w2.y & 0xffff0000u)}; }
          { const int tn = tok + 16;
            if (tn < t1) { const int tnb = tn + 1 < t1 ? tn + 1 : tn; pva = RT_LG(tn); pvb = RT_LG(tnb);
#pragma unroll
                for (int j = 0; j < 4; ++j) { pra[j] = *(const u32x2*)(X1 + (size_t)tn * DM + 4 * lane + 256 * j); prb[j] = *(const u32x2*)(X1 + (size_t)tnb * DM + 4 * lane + 256 * j); } } }
          const int mra = mrow_of(tok), mrb = mrow_of(tokb);
          if (mra != cur_mr) { cur_mr = mra; const float* mr = MOD + (size_t)mra * 6144;
#pragma unroll
              for (int j = 0; j < 4; ++j) { rsh[j] = *(const f32x4*)(mr + 3 * 1024 + 4 * lane + 256 * j); rsc[j] = *(const f32x4*)(mr + 4 * 1024 + 4 * lane + 256 * j); } }
          modulate_row_c(x, rg, rsh, rsc, lane, ya);
#pragma unroll
          for (int j = 0; j < 4; ++j) *(unsigned*)((unsigned char*)ACT + (size_t)tok * DM + 4 * lane + 256 * j) = pg8::pk4_fp8(ya[j].x, ya[j].y, ya[j].z, ya[j].w);
          if (mrb == mra) modulate_row_c(xb, rg, rsh, rsc, lane, yb);
          else { const float* mr2 = MOD + (size_t)mrb * 6144; modulate_row(xb, AIN(cx, I_N2G) + l * 1024, mr2 + 3 * 1024, mr2 + 4 * 1024, lane, yb); }
#pragma unroll
          for (int j = 0; j < 4; ++j) *(unsigned*)((unsigned char*)ACT + (size_t)tokb * DM + 4 * lane + 256 * j) = pg8::pk4_fp8(yb[j].x, yb[j].y, yb[j].z, yb[j].w); }
        router_top4(va, lane, my_e, tok, hist, TOPE, TOPG, TOPR);
        if (has2) router_top4(vb, lane, my_e, tokb, hist, TOPE, TOPG, TOPR);
    }
#undef RT_LG
    __syncthreads();
    if (cx.tid < 32) ((int*)(ws + WS_HIST))[cx.bid * 32 + cx.tid] = hist[cx.tid];
}
#else
__device__ __forceinline__ void phase_router(const Ctx& cx, int l, int n) {
    unsigned char* ws = AWS(cx); const bf16* X1 = (const bf16*)(ws + WS_X1); bf16* ACT = (bf16*)(ws + WS_ACT); const float* MOD = (const float*)(ws + WS_MOD) + (size_t)l * 3 * 6144;
    int* hist = (int*)(cx.lds + SCR_OFF);
    float* wT = (float*)cx.lds;
    const float* wr = AIN(cx, I_WR) + (size_t)l * 1024 * 32; const float* br = AIN(cx, I_BR) + l * 32;
    if (cx.tid < 32) hist[cx.tid] = 0;
#pragma unroll 4
    for (int it = 0; it < 16; ++it) { const int idx = cx.tid + 512 * it, k = idx & 1023, e4 = idx >> 10; const f32x4 wv = *(const f32x4*)(wr + (size_t)k * 32 + e4 * 4);
        wT[(e4 * 4 + 0) * 1024 + k] = wv.x; wT[(e4 * 4 + 1) * 1024 + k] = wv.y; wT[(e4 * 4 + 2) * 1024 + k] = wv.z; wT[(e4 * 4 + 3) * 1024 + k] = wv.w; }
    __syncthreads();
    const int tpb = (n + cx.G - 1) / cx.G, t0 = cx.bid * tpb, t1 = (t0 + tpb < n) ? t0 + tpb : n;
    int* TOPE = (int*)(ws + WS_TOPE); float* TOPG = (float*)(ws + WS_TOPG); int* TOPR = (int*)(ws + WS_TOPR);
    const int lane = cx.lane;
    const int my_e = ((lane >> 5) & 1) * 16 + ((lane >> 4) & 1) * 8 + ((lane >> 3) & 1) * 4 + ((lane >> 2) & 1) * 2 + ((lane >> 1) & 1);
    const float bias = br[my_e];
    u32x2 pra[4], prb[4];
    { const int tk = t0 + 2 * cx.wave;
      if (tk < t1) { const int tkb = tk + 1 < t1 ? tk + 1 : tk;
#pragma unroll
          for (int j = 0; j < 4; ++j) { pra[j] = *(const u32x2*)(X1 + (size_t)tk * DM + 4 * lane + 256 * j); prb[j] = *(const u32x2*)(X1 + (size_t)tkb * DM + 4 * lane + 256 * j); } } }
    for (int tok = t0 + 2 * cx.wave; tok < t1; tok += 16) {
        const bool has2 = tok + 1 < t1; const int tokb = has2 ? tok + 1 : tok;
        f32x2 y2[4][4];
        { f32x4 x[4], xb[4], ya[4], yb[4];
#pragma unroll
          for (int j = 0; j < 4; ++j) { const u32x2 w = pra[j], w2 = prb[j];
              x[j] = (f32x4){__uint_as_float(w.x << 16), __uint_as_float(w.x & 0xffff0000u), __uint_as_float(w.y << 16), __uint_as_float(w.y & 0xffff0000u)};
              xb[j] = (f32x4){__uint_as_float(w2.x << 16), __uint_as_float(w2.x & 0xffff0000u), __uint_as_float(w2.y << 16), __uint_as_float(w2.y & 0xffff0000u)}; }
          { const int tn = tok + 16;
            if (tn < t1) { const int tnb = tn + 1 < t1 ? tn + 1 : tn;
#pragma unroll
                for (int j = 0; j < 4; ++j) { pra[j] = *(const u32x2*)(X1 + (size_t)tn * DM + 4 * lane + 256 * j); prb[j] = *(const u32x2*)(X1 + (size_t)tnb * DM + 4 * lane + 256 * j); } } }
          const float* mr = MOD + (size_t)mrow_of(tok) * 6144;
          modulate_row(x, AIN(cx, I_N2G) + l * 1024, mr + 3 * 1024, mr + 4 * 1024, lane, ya);
#pragma unroll
          for (int j = 0; j < 4; ++j) *(unsigned*)((unsigned char*)ACT + (size_t)tok * DM + 4 * lane + 256 * j) = pg8::pk4_fp8(ya[j].x, ya[j].y, ya[j].z, ya[j].w);
          const float* mr2 = MOD + (size_t)mrow_of(tokb) * 6144;
          modulate_row(xb, AIN(cx, I_N2G) + l * 1024, mr2 + 3 * 1024, mr2 + 4 * 1024, lane, yb);
#pragma unroll
          for (int j = 0; j < 4; ++j) *(unsigned*)((unsigned char*)ACT + (size_t)tokb * DM + 4 * lane + 256 * j) = pg8::pk4_fp8(yb[j].x, yb[j].y, yb[j].z, yb[j].w);
#pragma unroll
          for (int j = 0; j < 4; ++j)
#pragma unroll
              for (int i = 0; i < 4; ++i) y2[j][i] = (f32x2){ya[j][i], yb[j][i]}; }
        float acc0[32], acc1[32];
#pragma unroll
        for (int e = 0; e < 32; ++e) { f32x2 s2 = (f32x2){0.f, 0.f};
#pragma unroll
            for (int j = 0; j < 4; ++j) { const f32x4 wv = *(const f32x4*)(wT + e * 1024 + 256 * j + 4 * lane);
                s2 += y2[j][0] * wv.x; s2 += y2[j][1] * wv.y; s2 += y2[j][2] * wv.z; s2 += y2[j][3] * wv.w; }
            acc0[e] = s2.x; acc1[e] = s2.y; }
        router_finish(acc0, lane, my_e, bias, tok, hist, TOPE, TOPG, TOPR);
        if (has2) router_finish(acc1, lane, my_e, bias, tokb, hist, TOPE, TOPG, TOPR);
    }
    __syncthreads();
    if (cx.tid < 32) ((int*)(ws + WS_HIST))[cx.bid * 32 + cx.tid] = hist[cx.tid];
}
#endif
__device__ __forceinline__ void phase_scatter(const Ctx& cx, int n) {
    unsigned char* ws = AWS(cx); int* sm = (int*)(cx.lds + SCR_OFF);
    const int* HIST = (const int*)(ws + WS_HIST);
    if (cx.tid < 64) sm[cx.tid] = 0;
    __syncthreads();
    { const int e = cx.tid & 31, part = cx.tid >> 5; int cnt = 0, bs = 0;
      for (int bb = part; bb < cx.G; bb += 16) { const int hv = HIST[bb * 32 + e]; cnt += hv; if (bb < cx.bid) bs += hv; }
      atomicAdd(&sm[e], cnt); atomicAdd(&sm[32 + e], bs); }
    __syncthreads();
    if (cx.tid == 0) { int ps = 0; int* TE = (int*)(ws + WS_TILEE); int nt = 0;
        for (int e = 0; e < 32; ++e) { sm[64 + e] = ps; const int tl = (sm[e] + 255) >> 8; if (cx.bid == 0) for (int q = 0; q < tl; ++q) TE[1 + nt + q] = e; nt += tl; ps += tl << 8; }
        if (cx.bid == 0) TE[0] = nt; }
    __syncthreads();
    const int tpb = (n + cx.G - 1) / cx.G, t0 = cx.bid * tpb, t1 = (t0 + tpb < n) ? t0 + tpb : n;
    const int* TOPE = (const int*)(ws + WS_TOPE); const float* TOPG = (const float*)(ws + WS_TOPG); const int* TOPR = (const int*)(ws + WS_TOPR);
    int* POS = (int*)(ws + WS_POS); float* GATES = (float*)(ws + WS_GATES); const bf16* ACT = (const bf16*)(ws + WS_ACT); bf16* XS = (bf16*)(ws + WS_XS);
    typedef int i4s __attribute__((ext_vector_type(4)));
    u32x4 r0 = {0u, 0u, 0u, 0u}, rn = r0; i4s ce = {0, 0, 0, 0}, cr = ce, ne = ce, nr = ce; f32x4 cgt = {0.f, 0.f, 0.f, 0.f}, ngt = cgt;
#define SC_LOAD(R, E, RK, GT, T) do { R = *(const u32x4*)((const unsigned char*)ACT + (size_t)(T) * DM + cx.lane * 16); E = *(const i4s*)(TOPE + (size_t)(T) * 4); RK = *(const i4s*)(TOPR + (size_t)(T) * 4); GT = *(const f32x4*)(TOPG + (size_t)(T) * 4); } while (0)
    if (t0 + cx.wave < t1) SC_LOAD(r0, ce, cr, cgt, t0 + cx.wave);
    for (int tok = t0 + cx.wave; tok < t1; tok += 8) {
        const bool hn = tok + 8 < t1;
        if (hn) SC_LOAD(rn, ne, nr, ngt, tok + 8);
#pragma unroll
        for (int k = 0; k < 4; ++k) { const int e = ce[k]; const int dest = sm[64 + e] + sm[32 + e] + cr[k];
            *(u32x4*)((unsigned char*)XS + (size_t)dest * DM + cx.lane * 16) = r0;
            if (cx.lane == 0) { POS[tok * 4 + k] = dest; GATES[dest] = cgt[k]; } }
        if (hn) { r0 = rn; ce = ne; cr = nr; cgt = ngt; }
    }
#undef SC_LOAD
}
__device__ __forceinline__ void phase_combine(const Ctx& cx, int l, int n) {
    unsigned char* ws = AWS(cx); const bf16* X1 = (const bf16*)(ws + WS_X1); bf16* X0 = (bf16*)(ws + WS_X0); bf16* ACT = (bf16*)(ws + WS_ACT);
    const float* MOD = (const float*)(ws + WS_MOD) + (size_t)l * 3 * 6144; const unsigned char* YS = (const unsigned char*)(ws + WS_XS); const int* POS = (const int*)(ws + WS_POS);
    const bool lastl = (l == DEPTH - 1);
    typedef int i4 __attribute__((ext_vector_type(4)));
    int tok = cx.gw; if (tok >= n) return;
    unsigned cy[4][4], ny[4][4]; u32x2 cxr[4], nxr[4];
#define CB_LOAD(Y, XR, T, P) do { _Pragma("unroll") for (int k = 0; k < 4; ++k) { const unsigned char* yr = YS + (size_t)(P)[k] * DM; \
        _Pragma("unroll") for (int j = 0; j < 4; ++j) Y[k][j] = *(const unsigned*)(yr + 4 * cx.lane + 256 * j); } \
        _Pragma("unroll") for (int j = 0; j < 4; ++j) XR[j] = *(const u32x2*)(X1 + (size_t)(T) * DM + 4 * cx.lane + 256 * j); } while (0)
    i4 p0 = *(const i4*)(POS + (size_t)tok * 4);
    CB_LOAD(cy, cxr, tok, p0);
    i4 pn = p0; if (tok + cx.NGW < n) pn = *(const i4*)(POS + (size_t)(tok + cx.NGW) * 4);
    f32x4 cgate[4], cg1[4], csh[4], csc[4]; int cur_mr = -1;
    if (!lastl) {
#pragma unroll
        for (int j = 0; j < 4; ++j) cg1[j] = *(const f32x4*)(AIN(cx, I_N1G) + (l + 1) * 1024 + 4 * cx.lane + 256 * j); }
    for (; tok < n; tok += cx.NGW) {
        const bool hn = tok + cx.NGW < n;
        if (hn) CB_LOAD(ny, nxr, tok + cx.NGW, pn);
        i4 pn2 = pn; if (tok + 2 * cx.NGW < n) pn2 = *(const i4*)(POS + (size_t)(tok + 2 * cx.NGW) * 4);
        const int mr = mrow_of(tok);
        if (mr != cur_mr) { cur_mr = mr; const float* g2 = MOD + (size_t)mr * 6144 + 5 * 1024; const float* mn = (const float*)(ws + WS_MOD) + (size_t)(lastl ? l : l + 1) * 3 * 6144 + (size_t)mr * 6144;
#pragma unroll
            for (int j = 0; j < 4; ++j) { cgate[j] = *(const f32x4*)(g2 + 4 * cx.lane + 256 * j); csh[j] = *(const f32x4*)(mn + 4 * cx.lane + 256 * j); csc[j] = *(const f32x4*)(mn + 1024 + 4 * cx.lane + 256 * j); } }
        f32x4 x[4];
#pragma unroll
        for (int j = 0; j < 4; ++j) { f32x4 ys = (f32x4){0.f, 0.f, 0.f, 0.f};
#pragma unroll
            for (int k = 0; k < 4; ++k) { const unsigned w = cy[k][j]; const auto lo = __builtin_amdgcn_cvt_pk_f32_fp8(w, false), hi = __builtin_amdgcn_cvt_pk_f32_fp8(w, true);
                ys.x += lo[0]; ys.y += lo[1]; ys.z += hi[0]; ys.w += hi[1]; }
            const u32x2 xw = cxr[j]; const f32x4 xv = {__uint_as_float(xw.x << 16), __uint_as_float(xw.x & 0xffff0000u), __uint_as_float(xw.y << 16), __uint_as_float(xw.y & 0xffff0000u)};
            x[j] = xv + cgate[j] * (ys * 0.03125f); }
        if (lastl) {
#pragma unroll
            for (int j = 0; j < 4; ++j) *(f32x4*)(AOUT(cx) + (size_t)tok * DM + 4 * cx.lane + 256 * j) = x[j];
        } else {
            store_row_bf16(X0 + (size_t)tok * DM, x, cx.lane);
            f32x4 y[4];
            modulate_row_c(x, cg1, csh, csc, cx.lane, y);
            store_row_fp8((unsigned char*)ACT + (size_t)tok * DM, y, cx.lane);
        }
        if (hn) {
#pragma unroll
            for (int k = 0; k < 4; ++k)
#pragma unroll
                for (int j = 0; j < 4; ++j) cy[k][j] = ny[k][j];
#pragma unroll
            for (int j = 0; j < 4; ++j) cxr[j] = nxr[j]; }
        pn = pn2;
    }
#undef CB_LOAD
}
#ifndef SEAM_DBL
#define SEAM_DBL 0
#endif
#ifndef GQA_128
#define GQA_128 1
#endif
#ifndef GQA_PING
#define GQA_PING true
#endif
#ifndef ATT_V2
#define ATT_V2 1
#endif
#ifndef ATT_V2C
#define ATT_V2C ATT_V2
#endif
#ifndef ATT_DBG_DEAD
#define ATT_DBG_DEAD 0
#endif
#ifndef ATT_V2CE
#define ATT_V2CE ATT_V2C
#endif
#ifndef ATT_V2CO
#define ATT_V2CO ATT_V2C
#endif
constexpr float C64 = 0.125f * LOG2E, THR64 = 8.0f / 0.125f;
constexpr float SC192 = 0.07216878364870322f, C192 = SC192 * LOG2E, THR192 = 8.0f / SC192;

__device__ __forceinline__ float max_abs_gain(const float* g, int n, int lane) {
    asm volatile("" : "+v"(lane));
    float m = 0.f; for (int i = lane; i < n; i += 64) m = fmaxf(m, fabsf(g[i]));
#pragma unroll
    for (int o = 1; o < 64; o <<= 1) m = fmaxf(m, shx(m, o, lane));
    return m;
}
__device__ __forceinline__ void phase_attn_even(const Ctx& cx, int li, bool need_ctx) {
    unsigned char* ws = AWS(cx); bf16* OCAT = (bf16*)(ws + WS_OCAT);
    const bf16* QA = (const bf16*)(ws + WS_QA); const bf16* KA = (const bf16*)(ws + WS_KA); const bf16* VA = (const bf16*)(ws + WS_VA);
    const bf16* QB = (const bf16*)(ws + WS_QB); const bf16* KB = (const bf16*)(ws + WS_KB); const bf16* VB = (const bf16*)(ws + WS_VB);
    AttnNA na0; na0.krow0 = 0; na0.rq = 0; na0.r0 = 0; na0.cq = 0; na0.c0 = 0; na0.rpb = nullptr;
    const float MCa0 = 64.f * max_abs_gain(AIN(cx, I_AQN) + li * 64, 64, cx.lane) * max_abs_gain(AIN(cx, I_AKN) + li * 64, 64, cx.lane) * C64;
    for (int u = cx.bid; u < 1024; u += cx.G) {
        const int qb = u & 63, h = (u >> 6) & 7, b = u >> 9;
        #if ATT_V2
#if GQA_128
        attn_gqa128((const unsigned char*)QA + ((size_t)(b * 8 + h) * SP + qb * 256) * 64, (const unsigned char*)KA + (size_t)(b * 2 + (h >> 2)) * SP * 64, (const unsigned char*)(ws + WS_VTA) + (size_t)((b * 2 + (h >> 2)) * 64) * SP,
                    0, SP / 64, OCAT + ((size_t)b * SEQ + qb * 256) * DM + h * 64, cx.lds, MCa0, cx.wave);
#else
        attn_dense2<64, 64, 2, true, 4, GQA_PING, true>(QA + ((size_t)(b * 8 + h) * SP + qb * 256) * 64, KA + (size_t)(b * 2 + (h >> 2)) * SP * 64, VA + (size_t)(b * 2 + (h >> 2)) * SP * 64,
                                     0, SP / 64, OCAT + ((size_t)b * SEQ + qb * 256) * DM + h * 64, cx.lds, C64, MCa0, cx.wave);
#endif
#else
        attn_unit<64, 64, false, 2>(QA + ((size_t)(b * 8 + h) * SP + qb * 256) * 64, KA + (size_t)(b * 2 + (h >> 2)) * SP * 64, VA + (size_t)(b * 2 + (h >> 2)) * SP * 64,
                                 SP / 64, 0, 0, SP / 64, OCAT + ((size_t)b * SEQ + qb * 256) * DM + h * 64, cx.lds, C64, THR64, na0, cx.wave);
#endif
    }
    float* rpb_l = (float*)(cx.lds + SCR_OFF);
    const int lane_n = lane_id_v(), tid_n = cx.wave * 64 + lane_n;
#ifndef REP_NA
#define REP_NA 1
#endif
    for (int rna_ = 0; rna_ < REP_NA; ++rna_)
    for (int u = cx.bid; u < 1024; u += cx.G) {
        const int qb = u & 63, h = (u >> 6) & 7, b = u >> 9;
        if (tid_n < 465) rpb_l[tid_n] = AIN(cx, I_RPB)[((size_t)li * 8 + h) * 465 + tid_n] * 8.0f;
        const int R = qb * 4;
        int k0 = R - 4; k0 = k0 < 0 ? 0 : (k0 > 248 ? 248 : k0);
        int kl = R + 3 - 4; kl = kl < 0 ? 0 : (kl > 248 ? 248 : kl); kl += 7;
        AttnNA na; na.krow0 = k0; na.rq = R + (cx.wave >> 1);
        { int r0 = na.rq - 4; na.r0 = r0 < 0 ? 0 : (r0 > 248 ? 248 : r0); }
        na.cq = (cx.wave & 1) * 32 + (lane_n & 31);
        { int c0 = na.cq - 8; na.c0 = c0 < 0 ? 0 : (c0 > 48 ? 48 : c0); }
        na.rpb = rpb_l;
        const int n1 = kl - k0 + 1;
        attn_unit<64, 64, true, 2>(QB + ((size_t)(b * 8 + h) * SP + qb * 256) * 64, KB + (size_t)(b * 8 + h) * SP * 64, VB + (size_t)(b * 8 + h) * SP * 64,
                                n1, k0 * 64, SEQ, n1 + 4, OCAT + ((size_t)b * SEQ + qb * 256) * DM + 512 + h * 64, cx.lds, C64, THR64, na, cx.wave);
    }
    if (need_ctx) for (int u = cx.bid; u < 32; u += cx.G) {
        const int part = u >> 4, h = u & 7, b = (u >> 3) & 1;
        const int lane_c = lane_id_v();
        const float MCa = 64.f * max_abs_gain(AIN(cx, I_AQN) + li * 64, 64, lane_c) * max_abs_gain(AIN(cx, I_AKN) + li * 64, 64, lane_c) * C64;
        const float MCb = 64.f * max_abs_gain(AIN(cx, I_BQN) + li * 64, 64, lane_c) * max_abs_gain(AIN(cx, I_BKN) + li * 64, 64, lane_c) * C64;
#if ATT_DBG_DEAD
        if (cx.G == 12345) {
        if (part == 0) attn_gqa128((const unsigned char*)QA + ((size_t)(b * 8 + h) * SP + SEQ) * 64, (const unsigned char*)KA + (size_t)(b * 2 + (h >> 2)) * SP * 64, (const unsigned char*)(ws + WS_VTA) + (size_t)((b * 2 + (h >> 2)) * 64) * SP,
                                   SEQ, 4, OCAT + ((size_t)NL + b * CTXL) * DM + h * 64, cx.lds, MCa, cx.wave);
        else attn_dense2<64, 64, 2, true>(QB + ((size_t)(b * 8 + h) * SP + SEQ) * 64, KB + (size_t)(b * 8 + h) * SP * 64, VB + (size_t)(b * 8 + h) * SP * 64,
                                          SEQ, 4, OCAT + ((size_t)NL + b * CTXL) * DM + 512 + h * 64, cx.lds, C64, MCb, cx.wave);
        }
#endif
#if ATT_V2CE
        if (part == 0) attn_gqa128((const unsigned char*)QA + ((size_t)(b * 8 + h) * SP + SEQ) * 64, (const unsigned char*)KA + (size_t)(b * 2 + (h >> 2)) * SP * 64, (const unsigned char*)(ws + WS_VTA) + (size_t)((b * 2 + (h >> 2)) * 64) * SP,
                                   SEQ, 4, OCAT + ((size_t)NL + b * CTXL) * DM + h * 64, cx.lds, MCa, cx.wave);
        else attn_dense2<64, 64, 2, true>(QB + ((size_t)(b * 8 + h) * SP + SEQ) * 64, KB + (size_t)(b * 8 + h) * SP * 64, VB + (size_t)(b * 8 + h) * SP * 64,
                                          SEQ, 4, OCAT + ((size_t)NL + b * CTXL) * DM + 512 + h * 64, cx.lds, C64, MCb, cx.wave);
#else
        if (part == 0) attn_unit<64, 64, false, 2>(QA + ((size_t)(b * 8 + h) * SP + SEQ) * 64, KA + (size_t)(b * 2 + (h >> 2)) * SP * 64, VA + (size_t)(b * 2 + (h >> 2)) * SP * 64,
                                                4, SEQ, 0, 4, OCAT + ((size_t)NL + b * CTXL) * DM + h * 64, cx.lds, C64, THR64, na0, cx.wave);
        else attn_unit<64, 64, false, 2>(QB + ((size_t)(b * 8 + h) * SP + SEQ) * 64, KB + (size_t)(b * 8 + h) * SP * 64, VB + (size_t)(b * 8 + h) * SP * 64,
                                      4, SEQ, 0, 4, OCAT + ((size_t)NL + b * CTXL) * DM + 512 + h * 64, cx.lds, C64, THR64, na0, cx.wave);
#endif
    }
}
#ifndef MLA_128
#define MLA_128 0
#endif
#if MLA_128
#define MLA_FN attn_mla8x
#else
#define MLA_FN attn_mla8
#endif
__device__ __forceinline__ void phase_attn_mla(const Ctx& cx, int li, bool need_ctx) {
    unsigned char* ws = AWS(cx); bf16* OCAT = (bf16*)(ws + WS_OCAT);
    const bf16* QM = (const bf16*)(ws + WS_QM); const bf16* KM = (const bf16*)(ws + WS_KM); const bf16* VM = (const bf16*)(ws + WS_VM);
    const float MCm = 192.f * max_abs_gain(AIN(cx, I_MQN) + li * 192, 192, cx.lane) * max_abs_gain(AIN(cx, I_MKN) + li * 192, 192, cx.lane) * C192;
    for (int u = cx.bid; u < 512; u += cx.G) {
        const int qb = u & 63, h = (u >> 6) & 3, b = u >> 8;
#if ATT_V2
        MLA_FN((const unsigned char*)QM + ((size_t)(b * 4 + h) * SP + qb * 256) * 192, (const unsigned char*)KM + (size_t)(b * 4 + h) * SP * 192, (const unsigned char*)(ws + WS_VTM) + (size_t)((b * 4 + h) * 128) * SP,
                  0, SP / 64, OCAT + ((size_t)b * SEQ + qb * 256) * DM + 512 + h * 128, cx.lds, MCm, cx.wave);
#else
        { AttnNA na0; na0.krow0 = 0; na0.rq = 0; na0.r0 = 0; na0.cq = 0; na0.c0 = 0; na0.rpb = nullptr;
          attn_unit<192, 128, false, 1>(QM + ((size_t)(b * 4 + h) * SP + qb * 256) * 192, KM + (size_t)(b * 4 + h) * SP * 192, VM + (size_t)(b * 4 + h) * SP * 128,
                                   SP / 64, 0, 0, SP / 64, OCAT + ((size_t)b * SEQ + qb * 256) * DM + 512 + h * 128, cx.lds, C192, THR192, na0, cx.wave); }
#endif
    }
    if (need_ctx) for (int u = cx.bid; u < 8; u += cx.G) {
        const int h = u & 3, b = u >> 2;
#if ATT_V2CO
        MLA_FN((const unsigned char*)QM + ((size_t)(b * 4 + h) * SP + SEQ) * 192, (const unsigned char*)KM + (size_t)(b * 4 + h) * SP * 192, (const unsigned char*)(ws + WS_VTM) + (size_t)((b * 4 + h) * 128) * SP,
                  SEQ, 4, OCAT + ((size_t)NL + b * CTXL) * DM + 512 + h * 128, cx.lds, MCm, cx.wave);
#else
        { AttnNA na0; na0.krow0 = 0; na0.rq = 0; na0.r0 = 0; na0.cq = 0; na0.c0 = 0; na0.rpb = nullptr;
          attn_unit<192, 128, false, 1>(QM + ((size_t)(b * 4 + h) * SP + SEQ) * 192, KM + (size_t)(b * 4 + h) * SP * 192, VM + (size_t)(b * 4 + h) * SP * 128,
                                   4, SEQ, 0, 4, OCAT + ((size_t)NL + b * CTXL) * DM + 512 + h * 128, cx.lds, C192, THR192, na0, cx.wave); }
#endif
    }
}

constexpr int NSLOT = 11, NPHASE = 2 + DEPTH * NSLOT;
__host__ __device__ constexpr bool phase_nonempty(int p) { return p < 2 ? true : !((((p - 2) / NSLOT) & 1) == 0 && (((p - 2) % NSLOT) == 2 || ((p - 2) % NSLOT) == 3)); }

__global__ void __launch_bounds__(512, 2) mk_fwd(Args a_k) {
    extern __shared__ __attribute__((aligned(16))) unsigned char lds_raw[];
    Ctx cx; cx.wave = __builtin_amdgcn_readfirstlane(threadIdx.x >> 6); cx.lane = lane_id_v(); cx.tid = cx.wave * 64 + cx.lane; cx.G = gridDim.x; cx.bid = blockIdx.x;
    cx.gw = cx.bid * 8 + cx.wave; cx.NGW = cx.G * 8; cx.lds = (char*)lds_raw;
    LAS unsigned char* ldsl = (LAS unsigned char*)lds_raw;
    volatile LAS unsigned* MISC = (volatile LAS unsigned*)(ldsl + MISC_OFF);
    if (cx.tid < 32) MISC[cx.tid] = 0u;
    if (cx.tid == 0) {
        volatile unsigned long long* tb = (volatile unsigned long long*)(cx.lds + ARG_OFF);
#pragma unroll
        for (int i = 0; i < 31; ++i) tb[i] = (unsigned long long)a_k.in[i];
        tb[31] = (unsigned long long)a_k.out; tb[32] = (unsigned long long)a_k.ws;
    }
    __syncthreads();
    const int lo = a_k.ph_lo, hi = a_k.ph_hi;
    if (hi - lo > 1) (void)xcd_barrier_post((unsigned*)(a_k.ws + WS_CTL) + CW_BAR, MISC + 8, cx.wave);
#ifndef SITE_MASK
#define SITE_MASK 0xFFFFFFFFu
#endif
#define SITE(n) ((SITE_MASK >> (n)) & 1u)
#ifndef REP_MASK
#define REP_MASK 0u
#endif
#define REP2(n) ((REP_MASK >> (n)) & 1u)
#define IN(k) (lo <= (k) && (k) < hi)
#define SITE_CTX() Ctx cs = cx; cs.lane = lane_id_v(); asm volatile("" : "+v"(cs.lane), "+s"(cs.wave), "+s"(cs.bid)); cs.tid = cs.wave * 64 + cs.lane; cs.gw = cs.bid * 8 + cs.wave; cs.atb = cx.lds + ARG_OFF; asm volatile("" : "+s"(cs.atb))
#define SEAM(k) do { if ((k) + 1 < hi) { SITE_CTX(); XcdBarrier b2_; b2_.bar = (unsigned*)(AWS(cs) + WS_CTL) + CW_BAR; b2_.x = xb_xcc_id(); b2_.st = MISC + 8; b2_.wave = cs.wave; xcd_barrier(b2_); if (SEAM_DBL) xcd_barrier(b2_); } } while (0)
    for (int rep_ = 0; rep_ < ((SITE(0) && IN(0)) ? 1 + (int)REP2(0) : 0); ++rep_) { { SITE_CTX(); phase_prologue(cs); }; SEAM(0); }
    for (int rep_ = 0; rep_ < ((SITE(1) && IN(1)) ? 1 + (int)REP2(1) : 0); ++rep_) { { SITE_CTX(); phase_init(cs); }; SEAM(1); }
    for (int l = 0; l < DEPTH; ++l) {
        const int pb = 2 + l * NSLOT, li = l >> 1; const bool odd = (l & 1) != 0, need_ctx = l < DEPTH - 1;
        if (pb >= hi) break;
        const int nrows = need_ctx ? NTOK : NL;
        for (int rep_ = 0; rep_ < ((SITE(2) && IN(pb + 0)) ? 1 + (int)REP2(2) : 0); ++rep_) {
            SITE_CTX();
            pg8::Gemm g{(const bf16*)(AWS(cs) + WS_ACT), (const bf16*)(odd ? AWS(cs) + WS_WINO + (size_t)li * OINP * 1024 : AWS(cs) + WS_WINE + (size_t)li * EIN * 1024), 512, 0};
            pg8::StaticOrder S; S.init(NTOK, odd ? OINP : EIN, cs.G, cs.bid);
            pg8::EpiBf16 E{(bf16*)(AWS(cs) + WS_RAW), RAWLD, 0.03125f};
            pg8::gemm_phase_f8(ldsl, g, S, E, cs.wave);
            SEAM(pb + 0);
        }
        if (!odd) {
            for (int rep_ = 0; rep_ < ((SITE(3) && IN(pb + 1)) ? 1 + (int)REP2(3) : 0); ++rep_) { { SITE_CTX(); phase_postproj_even(cs, li); } { SITE_CTX(); __syncthreads(); phase_vtrans<64>(cs, (const bf16*)(AWS(cs) + WS_RAW), RAWLD, 640, 64, 2, (unsigned char*)(AWS(cs) + WS_VTA)); }; SEAM(pb + 1); }
            for (int rep_ = 0; rep_ < ((SITE(4) && IN(pb + 4)) ? 1 + (int)REP2(4) : 0); ++rep_) { { SITE_CTX(); phase_attn_even(cs, li, need_ctx); }; SEAM(pb + 4); }
        } else {
            for (int rep_ = 0; rep_ < ((SITE(5) && IN(pb + 1)) ? 1 + (int)REP2(5) : 0); ++rep_) { { SITE_CTX(); phase_postproj_odd(cs, li); }; SEAM(pb + 1); }
            for (int rep_ = 0; rep_ < ((SITE(6) && IN(pb + 2)) ? 1 + (int)REP2(6) : 0); ++rep_) {
                SITE_CTX();
                pg8::Gemm g{(const bf16*)(AWS(cs) + WS_CQN), (const bf16*)(AWS(cs) + WS_WUQ) + (size_t)li * 768 * 256, 256, 0};
                pg8::StaticOrder S; S.init(NTOK, 768, cx.G, cx.bid); pg8::EpiBf16 E{(bf16*)(AWS(cs) + WS_QMR), 768, 1.0f};
                pg8::gemm_phase(ldsl, g, S, E, cs.wave);
            }
            for (int rep_ = 0; rep_ < ((SITE(15) && IN(pb + 2)) ? 1 + (int)REP2(15) : 0); ++rep_) {
                SITE_CTX();
                pg8::Gemm g{(const bf16*)(AWS(cs) + WS_CKVN), (const bf16*)(AWS(cs) + WS_WUKV) + (size_t)li * 1024 * 256, 256, 0};
                pg8::StaticOrder S; S.init(NTOK, 1024, cx.G, cx.bid); pg8::EpiBf16 E{(bf16*)(AWS(cs) + WS_KVR), 1024, 1.0f};
                pg8::gemm_phase(ldsl, g, S, E, cs.wave);
            }
            for (int rep_ = 0; rep_ < ((SITE(16) && IN(pb + 2)) ? 1 + (int)REP2(16) : 0); ++rep_) { __syncthreads(); { SITE_CTX(); phase_ret_kv(cs, li); }; SEAM(pb + 2); }
            for (int rep_ = 0; rep_ < ((SITE(7) && IN(pb + 3)) ? 1 + (int)REP2(7) : 0); ++rep_) { { SITE_CTX(); phase_mla_prep(cs, li); } { SITE_CTX(); __syncthreads(); phase_vtrans<128>(cs, (const bf16*)(AWS(cs) + WS_KVR), 1024, 128, 256, 4, (unsigned char*)(AWS(cs) + WS_VTM)); }; { SITE_CTX(); phase_ret_scan(cs, li); }; SEAM(pb + 3); }
            for (int rep_ = 0; rep_ < ((SITE(8) && IN(pb + 4)) ? 1 + (int)REP2(8) : 0); ++rep_) { { SITE_CTX(); phase_attn_mla(cs, li, need_ctx); }; }
            for (int rep_ = 0; rep_ < ((SITE(17) && IN(pb + 4)) ? 1 + (int)REP2(17) : 0); ++rep_) { __syncthreads(); { SITE_CTX(); phase_ret_out(cs, li, need_ctx ? NCHUNK : 128); }; SEAM(pb + 4); }
        }
        for (int rep_ = 0; rep_ < ((SITE(9) && IN(pb + 5)) ? 1 + (int)REP2(9) : 0); ++rep_) {
            SITE_CTX();
            pg8::Gemm g{(const bf16*)(AWS(cs) + WS_OCAT), odd ? (const bf16*)(AWS(cs) + WS_WOUTO) + (size_t)li * 1024 * 1024 : (const bf16*)(AWS(cs) + WS_WOUTE) + (size_t)li * 1024 * 1024, 1024, 0};
            if (need_ctx) { SITE_CTX(); phase_wout_ctx(cs, odd ? (const bf16*)(AWS(cs) + WS_WOUTO) + (size_t)li * 1024 * 1024 : (const bf16*)(AWS(cs) + WS_WOUTE) + (size_t)li * 1024 * 1024, (const float*)(AWS(cs) + WS_MOD) + (size_t)l * 3 * 6144 + 2 * 1024); }
            pg8::StaticOrder S; S.init(NL, 1024, cx.G, cx.bid);
            pg8::EpiRes E{(const bf16*)(AWS(cs) + WS_X0), (bf16*)(AWS(cs) + WS_X1), (const float*)(AWS(cs) + WS_MOD) + (size_t)l * 3 * 6144 + 2 * 1024};
            pg8::gemm_phase(ldsl, g, S, E, cs.wave);
            SEAM(pb + 5);
        }
        for (int rep_ = 0; rep_ < ((SITE(10) && IN(pb + 6)) ? 1 + (int)REP2(10) : 0); ++rep_) { { SITE_CTX(); phase_router(cs, l, nrows); }; SEAM(pb + 6); }
        for (int rep_ = 0; rep_ < ((SITE(11) && IN(pb + 7)) ? 1 + (int)REP2(11) : 0); ++rep_) { { SITE_CTX(); phase_scatter(cs, nrows); }; SEAM(pb + 7); }
        for (int rep_ = 0; rep_ < ((SITE(12) && IN(pb + 8)) ? 1 + (int)REP2(12) : 0); ++rep_) {
            SITE_CTX();
            pg8::Gemm g{(const bf16*)(AWS(cs) + WS_XS), (const bf16*)(AWS(cs) + WS_W1 + (size_t)l * 32 * 2048 * 1024), 512, (size_t)2048 * 1024};
            pg8::MoeOrder S; S.init((const int*)(AWS(cs) + WS_TILEE), 8, cx.G, cx.bid, (LAS int*)(ldsl + SCR_OFF + 4096), cs.tid);
            pg8::EpiSwiGLU8 E{(unsigned char*)(AWS(cs) + WS_ACTS), AIN(cs, I_B1) + (size_t)l * 32 * 2048};
#ifdef REP_NOEPI
            if (rep_ == 1) pg8::gemm_phase_f8(ldsl, g, S, pg8::EpiKeep{}, cs.wave); else
#endif
            pg8::gemm_phase_f8(ldsl, g, S, E, cs.wave);
            SEAM(pb + 8);
        }
        for (int rep_ = 0; rep_ < ((SITE(13) && IN(pb + 9)) ? 1 + (int)REP2(13) : 0); ++rep_) {
            SITE_CTX();
            pg8::Gemm g{(const bf16*)(AWS(cs) + WS_ACTS), (const bf16*)(AWS(cs) + WS_W2 + (size_t)l * 32 * 1024 * 1024), 512, (size_t)1024 * 1024};
            pg8::MoeOrder S; S.init((const int*)(AWS(cs) + WS_TILEE), 4, cx.G, cx.bid, (LAS int*)(ldsl + SCR_OFF + 4096), cs.tid);
            pg8::EpiMoe2F8 E{(unsigned char*)(AWS(cs) + WS_XS), AIN(cs, I_B2) + (size_t)l * 32 * 1024, (const float*)(AWS(cs) + WS_GATES)};
#ifdef REP_NOEPI
            if (rep_ == 1) pg8::gemm_phase_f8(ldsl, g, S, pg8::EpiKeep{}, cs.wave); else
#endif
            pg8::gemm_phase_f8(ldsl, g, S, E, cs.wave);
            SEAM(pb + 9);
        }
        for (int rep_ = 0; rep_ < ((SITE(14) && IN(pb + 10)) ? 1 + (int)REP2(14) : 0); ++rep_) { { SITE_CTX(); phase_combine(cs, l, nrows); }; SEAM(pb + 10); }
    }
#undef IN
#undef SEAM
}

extern "C" void kernel_launch(void* const* d_in, const int* in_sizes, int n_in, void* d_out, int out_size, void* d_ws, size_t ws_size, hipStream_t stream) {
    static int grid = 0;
    if (grid == 0) {
        if (n_in != 31 || out_size != NL * DM || ws_size < WS_END) { fprintf(stderr, "kernel_launch: unexpected shapes (n_in %d out %d ws %zu need %zu)\n", n_in, out_size, ws_size, (size_t)WS_END); grid = -1; return; }
        int dev = 0, cus = 0, per_cu = 0;
        if (hipGetDevice(&dev) != hipSuccess || hipDeviceGetAttribute(&cus, hipDeviceAttributeMultiprocessorCount, dev) != hipSuccess) { grid = -1; return; }
        if (hipFuncSetAttribute((const void*)mk_fwd, hipFuncAttributeMaxDynamicSharedMemorySize, LDS_BYTES) != hipSuccess) { fprintf(stderr, "kernel_launch: hipFuncSetAttribute failed\n"); grid = -1; return; }
        if (hipOccupancyMaxActiveBlocksPerMultiprocessor(&per_cu, (const void*)mk_fwd, 512, LDS_BYTES) != hipSuccess || per_cu < 1) { fprintf(stderr, "kernel_launch: occupancy query says %d\n", per_cu); (void)hipGetLastError(); grid = -1; return; }
        grid = cus;
    }
    if (grid < 0) return;
    (void)hipMemsetAsync((char*)d_ws + WS_CTL, 0, CTL_BYTES, stream);
    Args a{};
    for (int i = 0; i < 31; ++i) a.in[i] = (const float*)d_in[i];
    a.out = (float*)d_out; a.ws = (unsigned char*)d_ws;
    const int stop = MK_STOP < NPHASE ? MK_STOP : NPHASE;
#if MK_MULTI
    for (int p = 0; p < stop; ++p) { if (!phase_nonempty(p)) continue; a.ph_lo = p; a.ph_hi = p + 1; hipLaunchKernelGGL(mk_fwd, dim3(grid), dim3(512), LDS_BYTES, stream, a); }
#else
    a.ph_lo = 0; a.ph_hi = stop; hipLaunchKernelGGL(mk_fwd, dim3(grid), dim3(512), LDS_BYTES, stream, a);
#endif
    const hipError_t le = hipPeekAtLastError();
    if (le != hipSuccess) fprintf(stderr, "kernel_launch: launch failed: %s\n", hipGetErrorName(le));
}
```
